# Optimizing an MI355X kernel written in HIP

```python
import jax, jax.numpy as jnp
from jax import lax
import numpy as np

D_MODEL = 2048
BATCH = 32
SEQ = 256
DEPTH = 2
DEC_BATCH = 8
DEC_SEQ = 2048
PAST_LEN = 256

GRID_W = 64
HEAD_DIM = 128
NA_HEADS = 12
NA_KR = 8
NA_KC = 16
NA_QC = 16
NA_KCB = 32
FNET_GROUPS = 4
FNET_CH = 128
POOL_WINDOWS = (2, 4, 8, 16)
POOL_CH = 128
GQA_Q_HEADS = 12
GQA_KV_HEADS = 4
D_FF = 5632
CONV_W = 3
ROPE_BASE = 10000.0
Q_BLOCK = 128
EPS = 1e-6
NEG_INF = -1e30
N_EVEN = (DEPTH + 1) // 2
N_ODD = DEPTH // 2
NA_WIDTH = NA_HEADS * HEAD_DIM
FNET_WIDTH = FNET_GROUPS * FNET_CH
POOL_WIDTH = len(POOL_WINDOWS) * POOL_CH
GQA_Q_WIDTH = GQA_Q_HEADS * HEAD_DIM
GQA_KV_WIDTH = GQA_KV_HEADS * HEAD_DIM
EVEN_IN = 3 * NA_WIDTH + FNET_WIDTH
ODD_IN = POOL_WIDTH + GQA_Q_WIDTH + 2 * GQA_KV_WIDTH
MIX_WIDTH = NA_WIDTH + FNET_WIDTH

kernel_name = 'hybrid_diffusion_prefix_step'

f32 = jnp.float32


def rms_norm(x, g):
    x32 = x.astype(f32)
    y = x32 * lax.rsqrt(jnp.mean(x32 * x32, axis=-1, keepdims=True) + EPS)
    return (y * g.astype(f32)).astype(x.dtype)


def ada_modulation(cond, w, b):
    m = jax.nn.silu(cond) @ w + b
    return m.reshape(cond.shape[0], 6, 1, D_MODEL)


def modulate(x, g, shift, scale):
    return rms_norm(x, g) * (1 + scale) + shift


def axial_rope(x):
    n = x.shape[1]
    t = jnp.arange(n)
    rows = (t // GRID_W).astype(f32)
    cols = (t % GRID_W).astype(f32)
    half = HEAD_DIM // 2
    inv_freq = jnp.power(ROPE_BASE, -jnp.arange(0, half, 2, dtype=f32) / half)

    def rot(xa, pos):
        ang = pos[:, None] * inv_freq[None, :]
        cos = jnp.cos(ang)[None, :, None, :]
        sin = jnp.sin(ang)[None, :, None, :]
        x1, x2 = xa[..., :half // 2], xa[..., half // 2:]
        return jnp.concatenate([x1 * cos - x2 * sin, x2 * cos + x1 * sin], axis=-1)

    x32 = x.astype(f32)
    out = jnp.concatenate([rot(x32[..., :half], rows), rot(x32[..., half:], cols)], axis=-1)
    return out.astype(x.dtype)


def block_attention(q, k, v):
    B, S, Hq, dh = q.shape
    Hkv = k.shape[2]
    G = Hq // Hkv
    nb = S // Q_BLOCK
    scale = dh ** -0.5
    qb = q.reshape(B, nb, Q_BLOCK, Hkv, G, dh).transpose(1, 0, 2, 3, 4, 5)

    def one(qi):
        s = jnp.einsum('bqhgd,bkhd->bhgqk', qi, k).astype(f32) * scale
        p = jax.nn.softmax(s, axis=-1).astype(v.dtype)
        return jnp.einsum('bhgqk,bkhd->bqhgd', p, v)

    o = lax.map(one, qb)
    return o.transpose(1, 0, 2, 3, 4, 5).reshape(B, S, Hq * dh)


def neighbourhood_attention(q, k, v, ctx_k, ctx_v, rel_bias):
    B, N, H, dh = q.shape
    R = N // GRID_W
    kr = min(NA_KR, R)
    n_cb = GRID_W // NA_QC
    qg = q.reshape(B, R, GRID_W, H, dh)
    kg = k.reshape(B, R, GRID_W, H, dh)
    vg = v.reshape(B, R, GRID_W, H, dh)
    cb_start = jnp.clip(jnp.arange(n_cb) * NA_QC - NA_KC // 2, 0, GRID_W - NA_KCB)
    col_idx = cb_start[:, None] + jnp.arange(NA_KCB)[None, :]
    q_col = jnp.arange(GRID_W).reshape(n_cb, NA_QC)
    q_start = jnp.clip(q_col - NA_KC // 2, 0, GRID_W - NA_KC)
    kc = col_idx[:, None, :]
    col_valid = (kc >= q_start[..., None]) & (kc < q_start[..., None] + NA_KC)
    dc_idx = jnp.clip(kc - q_col[..., None], -(NA_KC - 1), NA_KC - 1) + NA_KC - 1
    col_bias = rel_bias[:, :, dc_idx].astype(f32)
    scale = dh ** -0.5

    def one_row(r):
        r0 = jnp.clip(r - kr // 2, 0, R - kr)
        k_blk = lax.dynamic_slice_in_dim(kg, r0, kr, axis=1)[:, :, col_idx]
        v_blk = lax.dynamic_slice_in_dim(vg, r0, kr, axis=1)[:, :, col_idx]
        qr = lax.dynamic_index_in_dim(qg, r, axis=1, keepdims=False).reshape(B, n_cb, NA_QC, H, dh)
        dr_idx = r0 + jnp.arange(kr) - r + NA_KR - 1
        bias = col_bias[:, dr_idx].transpose(0, 2, 3, 1, 4)
        s_loc = jnp.einsum('bjqhd,bijchd->bhjqic', qr, k_blk).astype(f32) * scale + bias[None]
        s_loc = jnp.where(col_valid[:, :, None, :], s_loc, NEG_INF).reshape(B, H, n_cb, NA_QC, kr * NA_KCB)
        s_ctx = jnp.einsum('bjqhd,blhd->bhjql', qr, ctx_k).astype(f32) * scale
        p = jax.nn.softmax(jnp.concatenate([s_loc, s_ctx], axis=-1), axis=-1).astype(v.dtype)
        p_loc = p[..., :kr * NA_KCB].reshape(B, H, n_cb, NA_QC, kr, NA_KCB)
        p_ctx = p[..., kr * NA_KCB:]
        o = (jnp.einsum('bhjqic,bijchd->bjqhd', p_loc, v_blk)
             + jnp.einsum('bhjql,blhd->bjqhd', p_ctx, ctx_v))
        return o.reshape(B, GRID_W, H * dh)

    out = lax.map(one_row, jnp.arange(R))
    return out.transpose(1, 0, 2, 3).reshape(B, N, H * dh)


def fourier_mix(xb, fnet_w):
    B, N, _ = xb.shape
    xg = xb.astype(f32).reshape(B, N, FNET_GROUPS, FNET_CH)
    f = jnp.fft.fft2(xg, axes=(1, 3), norm='ortho').real.astype(xb.dtype)
    return jnp.einsum('bngc,gcd->bngd', f, fnet_w).reshape(B, N, FNET_WIDTH)


def pool_mix(xc, pool_w, pool_scale):
    B, N, _ = xc.shape
    xg = xc.reshape(B, N, len(POOL_WINDOWS), POOL_CH)
    cs = jnp.concatenate([jnp.zeros((B, 1, len(POOL_WINDOWS), POOL_CH), f32),
                          jnp.cumsum(xg.astype(f32), axis=1)], axis=1)
    t = jnp.arange(N)
    outs = []
    for g, w in enumerate(POOL_WINDOWS):
        lo = jnp.clip(t - w // 2, 0, N)
        hi = jnp.clip(t + w // 2, 0, N)
        mean = (cs[:, hi, g] - cs[:, lo, g]) / (hi - lo).astype(f32)[None, :, None]
        outs.append(mean - xg[:, :, g].astype(f32))
    pooled = jnp.stack(outs, axis=2).astype(xc.dtype)
    return jnp.einsum('bngc,gcd->bngd', pooled, pool_w).reshape(B, N, POOL_WIDTH) * pool_scale


def conv_ffn(h, w_up, conv_w, conv_b, w_down):
    n = h.shape[1]
    u = h @ w_up
    up = jnp.pad(u, ((0, 0), (CONV_W // 2, CONV_W // 2), (0, 0)))
    u = sum(up[:, i:i + n] * conv_w[i] for i in range(CONV_W)) + conv_b
    val, gate = jnp.split(u, 2, axis=-1)
    return (jax.nn.silu(gate) * val) @ w_down


def split_even(proj):
    B, N, _ = proj.shape
    qa, ka, va, xb = jnp.split(proj, [NA_WIDTH, 2 * NA_WIDTH, 3 * NA_WIDTH], axis=-1)
    heads = lambda a: a.reshape(B, N, NA_HEADS, HEAD_DIM)
    return heads(qa), heads(ka), heads(va), xb


def split_odd(proj):
    B, N, _ = proj.shape
    xc, q, k, v = jnp.split(proj, [POOL_WIDTH, POOL_WIDTH + GQA_Q_WIDTH,
                                   POOL_WIDTH + GQA_Q_WIDTH + GQA_KV_WIDTH], axis=-1)
    return (xc, q.reshape(B, N, GQA_Q_HEADS, HEAD_DIM),
            k.reshape(B, N, GQA_KV_HEADS, HEAD_DIM), v.reshape(B, N, GQA_KV_HEADS, HEAD_DIM))


def even_mixer_context(h, w_in, fnet_w, w_out):
    q, k, v, xb = split_even(h @ w_in)
    a = block_attention(q, k, v)
    out = jnp.concatenate([a, fourier_mix(xb, fnet_w)], axis=-1) @ w_out
    return out, k, v


def even_mixer_latent(h, ctx_k, ctx_v, w_in, na_bias, fnet_w, w_out):
    q, k, v, xb = split_even(h @ w_in)
    a = neighbourhood_attention(q, k, v, ctx_k, ctx_v, na_bias)
    return jnp.concatenate([a, fourier_mix(xb, fnet_w)], axis=-1) @ w_out


def odd_mixer_context(h, w_in, pool_w, pool_scale, q_g, k_g, w_out):
    xc, q, k, v = split_odd(h @ w_in)
    q = rms_norm(q, q_g)
    k = rms_norm(k, k_g)
    a = block_attention(q, k, v)
    out = jnp.concatenate([pool_mix(xc, pool_w, pool_scale), a], axis=-1) @ w_out
    return out, k, v


def odd_mixer_latent(h, ctx_k, ctx_v, w_in, pool_w, pool_scale, q_g, k_g, w_out):
    xc, q, k, v = split_odd(h @ w_in)
    q = axial_rope(rms_norm(q, q_g))
    k = axial_rope(rms_norm(k, k_g))
    a = block_attention(q, jnp.concatenate([ctx_k, k], axis=1), jnp.concatenate([ctx_v, v], axis=1))
    return jnp.concatenate([pool_mix(xc, pool_w, pool_scale), a], axis=-1) @ w_out


def setup_inputs(seed: int = 0) -> dict:
    key = jax.random.key(seed)
    ks = jax.random.split(key, 28)

    def nrm(k, shape, scale):
        return jax.random.normal(k, shape, f32) * scale

    return {
        'x_prompt': nrm(ks[0], (BATCH, SEQ, D_MODEL), 1.0),
        'x_sample': nrm(ks[1], (DEC_BATCH, DEC_SEQ, D_MODEL), 1.0),
        'c': nrm(ks[2], (DEC_BATCH, D_MODEL), 1.0),
        'cache_na_k': nrm(ks[3], (DEC_BATCH, N_EVEN, PAST_LEN, NA_HEADS, HEAD_DIM), 1.0),
        'cache_na_v': nrm(ks[4], (DEC_BATCH, N_EVEN, PAST_LEN, NA_HEADS, HEAD_DIM), 1.0),
        'cache_gqa_k': nrm(ks[5], (DEC_BATCH, N_ODD, PAST_LEN, GQA_KV_HEADS, HEAD_DIM), 1.0),
        'cache_gqa_v': nrm(ks[6], (DEC_BATCH, N_ODD, PAST_LEN, GQA_KV_HEADS, HEAD_DIM), 1.0),
        'c_ctx': nrm(ks[7], (D_MODEL,), 1.0),
        'norm1_g': 1.0 + nrm(ks[8], (DEPTH, D_MODEL), 0.05),
        'norm2_g': 1.0 + nrm(ks[9], (DEPTH, D_MODEL), 0.05),
        'ada_w': nrm(ks[10], (DEPTH, D_MODEL, 6 * D_MODEL), 0.5 * D_MODEL ** -0.5),
        'ada_b': nrm(ks[11], (DEPTH, 6 * D_MODEL), 0.02),
        'ev_w_in': nrm(ks[12], (N_EVEN, D_MODEL, EVEN_IN), D_MODEL ** -0.5),
        'ev_na_bias': nrm(ks[13], (N_EVEN, NA_HEADS, 2 * NA_KR - 1, 2 * NA_KC - 1), 0.1),
        'ev_fnet_w': nrm(ks[14], (N_EVEN, FNET_GROUPS, FNET_CH, FNET_CH), FNET_CH ** -0.5),
        'ev_w_out': nrm(ks[15], (N_EVEN, MIX_WIDTH, D_MODEL), MIX_WIDTH ** -0.5),
        'od_w_in': nrm(ks[16], (N_ODD, D_MODEL, ODD_IN), D_MODEL ** -0.5),
        'od_pool_w': nrm(ks[17], (N_ODD, len(POOL_WINDOWS), POOL_CH, POOL_CH), POOL_CH ** -0.5),
        'od_pool_scale': 1.0 + nrm(ks[18], (N_ODD, POOL_WIDTH), 0.1),
        'od_q_norm_g': 1.0 + nrm(ks[19], (N_ODD, HEAD_DIM), 0.05),
        'od_k_norm_g': 1.0 + nrm(ks[20], (N_ODD, HEAD_DIM), 0.05),
        'od_w_out': nrm(ks[21], (N_ODD, MIX_WIDTH, D_MODEL), MIX_WIDTH ** -0.5),
        'ffn_w_up': nrm(ks[22], (DEPTH, D_MODEL, 2 * D_FF), D_MODEL ** -0.5),
        'ffn_conv_w': nrm(ks[23], (DEPTH, CONV_W, 2 * D_FF), CONV_W ** -0.5),
        'ffn_conv_b': nrm(ks[24], (DEPTH, 2 * D_FF), 0.02),
        'ffn_w_down': nrm(ks[25], (DEPTH, D_FF, D_MODEL), D_FF ** -0.5),
        'final_norm_g': 1.0 + nrm(ks[26], (D_MODEL,), 0.05),
    }


def reference(x_prompt, x_sample, c, cache_na_k, cache_na_v, cache_gqa_k, cache_gqa_v, c_ctx,
              norm1_g, norm2_g, ada_w, ada_b,
              ev_w_in, ev_na_bias, ev_fnet_w, ev_w_out,
              od_w_in, od_pool_w, od_pool_scale, od_q_norm_g, od_k_norm_g, od_w_out,
              ffn_w_up, ffn_conv_w, ffn_conv_b, ffn_w_down, final_norm_g):
    xp = x_prompt
    xs = x_sample
    na_k_new, na_v_new, gqa_k_new, gqa_v_new = [], [], [], []
    for i in range(DEPTH):
        j = i // 2
        mc = ada_modulation(c_ctx[None, :], ada_w[i], ada_b[i])
        ms = ada_modulation(c, ada_w[i], ada_b[i])
        hp = modulate(xp, norm1_g[i], mc[:, 0], mc[:, 1])
        hs = modulate(xs, norm1_g[i], ms[:, 0], ms[:, 1])
        if i % 2 == 0:
            op, kp, vp = even_mixer_context(hp, ev_w_in[j], ev_fnet_w[j], ev_w_out[j])
            osm = even_mixer_latent(hs, cache_na_k[:, j], cache_na_v[:, j], ev_w_in[j],
                                    ev_na_bias[j], ev_fnet_w[j], ev_w_out[j])
            na_k_new.append(kp)
            na_v_new.append(vp)
        else:
            op, kp, vp = odd_mixer_context(hp, od_w_in[j], od_pool_w[j], od_pool_scale[j],
                                           od_q_norm_g[j], od_k_norm_g[j], od_w_out[j])
            osm = odd_mixer_latent(hs, cache_gqa_k[:, j], cache_gqa_v[:, j], od_w_in[j], od_pool_w[j],
                                   od_pool_scale[j], od_q_norm_g[j], od_k_norm_g[j], od_w_out[j])
            gqa_k_new.append(kp)
            gqa_v_new.append(vp)
        xp = xp + mc[:, 2] * op
        xs = xs + ms[:, 2] * osm
        xp = xp + mc[:, 5] * conv_ffn(modulate(xp, norm2_g[i], mc[:, 3], mc[:, 4]),
                                      ffn_w_up[i], ffn_conv_w[i], ffn_conv_b[i], ffn_w_down[i])
        xs = xs + ms[:, 5] * conv_ffn(modulate(xs, norm2_g[i], ms[:, 3], ms[:, 4]),
                                      ffn_w_up[i], ffn_conv_w[i], ffn_conv_b[i], ffn_w_down[i])
    y_prompt = rms_norm(xp, final_norm_g)
    y_sample = rms_norm(xs, final_norm_g)
    new_na_k = jnp.stack(na_k_new, axis=1)
    new_na_v = jnp.stack(na_v_new, axis=1)
    new_gqa_k = jnp.stack(gqa_k_new, axis=1)
    new_gqa_v = jnp.stack(gqa_v_new, axis=1)
    return (y_prompt, y_sample, new_na_k, new_na_v, new_gqa_k, new_gqa_v)
```

```cpp
#include <hip/hip_runtime.h>
#include <hip/hip_cooperative_groups.h>
#include <cstdio>
#include <cstdint>
namespace cg = cooperative_groups;

#ifndef PH_LIMIT
#define PH_LIMIT 19
#endif
#ifndef SKIP_PH
#define SKIP_PH 99
#endif
#ifndef DBG_L0
#define DBG_L0 0
#endif
#ifndef DBG_SRC0
#define DBG_SRC0 0
#endif
#ifndef REPMASK
#define REPMASK 0
#endif
#ifndef EXTRA_SYNCS
#define EXTRA_SYNCS 0
#endif
#ifndef AMASK
#define AMASK 7
#endif
#ifndef KMASK
#define KMASK 511
#endif
#ifndef N_LAUNCH_SPLIT
#define N_LAUNCH_SPLIT 0
#endif

typedef unsigned short bf16_t;
typedef short bf16x8 __attribute__((ext_vector_type(8)));
typedef short s16x4 __attribute__((ext_vector_type(4)));
typedef float f32x4 __attribute__((ext_vector_type(4)));
typedef float f32x16 __attribute__((ext_vector_type(16)));
typedef unsigned u32x4 __attribute__((ext_vector_type(4)));
typedef unsigned u32x2 __attribute__((ext_vector_type(2)));
#define LAS __attribute__((address_space(3)))

constexpr int DM = 2048, NP = 8192, NS = 16384, NTOK = 24576;
constexpr int EVN = 5632, ODN = 3072, FF = 5632, FF2 = 11264;
constexpr int NPH = 19;
constexpr int LDS_BYTES = 135168;

enum { I_XP = 0, I_XS, I_C, I_CNAK, I_CNAV, I_CGK, I_CGV, I_CCTX, I_N1G, I_N2G, I_ADAW, I_ADAB, I_EVWIN, I_EVBIAS, I_EVFNET, I_EVWOUT,
       I_ODWIN, I_ODPOOLW, I_ODPOOLS, I_ODQG, I_ODKG, I_ODWOUT, I_FFUP, I_FFCW, I_FFCB, I_FFDN, I_FING };
constexpr size_t O_Y = 0, O_NAK = 50331648, O_NAV = 62914560, O_GK = 75497472, O_GV = 79691776;
constexpr size_t al256(size_t x) { return (x + 255) / 256 * 256; }
constexpr size_t W_PART = 0;
constexpr size_t W_FOLDM = W_PART + al256((size_t)2 * 2 * 9 * 12288 * 4);
constexpr size_t W_ROPE = W_FOLDM + al256((size_t)4 * 128 * 256 * 4);
constexpr size_t W_EVOUT = W_ROPE + al256((size_t)64 * 32 * 2 * 4);
constexpr size_t W_ODIN = W_EVOUT + (size_t)DM * DM * 2;
constexpr size_t W_ODOUT = W_ODIN + (size_t)ODN * DM * 2;
constexpr size_t W_UP = W_ODOUT + (size_t)DM * DM * 2;
constexpr size_t W_CGK = W_UP + (size_t)2 * FF2 * DM * 2;
constexpr size_t W_CGV = W_CGK + (size_t)8 * 256 * 512 * 2;
constexpr size_t W_EVIN = W_CGV + (size_t)8 * 256 * 512 * 2;
constexpr size_t W_XB = W_EVIN;
constexpr size_t W_DFTS = W_EVIN + (size_t)EVN * DM * 2;
constexpr size_t W_DFTC = W_DFTS + (size_t)2048 * 4096 * 2;
constexpr size_t W_CNAK = W_DFTC + (size_t)256 * 512 * 2;
constexpr size_t W_CNAV = W_CNAK + (size_t)8 * 256 * 1536 * 2;
constexpr size_t W_YTS = W_CNAV + (size_t)8 * 256 * 1536 * 2;
constexpr size_t W_YTC = W_YTS + (size_t)4096 * 4096 * 2;
static_assert(W_YTC + (size_t)16384 * 512 * 2 - W_XB >= (size_t)NTOK * DM * 2, "XB alias region too small");
constexpr size_t W_ACT = W_YTC + (size_t)16384 * 512 * 2;
constexpr size_t W_BIG = W_ACT + (size_t)NTOK * DM * 2;
constexpr size_t W_UB = W_BIG + (size_t)NTOK * EVN * 2;
constexpr size_t W_DN = W_UB + (size_t)384 * 4 * FF2 * 4;
constexpr size_t W_BAR = W_DN + (size_t)2 * DM * FF * 2;
constexpr size_t W_END = W_BAR + 16384;

struct Params { const float* in[27]; float* out; unsigned char* ws; int ph_lo, ph_hi; };

__device__ __forceinline__ unsigned cvtpk(float lo, float hi) { unsigned r; asm volatile("v_cvt_pk_bf16_f32 %0, %1, %2" : "=v"(r) : "v"(lo), "v"(hi)); return r; }
__device__ __forceinline__ float bf2f(bf16_t b) { return __uint_as_float(((unsigned)b) << 16); }
__device__ __forceinline__ float bflo(unsigned w) { return __uint_as_float(w << 16); }
__device__ __forceinline__ float bfhi(unsigned w) { return __uint_as_float(w & 0xffff0000u); }
__device__ __forceinline__ float wave_sum(float v) {
#pragma unroll
  for (int o = 32; o > 0; o >>= 1) v += __shfl_xor(v, o);
  return v;
}
__device__ __forceinline__ int tid_opaque() { int t = threadIdx.x; asm volatile("" : "+v"(t)); return t; }
__device__ __forceinline__ float silu_f(float x) { return x / (1.f + __expf(-x)); }
__device__ __forceinline__ float silu_fast(float x) { return x * __builtin_amdgcn_rcpf(1.f + __builtin_amdgcn_exp2f(x * -1.4426950408889634f)); }
__device__ __forceinline__ f32x4 modv4(const float* part, int l, int bidx, int k, int col) {
  const float* p0 = part + ((size_t)(l * 2 + 0) * 9 + bidx) * 12288 + k * 2048 + col;
  const float* p1 = part + ((size_t)(l * 2 + 1) * 9 + bidx) * 12288 + k * 2048 + col;
  return *(const f32x4*)p0 + *(const f32x4*)p1;
}

namespace pg8 {
constexpr int BM = 256, BK = 64, HALF = 128, HTB = HALF * BK * 2, STAGE_BYTES = 8 * HTB, NXCD = 8, WGM = 8;
__host__ __device__ __forceinline__ int lds_byte(int r, int c) { const int st = (r >> 4) * 2 + (c >> 5), rr = r & 15, cc = c & 31, ob = rr * 64 + cc * 2; return st * 1024 + (ob ^ (((ob >> 9) & 1) << 5)); }
__host__ __device__ __forceinline__ void stage_rc(int b, int& R, int& C) { const int st = b / 1024, sb = b % 1024, swz = sb ^ (((sb >> 9) & 1) << 5); R = (st >> 1) * 16 + swz / 64; C = (st & 1) * 32 + (swz % 64) / 2; }
__host__ __device__ __forceinline__ int perm32(int rho) { const int n = rho >> 4, i = rho & 15; return 8 * (i >> 2) + 4 * n + (i & 3); }
struct Unit { int pm, pn; };
struct Gemm { const bf16_t* A; const bf16_t* Bt; int M, N, K; };
struct StaticOrder {
  int nM, nN, nwg, G, c;
  __device__ void init(int M, int N, int G_, int c_) { nM = M / BM; nN = N / BM; nwg = nM * nN; G = G_; c = c_; }
  __device__ bool next(int i, Unit& u) const {
    const long L = (long)i * G + c; if (L >= nwg) return false;
    int wgid = (int)L; { const int q = nwg / NXCD, r = nwg % NXCD, xcd = wgid % NXCD, off = wgid / NXCD; wgid = (xcd < r ? xcd * (q + 1) : r * (q + 1) + (xcd - r) * q) + off; }
    const int nig = WGM * nN, gid = wgid / nig, fm = gid * WGM, gsz = (nM - fm) < WGM ? (nM - fm) : WGM;
    u.pm = fm + ((wgid % nig) % gsz); u.pn = (wgid % nig) / gsz; return true;
  }
};

template <class Epi>
__device__ __forceinline__ void gemm_phase(LAS unsigned char* lds, const Gemm g, const StaticOrder& S, const Epi& E) {
  const int tid = tid_opaque(), wid = __builtin_amdgcn_readfirstlane(tid >> 6), lane = tid & 63, wr = wid >> 2, wc = wid & 3, fr = lane & 15, fq = lane >> 4;
  const int K = g.K, nt = K / BK;
  unsigned voffA[2], voffB[2];
#pragma unroll
  for (int i = 0; i < 2; ++i) { int R, C; stage_rc(tid * 16 + i * 8192, R, C); const int Rb = Epi::PERM ? ((R & ~31) + perm32(R & 31)) : R;
    const int Ra = Epi::APERM ? ((R & ~63) + 4 * (R & 15) + ((R >> 4) & 3)) : R;
    voffA[i] = (unsigned)(Ra * K + C) * 2u; voffB[i] = (unsigned)(Rb * K + C) * 2u; }
  const size_t kstep = (size_t)(BK * 2);
  const size_t hstep = (size_t)HALF * K * 2;
  const size_t tstep = 2 * hstep;
  const unsigned ldsw = (unsigned)wid * 1024u;
  const int aoff = lds_byte(wr * 64 + fr, fq * 8), boff = lds_byte(wc * 32 + fr, fq * 8);
#define PG8_SA(b, h) (((b) * 2 + (h)) * HTB)
#define PG8_SB(b, h) ((4 + (b) * 2 + (h)) * HTB)
#define PG8_STAGE(bufoff, gbase, voff) do { _Pragma("unroll") for (int _i = 0; _i < 2; ++_i) \
    __builtin_amdgcn_global_load_lds((const unsigned*)((const char*)(gbase) + (voff)[_i]), (LAS unsigned*)(lds + (bufoff) + ldsw + _i * 8192), 16, 0, 0); } while (0)
#define PG8_LDA(dst, b, h) do { _Pragma("unroll") for (int m = 0; m < 4; ++m) _Pragma("unroll") for (int k = 0; k < 2; ++k) dst[m][k] = *(const LAS bf16x8*)(lds + PG8_SA(b, h) + aoff + m * 2048 + k * 1024); } while (0)
#define PG8_LDB(dst, b, h) do { _Pragma("unroll") for (int n = 0; n < 2; ++n) _Pragma("unroll") for (int k = 0; k < 2; ++k) dst[n][k] = *(const LAS bf16x8*)(lds + PG8_SB(b, h) + boff + n * 2048 + k * 1024); } while (0)
#define PG8_MMA(ai, bj, At, Bt) do { __builtin_amdgcn_s_setprio(1); _Pragma("unroll") for (int m = 0; m < 4; ++m) _Pragma("unroll") for (int n = 0; n < 2; ++n) _Pragma("unroll") for (int k = 0; k < 2; ++k) \
    acc[ai][bj][m][n] = __builtin_amdgcn_mfma_f32_16x16x32_bf16(Bt[n][k], At[m][k], acc[ai][bj][m][n], 0, 0, 0); __builtin_amdgcn_s_setprio(0); } while (0)
#define PG8_WAIT_V(n) asm volatile("s_waitcnt vmcnt(" #n ")" ::: "memory")
#define PG8_WAIT_L(n) asm volatile("s_waitcnt lgkmcnt(" #n ")" ::: "memory")
#define PG8_BAR __builtin_amdgcn_s_barrier()
#define PG8_SCHED __builtin_amdgcn_sched_barrier(0)
  Unit cur, nxt; int ui = 0;
  if (!S.next(0, cur)) return;
  f32x4 acc[2][2][4][2];
#pragma unroll
  for (int a = 0; a < 2; ++a)
#pragma unroll
    for (int b = 0; b < 2; ++b)
#pragma unroll
      for (int m = 0; m < 4; ++m)
#pragma unroll
        for (int n = 0; n < 2; ++n) acc[a][b][m][n] = (f32x4){0.f, 0.f, 0.f, 0.f};
  bf16x8 At[4][2], B0[2][2], B1[2][2];
  const char* cA = (const char*)g.A + (size_t)cur.pm * tstep; const char* cB = (const char*)g.Bt + (size_t)cur.pn * tstep;
  PG8_STAGE(PG8_SB(0, 0), cB, voffB); PG8_STAGE(PG8_SA(0, 0), cA, voffA); PG8_STAGE(PG8_SB(0, 1), cB + hstep, voffB); PG8_STAGE(PG8_SA(0, 1), cA + hstep, voffA);
  if (wr == 1) PG8_BAR;
  PG8_WAIT_V(4); PG8_BAR;
  PG8_STAGE(PG8_SB(1, 0), cB + kstep, voffB); PG8_STAGE(PG8_SA(1, 0), cA + kstep, voffA); PG8_STAGE(PG8_SB(1, 1), cB + hstep + kstep, voffB);
  PG8_WAIT_V(6); PG8_BAR;
  for (;;) {
    const bool has_next = S.next(ui + 1, nxt);
    const char* nA = has_next ? (const char*)g.A + (size_t)nxt.pm * tstep : cA; const char* nB = has_next ? (const char*)g.Bt + (size_t)nxt.pn * tstep : cB;
    for (int t = 0; t < nt; t += 2) {
      const bool last = (t == nt - 2);
      const char* a1 = cA + (size_t)(t + 1) * kstep;
      const char* a2 = last ? nA : cA + (size_t)(t + 2) * kstep; const char* b2 = last ? nB : cB + (size_t)(t + 2) * kstep;
      const char* a3 = a2 + kstep; const char* b3 = b2 + kstep;
      PG8_LDB(B0, 0, 0); PG8_SCHED; PG8_LDA(At, 0, 0); PG8_STAGE(PG8_SA(1, 1), a1 + hstep, voffA);
      PG8_WAIT_L(8); PG8_BAR; PG8_WAIT_L(0); PG8_MMA(0, 0, At, B0); PG8_BAR; PG8_SCHED;
      PG8_LDB(B1, 0, 1); PG8_STAGE(PG8_SB(0, 0), b2, voffB);
      PG8_BAR; PG8_WAIT_L(0); PG8_MMA(0, 1, At, B1); PG8_BAR;
      PG8_LDA(At, 0, 1); PG8_STAGE(PG8_SA(0, 0), a2, voffA);
      PG8_BAR; PG8_WAIT_L(0); PG8_MMA(1, 0, At, B0); PG8_BAR; PG8_SCHED;
      PG8_STAGE(PG8_SB(0, 1), b2 + hstep, voffB);
      PG8_WAIT_V(6); PG8_BAR; PG8_MMA(1, 1, At, B1); PG8_BAR;
      PG8_LDB(B0, 1, 0); PG8_SCHED; PG8_LDA(At, 1, 0); PG8_STAGE(PG8_SA(0, 1), a2 + hstep, voffA);
      PG8_WAIT_L(8); PG8_BAR; PG8_WAIT_L(0); PG8_MMA(0, 0, At, B0); PG8_BAR; PG8_SCHED;
      PG8_LDB(B1, 1, 1); PG8_STAGE(PG8_SB(1, 0), b3, voffB);
      PG8_BAR; PG8_WAIT_L(0); PG8_MMA(0, 1, At, B1); PG8_BAR;
      PG8_LDA(At, 1, 1); PG8_STAGE(PG8_SA(1, 0), a3, voffA);
      PG8_BAR; PG8_WAIT_L(0); PG8_MMA(1, 0, At, B0); PG8_BAR; PG8_SCHED;
      PG8_STAGE(PG8_SB(1, 1), b3 + hstep, voffB);
      PG8_WAIT_V(6); PG8_BAR; PG8_MMA(1, 1, At, B1); PG8_BAR;
    }
    E(acc, cur, wr, wc, fr, fq);
    if (!has_next) break;
#pragma unroll
    for (int a = 0; a < 2; ++a)
#pragma unroll
      for (int b = 0; b < 2; ++b)
#pragma unroll
        for (int m = 0; m < 4; ++m)
#pragma unroll
          for (int n = 0; n < 2; ++n) acc[a][b][m][n] = (f32x4){0.f, 0.f, 0.f, 0.f};
    cur = nxt; cA = nA; cB = nB; ++ui;
  }
  PG8_WAIT_V(0);
  if (wr == 0) PG8_BAR;
  PG8_BAR;
#undef PG8_SA
#undef PG8_SB
#undef PG8_STAGE
#undef PG8_LDA
#undef PG8_LDB
#undef PG8_MMA
#undef PG8_WAIT_V
#undef PG8_WAIT_L
#undef PG8_BAR
#undef PG8_SCHED
}
}
using pg8::Unit;
typedef f32x4 AccT[2][2][4][2];

struct EpiIn {
  static constexpr bool PERM = true; static constexpr bool APERM = false;
  bf16_t* O; int ldc; int even; float* out; bf16_t* yts; bf16_t* ytc;
  __device__ __forceinline__ void operator()(const AccT& acc, const Unit& u, int wr, int wc, int fr, int fq) const {
    const int row0 = u.pm * 256 + wr * 64 + fr;
    if (even && u.pn >= 18) {
      const int g = u.pn - 18;
      bf16_t* base; size_t rs; int half, pos0;
      if (u.pm < 32) { base = ytc + (size_t)((u.pm * 4 + g) * 128) * 512; rs = 512; half = 256; pos0 = wr * 64 + fr; }
      else { const int b = (u.pm - 32) >> 3; base = yts + (size_t)((b * 4 + g) * 128) * 4096; rs = 4096; half = 2048; pos0 = ((u.pm - 32) & 7) * 256 + wr * 64 + fr; }
#pragma unroll
      for (int ai = 0; ai < 2; ++ai)
#pragma unroll
        for (int m = 0; m < 4; ++m) { const int pos = pos0 + ai * 128 + m * 16;
#pragma unroll
          for (int bj = 0; bj < 2; ++bj)
#pragma unroll
            for (int n = 0; n < 2; ++n)
#pragma unroll
              for (int j = 0; j < 4; ++j) { const int d = wc * 32 + 8 * fq + 4 * n + j;
                base[(size_t)d * rs + bj * half + pos] = (bf16_t)(cvtpk(acc[ai][bj][m][n][j], 0.f) & 0xffffu); } }
      return;
    }
    const int col0 = u.pn * 256 + wc * 32 + 8 * fq;
    float* side = nullptr; int sld = 0;
    if (u.pm < 32) {
      if (even) { if (u.pn >= 6 && u.pn < 12) { side = out + O_NAK + (col0 - 1536); sld = 1536; } else if (u.pn >= 12) { side = out + O_NAV + (col0 - 3072); sld = 1536; } }
      else if (u.pn >= 10) { side = out + O_GV + (col0 - 2560); sld = 512; }
    }
#pragma unroll
    for (int ai = 0; ai < 2; ++ai)
#pragma unroll
      for (int m = 0; m < 4; ++m) { const int row = row0 + ai * 128 + m * 16; bf16_t* rowp = O + (size_t)row * ldc + col0;
#pragma unroll
        for (int bj = 0; bj < 2; ++bj) { const f32x4 v0 = acc[ai][bj][m][0], v1 = acc[ai][bj][m][1];
          u32x4 w = {cvtpk(v0[0], v0[1]), cvtpk(v0[2], v0[3]), cvtpk(v1[0], v1[1]), cvtpk(v1[2], v1[3])};
          *(u32x4*)(rowp + bj * 128) = w;
          if (side) { float* sp = side + (size_t)row * sld + bj * 128; *(f32x4*)sp = v0; *(f32x4*)(sp + 4) = v1; } } }
  }
};
struct EpiRes {
  static constexpr bool PERM = true; static constexpr bool APERM = false;
  const float* xp; const float* xs; bf16_t* xb; bf16_t* xo; const float* part; int layer, gk; int from_in;
  __device__ __forceinline__ void operator()(const AccT& acc, const Unit& u, int wr, int wc, int fr, int fq) const {
    const int bidx = u.pm < 32 ? 8 : ((u.pm - 32) >> 3);
    const int row0 = u.pm * 256 + wr * 64 + fr, col0 = u.pn * 256 + wc * 32 + 8 * fq;
    const float* xin = u.pm < 32 ? xp : (xs - (size_t)NP * DM);
    f32x4 gv[2][2];
#pragma unroll
    for (int bj = 0; bj < 2; ++bj)
#pragma unroll
      for (int n = 0; n < 2; ++n) gv[bj][n] = modv4(part, layer, bidx, gk, col0 + bj * 128 + n * 4);
#pragma unroll
    for (int ai = 0; ai < 2; ++ai)
#pragma unroll
      for (int m = 0; m < 4; ++m) { const size_t ro = (size_t)(row0 + ai * 128 + m * 16) * DM + col0;
#pragma unroll
        for (int bj = 0; bj < 2; ++bj) { f32x4 x0, x1;
          if (from_in) { x0 = *(const f32x4*)(xin + ro + bj * 128); x1 = *(const f32x4*)(xin + ro + bj * 128 + 4); }
          else { const u32x4 w = *(const u32x4*)(xb + ro + bj * 128); x0 = (f32x4){bflo(w[0]), bfhi(w[0]), bflo(w[1]), bfhi(w[1])}; x1 = (f32x4){bflo(w[2]), bfhi(w[2]), bflo(w[3]), bfhi(w[3])}; }
          x0 = x0 + gv[bj][0] * acc[ai][bj][m][0]; x1 = x1 + gv[bj][1] * acc[ai][bj][m][1];
          u32x4 o = {cvtpk(x0[0], x0[1]), cvtpk(x0[2], x0[3]), cvtpk(x1[0], x1[1]), cvtpk(x1[2], x1[3])};
          *(u32x4*)(xo + ro + bj * 128) = o; } }
  }
};
__device__ __forceinline__ float dpp_ror1(float v) { return __builtin_bit_cast(float, __builtin_amdgcn_update_dpp(0, __builtin_bit_cast(int, v), 0x121, 0xf, 0xf, false)); }
__device__ __forceinline__ float dpp_rol1(float v) { return __builtin_bit_cast(float, __builtin_amdgcn_update_dpp(0, __builtin_bit_cast(int, v), 0x12F, 0xf, 0xf, false)); }
struct EpiUp {
  static constexpr bool PERM = true; static constexpr bool APERM = true;
  bf16_t* G; float* UB; const float* cw; const float* cb;
  __device__ __forceinline__ void operator()(const AccT& acc, const Unit& u, int wr, int wc, int fr, int fq) const {
    const int cc0 = wc * 32 + 8 * fq;
    const int chv = u.pn * 128 + cc0;
    f32x4 cwa[2][8];
#pragma unroll
    for (int n = 0; n < 2; ++n) { const int ch = chv + 4 * n;
      cwa[n][0] = *(const f32x4*)(cw + ch); cwa[n][1] = *(const f32x4*)(cw + FF2 + ch); cwa[n][2] = *(const f32x4*)(cw + 2 * FF2 + ch); cwa[n][3] = *(const f32x4*)(cb + ch);
      cwa[n][4] = *(const f32x4*)(cw + FF + ch); cwa[n][5] = *(const f32x4*)(cw + FF2 + FF + ch); cwa[n][6] = *(const f32x4*)(cw + 2 * FF2 + FF + ch); cwa[n][7] = *(const f32x4*)(cb + FF + ch); }
#pragma unroll
    for (int n = 0; n < 2; ++n) {
      const f32x4* cwv[1] = {cwa[n]};
      const f32x4 v0 = cwv[0][0] * -0.6931471805599453f, v1 = cwv[0][1] * -0.6931471805599453f, v2 = cwv[0][2] * -0.6931471805599453f, vb = cwv[0][3] * -0.6931471805599453f;
      const f32x4 g0 = cwv[0][4] * -1.4426950408889634f, g1 = cwv[0][5] * -1.4426950408889634f, g2 = cwv[0][6] * -1.4426950408889634f, gb = cwv[0][7] * -1.4426950408889634f;
#pragma unroll
      for (int ai = 0; ai < 2; ++ai) {
        const int chunk = u.pm * 4 + ai * 2 + wr;
        f32x4 o[4];
        {
          const f32x4 a0 = acc[ai][0][0][n], a1 = acc[ai][0][1][n], a2 = acc[ai][0][2][n], a3 = acc[ai][0][3][n];
          const f32x4 b0 = acc[ai][1][0][n], b1 = acc[ai][1][1][n], b2 = acc[ai][1][2][n], b3 = acc[ai][1][3][n];
          f32x4 au, ad, bu, bd;
#pragma unroll
          for (int j = 0; j < 4; ++j) { au[j] = dpp_ror1(a3[j]); ad[j] = dpp_rol1(a0[j]); bu[j] = dpp_ror1(b3[j]); bd[j] = dpp_rol1(b0[j]); }
          f32x4 vv[4], gg[4];
          vv[0] = v0 * au + v1 * a0 + v2 * a1 + vb; vv[1] = v0 * a0 + v1 * a1 + v2 * a2 + vb; vv[2] = v0 * a1 + v1 * a2 + v2 * a3 + vb; vv[3] = v0 * a2 + v1 * a3 + v2 * ad + vb;
          gg[0] = g0 * bu + g1 * b0 + g2 * b1 + gb; gg[1] = g0 * b0 + g1 * b1 + g2 * b2 + gb; gg[2] = g0 * b1 + g1 * b2 + g2 * b3 + gb; gg[3] = g0 * b2 + g1 * b3 + g2 * bd + gb;
#pragma unroll
          for (int m = 0; m < 4; ++m) { f32x4 e, r;
#pragma unroll
            for (int j = 0; j < 4; ++j) e[j] = __builtin_amdgcn_exp2f(gg[m][j]);
            e = e + 1.f;
#pragma unroll
            for (int j = 0; j < 4; ++j) r[j] = __builtin_amdgcn_rcpf(e[j]);
            o[m] = (vv[m] * gg[m]) * r; }
        }
#pragma unroll
        for (int m = 0; m < 4; ++m) { const bool skip = (m == 0 && fr == 0) || (m == 3 && fr == 15);
          if (!skip) { u32x2 w2 = {cvtpk(o[m][0], o[m][1]), cvtpk(o[m][2], o[m][3])}; *(u32x2*)(G + (size_t)(chunk * 64 + 4 * fr + m) * FF + chv + 4 * n) = w2; } }
        if (fr == 0 || fr == 15) {
          float* ub = UB + ((size_t)chunk * 4 + (fr ? 2 : 0)) * FF2 + u.pn * 256 + cc0 + 4 * n;
          if (fr == 0) { *(f32x4*)ub = acc[ai][0][0][n]; *(f32x4*)(ub + 128) = acc[ai][1][0][n]; *(f32x4*)(ub + FF2) = acc[ai][0][1][n]; *(f32x4*)(ub + FF2 + 128) = acc[ai][1][1][n]; }
          else { *(f32x4*)ub = acc[ai][0][2][n]; *(f32x4*)(ub + 128) = acc[ai][1][2][n]; *(f32x4*)(ub + FF2) = acc[ai][0][3][n]; *(f32x4*)(ub + FF2 + 128) = acc[ai][1][3][n]; }
        }
      }
    }
  }
};
struct EpiFourier {
  static constexpr bool PERM = true; static constexpr bool APERM = false;
  bf16_t* mix; int rowbase, npos; float scale;
  __device__ __forceinline__ void operator()(const AccT& acc, const Unit& u, int wr, int wc, int fr, int fq) const {
    const int pos0 = u.pm * 256 + wr * 64 + fr;
#pragma unroll
    for (int bj = 0; bj < 2; ++bj) {
      const int col = u.pn * 256 + bj * 128 + wc * 32 + 8 * fq; const int b = col >> 9, gd = col & 511;
      bf16_t* basep = mix + (size_t)(rowbase + b * npos) * DM + 1536 + gd;
#pragma unroll
      for (int ai = 0; ai < 2; ++ai)
#pragma unroll
        for (int m = 0; m < 4; ++m) { const f32x4 v0 = acc[ai][bj][m][0] * scale, v1 = acc[ai][bj][m][1] * scale;
          u32x4 w = {cvtpk(v0[0], v0[1]), cvtpk(v0[2], v0[3]), cvtpk(v1[0], v1[1]), cvtpk(v1[2], v1[3])};
          *(u32x4*)(basep + (size_t)(pos0 + ai * 128 + m * 16) * DM) = w; }
    }
  }
};

namespace at {
constexpr int D = 128, NW = 8, QBLK = 32, KVBLK = 64;
constexpr float SCALE = 0.088388347648318440f;
constexpr float THR = 8.f;
constexpr size_t SHM_V = KVBLK * D * 2, SHM_K = KVBLK * D * 2, SHM_ATTN = 2 * SHM_V + 2 * SHM_K + NW * 64 * 4;
#define KSWZ(row, colB) ((row) * 256 + ((colB) ^ (((row) & 7) << 4)))
#define SBAR() __builtin_amdgcn_sched_barrier(0)
__device__ __forceinline__ int crow(int r, int hi) { return (r & 3) + 8 * (r >> 2) + 4 * hi; }
__device__ __forceinline__ void partialSM(f32x16& p0, f32x16& p1, float& m_reg, float& mn, float& alpha) {
  constexpr float C = SCALE * 1.4426950408889634f;
  float pmax = p0[0];
#pragma unroll
  for (int r = 1; r < 16; ++r) pmax = fmaxf(pmax, p0[r]);
#pragma unroll
  for (int r = 0; r < 16; ++r) pmax = fmaxf(pmax, p1[r]);
  { auto rr = __builtin_amdgcn_permlane32_swap(__float_as_uint(pmax), __float_as_uint(pmax), false, false);
    pmax = fmaxf(__uint_as_float(rr[0]), __uint_as_float(rr[1])); }
  if (__builtin_expect(__all(pmax - m_reg <= THR / SCALE), 1)) { mn = m_reg; alpha = 1.f; }
  else { mn = fmaxf(m_reg, pmax); alpha = __builtin_amdgcn_exp2f((m_reg - mn) * C); m_reg = mn; }
  float mnC = -mn * C;
  p0 = p0 * C + mnC; p1 = p1 * C + mnC;
#pragma unroll
  for (int r = 0; r < 16; ++r) p0[r] = __builtin_amdgcn_exp2f(p0[r]);
}
__device__ __forceinline__ void finishSM(f32x16& p0, f32x16& p1, float alpha, float& l_reg, bf16x8& pa0, bf16x8& pa1, bf16x8& pa2, bf16x8& pa3) {
#pragma unroll
  for (int r = 0; r < 16; ++r) p1[r] = __builtin_amdgcn_exp2f(p1[r]);
  float ps;
  { typedef float f32x8 __attribute__((ext_vector_type(8))); typedef float f32x2v __attribute__((ext_vector_type(2)));
    const f32x16 s16 = p0 + p1; const f32x8 s8 = s16.lo + s16.hi; const f32x4 s4 = s8.lo + s8.hi; const f32x2v s2 = s4.lo + s4.hi; ps = s2.x + s2.y; }
  { auto rr = __builtin_amdgcn_permlane32_swap(__float_as_uint(ps), __float_as_uint(ps), false, false);
    ps = __uint_as_float(rr[0]) + __uint_as_float(rr[1]); }
  l_reg = l_reg * alpha + ps;
#define PK4(P, BASE, OUT) do { unsigned a0 = cvtpk(P[BASE + 0], P[BASE + 1]), a1 = cvtpk(P[BASE + 2], P[BASE + 3]);   \
    unsigned b0 = cvtpk(P[BASE + 4], P[BASE + 5]), b1 = cvtpk(P[BASE + 6], P[BASE + 7]);                              \
    auto r0 = __builtin_amdgcn_permlane32_swap(a0, b0, false, false); auto r1 = __builtin_amdgcn_permlane32_swap(a1, b1, false, false); \
    u32x4 w = {r0[0], r1[0], r0[1], r1[1]}; OUT = *reinterpret_cast<bf16x8*>(&w); } while (0)
  PK4(p0, 0, pa0); PK4(p0, 8, pa1); PK4(p1, 0, pa2); PK4(p1, 8, pa3);
#undef PK4
}
__device__ __forceinline__ void qkt(f32x16& p0, f32x16& p1, const char* Ks, const bf16x8* qr, int r32, int hi) {
  p0 = f32x16{}; p1 = f32x16{};
#pragma unroll
  for (int d0 = 0; d0 < 8; ++d0) { int cb = (d0 * 16 + hi * 8) * 2;
    bf16x8 b0 = *reinterpret_cast<const bf16x8*>(Ks + KSWZ(r32, cb));
    bf16x8 b1 = *reinterpret_cast<const bf16x8*>(Ks + KSWZ(32 + r32, cb));
    p0 = __builtin_amdgcn_mfma_f32_32x32x16_bf16(b0, qr[d0], p0, 0, 0, 0);
    p1 = __builtin_amdgcn_mfma_f32_32x32x16_bf16(b1, qr[d0], p1, 0, 0, 0); }
}
__device__ __forceinline__ int v_st(int k, int c) { const int kk = (k & ~0xC) | ((k & 4) << 1) | ((k & 8) >> 1); return ((kk >> 3) * 4 + (c >> 5)) * 512 + ((kk & 7) * 32 + (c & 31)) * 2; }
__device__ __forceinline__ int v_rd_base(int lane) { return ((lane & 3) << 3) | (((lane >> 2) & 3) << 6) | (((lane >> 4) & 1) << 5) | (((lane >> 5) & 1) << 8); }
constexpr int v_rd_off(int d0, int ks, int half) { return d0 * 512 + ks * 4096 + half * 2048; }
template <int OFF> __device__ __forceinline__ s16x4 tr_read(int vb) {
  s16x4 r; asm volatile("ds_read_b64_tr_b16 %0, %1 offset:%2" : "=&v"(r) : "v"(vb), "i"(OFF) : "memory"); return r;
}
template <int D0> __device__ __forceinline__ void pv_one(f32x16& od, int vb, bf16x8 pa0, bf16x8 pa1, bf16x8 pa2, bf16x8 pa3) {
  const s16x4 l0 = tr_read<v_rd_off(D0, 0, 0)>(vb), h0 = tr_read<v_rd_off(D0, 0, 1)>(vb), l1 = tr_read<v_rd_off(D0, 1, 0)>(vb), h1 = tr_read<v_rd_off(D0, 1, 1)>(vb);
  const s16x4 l2 = tr_read<v_rd_off(D0, 2, 0)>(vb), h2 = tr_read<v_rd_off(D0, 2, 1)>(vb), l3 = tr_read<v_rd_off(D0, 3, 0)>(vb), h3 = tr_read<v_rd_off(D0, 3, 1)>(vb);
  asm volatile("s_waitcnt lgkmcnt(0)" ::: "memory"); SBAR();
#define PK(L, H) (bf16x8){L[0], L[1], L[2], L[3], H[0], H[1], H[2], H[3]}
  od = __builtin_amdgcn_mfma_f32_32x32x16_bf16(pa0, PK(l0, h0), od, 0, 0, 0);
  od = __builtin_amdgcn_mfma_f32_32x32x16_bf16(pa1, PK(l1, h1), od, 0, 0, 0);
  od = __builtin_amdgcn_mfma_f32_32x32x16_bf16(pa2, PK(l2, h2), od, 0, 0, 0);
  od = __builtin_amdgcn_mfma_f32_32x32x16_bf16(pa3, PK(l3, h3), od, 0, 0, 0);
#undef PK
}
__device__ __forceinline__ void pv_d0(f32x16* o, int vb, bf16x8 pa0, bf16x8 pa1, bf16x8 pa2, bf16x8 pa3) {
  pv_one<0>(o[0], vb, pa0, pa1, pa2, pa3); pv_one<1>(o[1], vb, pa0, pa1, pa2, pa3); pv_one<2>(o[2], vb, pa0, pa1, pa2, pa3); pv_one<3>(o[3], vb, pa0, pa1, pa2, pa3);
}
struct Desc {
  const bf16_t* Q; int ldq;
  const bf16_t* K0; const bf16_t* V0; int ld0, n0;
  const bf16_t* K1; const bf16_t* V1; int ld1;
  int seq;
  bf16_t* O; int ldo;
  int ks, qrow0;
};
template <int MODE> __device__ __forceinline__ void na_mask(f32x16& p0, f32x16& p1, int t, const Desc& d, int wid, int r32, int hi, const float* btab) {
  if constexpr (MODE == 1) {
    if (t >= 4) {
      const int kr = d.ks + t - 4, qrow = d.qrow0 + (wid >> 1), qc = (wid & 1) * 32 + r32;
      const int r0q = min(max(qrow - 4, 0), 24);
      const bool rowok = (kr >= r0q) && (kr < r0q + 8);
      if (rowok) {
        const int qs = min(max(qc - 8, 0), 48);
        const float* brow = btab + (kr - qrow + 7) * 31 + (15 - qc + 4 * hi);
        const int kb = 4 * hi - qs;
#pragma unroll
        for (int rg = 0; rg < 4; ++rg) {
#pragma unroll
          for (int r = rg * 4; r < rg * 4 + 4; ++r) {
            const int kc = (r & 3) + 8 * (r >> 2);
            const bool ok0 = ((unsigned)(kc + kb) < 16u);
            const float b0 = brow[kc];
            p0[r] = ok0 ? p0[r] + b0 : -1e30f;
          }
          SBAR();
        }
#pragma unroll
        for (int rg = 0; rg < 4; ++rg) {
#pragma unroll
          for (int r = rg * 4; r < rg * 4 + 4; ++r) {
            const int kc = (r & 3) + 8 * (r >> 2);
            const bool ok1 = ((unsigned)(kc + 32 + kb) < 16u);
            const float b1 = brow[kc + 32];
            p1[r] = ok1 ? p1[r] + b1 : -1e30f;
          }
          SBAR();
        }
      } else {
#pragma unroll
        for (int r = 0; r < 16; ++r) { p0[r] = -1e30f; p1[r] = -1e30f; }
      }
    }
  }
}
template <int MODE>
__device__ __forceinline__ void attn_body(const Desc& d, char* lds) {
  const int tid = tid_opaque(), wid = tid >> 6, lane = tid & 63, r32 = lane & 31, hi = lane >> 5;
  char* V_lds = lds; char* K_lds = lds + 2 * SHM_V;
  float* ws = (float*)(lds + 2 * SHM_V + 2 * SHM_K) + wid * 64; float* li_l = ws; float* al_l = ws + 32;
  const float* btab = (const float*)(lds + SHM_ATTN) + 64;
  float m_reg = -1e30f, l_reg = 0; f32x16 o[4] = {}; bf16x8 qr[8];
  const bf16_t* Qw = d.Q + (long)(wid * QBLK + r32) * d.ldq + hi * 8;
#pragma unroll
  for (int d0 = 0; d0 < 8; ++d0) qr[d0] = *reinterpret_cast<const bf16x8*>(Qw + d0 * 16);
  const int sr = tid >> 4, sc = (tid & 15) * 8, vst0 = v_st(sr, sc), vst1 = v_st(32 + sr, sc);
  const int vb0 = (int)(uintptr_t)V_lds + v_rd_base(lane);
  constexpr int SDEPTH = (MODE == 1) ? 1 : 2;
  struct { bf16x8 vs0, vs1, ks0, ks1; } sr_[SDEPTH];
  const unsigned vo0a = (unsigned)(sr * d.ld0 + sc) * 2u, vo0b = (unsigned)((sr + 32) * d.ld0 + sc) * 2u, vo1a = (unsigned)(sr * d.ld1 + sc) * 2u, vo1b = (unsigned)((sr + 32) * d.ld1 + sc) * 2u;
#define SLOAD(i, k0) do { const bool s0_ = (k0) < d.n0; \
    const char* kb_ = s0_ ? (const char*)d.K0 + (size_t)(k0) * d.ld0 * 2 : (const char*)d.K1 + (size_t)((k0) - d.n0) * d.ld1 * 2; \
    const char* vb_ = s0_ ? (const char*)d.V0 + (size_t)(k0) * d.ld0 * 2 : (const char*)d.V1 + (size_t)((k0) - d.n0) * d.ld1 * 2; \
    const unsigned oa_ = s0_ ? vo0a : vo1a, ob_ = s0_ ? vo0b : vo1b; \
    sr_[i].vs0 = *reinterpret_cast<const bf16x8*>(vb_ + oa_); sr_[i].vs1 = *reinterpret_cast<const bf16x8*>(vb_ + ob_); \
    sr_[i].ks0 = *reinterpret_cast<const bf16x8*>(kb_ + oa_); sr_[i].ks1 = *reinterpret_cast<const bf16x8*>(kb_ + ob_); } while (0)
#define SWRITE(b, i) do { *(bf16x8*)(V_lds + (b) * SHM_V + vst0) = sr_[i].vs0;          \
    *(bf16x8*)(V_lds + (b) * SHM_V + vst1) = sr_[i].vs1; int kc = sc * 2;               \
    *(bf16x8*)(K_lds + (b) * SHM_K + KSWZ(sr, kc)) = sr_[i].ks0;                       \
    *(bf16x8*)(K_lds + (b) * SHM_K + KSWZ(32 + sr, kc)) = sr_[i].ks1; } while (0)
#define SWAIT() do { if constexpr (SDEPTH == 2) asm volatile("s_waitcnt vmcnt(4)" ::: "memory"); else asm volatile("s_waitcnt vmcnt(0)" ::: "memory"); } while (0)
#define RESC(a) do { if (__any((a) < 1.f)) { if (hi == 0) al_l[r32] = (a); asm volatile("s_waitcnt lgkmcnt(0)" ::: "memory"); \
    _Pragma("unroll") for (int dd = 0; dd < 4; ++dd) _Pragma("unroll") for (int r = 0; r < 16; ++r) o[dd][r] *= al_l[crow(r, hi)]; } } while (0)
  f32x16 pA0, pA1, pB0, pB1; float mnA, mnB, alA, alB; bf16x8 pa0, pa1, pa2, pa3; const int NT = d.seq / KVBLK;
  constexpr int SE = 0, SO = SDEPTH - 1;
  SLOAD(SE, 0); asm volatile("s_waitcnt vmcnt(0)" ::: "memory"); SWRITE(0, SE); __syncthreads();
  qkt(pA0, pA1, K_lds, qr, r32, hi); na_mask<MODE>(pA0, pA1, 0, d, wid, r32, hi, btab); partialSM(pA0, pA1, m_reg, mnA, alA);
  SLOAD(SO, KVBLK); if constexpr (SDEPTH == 2) { if (2 < NT) SLOAD(SE, 2 * KVBLK); }
  SWAIT(); SWRITE(1, SO); if constexpr (SDEPTH == 1) { if (2 < NT) SLOAD(SE, 2 * KVBLK); } __syncthreads();
  for (int j = 1; j + 1 < NT; j += 2) {
    SBAR(); qkt(pB0, pB1, K_lds + SHM_K, qr, r32, hi); na_mask<MODE>(pB0, pB1, j, d, wid, r32, hi, btab);
    finishSM(pA0, pA1, alA, l_reg, pa0, pa1, pa2, pa3); SBAR();
    if constexpr (SDEPTH == 2) SLOAD(SO, (j + SDEPTH) * KVBLK); SBAR();
    pv_d0(o, vb0, pa0, pa1, pa2, pa3); partialSM(pB0, pB1, m_reg, mnB, alB);
    __syncthreads(); SWAIT(); SWRITE(0, SE); if constexpr (SDEPTH == 1) SLOAD(SE, (j + 2) * KVBLK);
    RESC(alB); __syncthreads();
    SBAR(); qkt(pA0, pA1, K_lds, qr, r32, hi); na_mask<MODE>(pA0, pA1, j + 1, d, wid, r32, hi, btab);
    finishSM(pB0, pB1, alB, l_reg, pa0, pa1, pa2, pa3); SBAR();
    if constexpr (SDEPTH == 2) { if (j + 3 < NT) SLOAD(SE, (j + 3) * KVBLK); } SBAR();
    pv_d0(o, vb0 + (int)SHM_V, pa0, pa1, pa2, pa3); partialSM(pA0, pA1, m_reg, mnA, alA);
    __syncthreads(); SWAIT(); SWRITE(1, SO); if constexpr (SDEPTH == 1) { if (j + 3 < NT) SLOAD(SO, (j + 3) * KVBLK); }
    RESC(alA); __syncthreads();
  }
  SBAR(); qkt(pB0, pB1, K_lds + SHM_K, qr, r32, hi); na_mask<MODE>(pB0, pB1, NT - 1, d, wid, r32, hi, btab);
  finishSM(pA0, pA1, alA, l_reg, pa0, pa1, pa2, pa3); SBAR();
  pv_d0(o, vb0, pa0, pa1, pa2, pa3); partialSM(pB0, pB1, m_reg, mnB, alB);
  __syncthreads(); RESC(alB);
  finishSM(pB0, pB1, alB, l_reg, pa0, pa1, pa2, pa3); SBAR();
  pv_d0(o, vb0 + (int)SHM_V, pa0, pa1, pa2, pa3);
  if (hi == 0) li_l[r32] = l_reg; asm volatile("s_waitcnt lgkmcnt(0)" ::: "memory");
  float rli[16];
#pragma unroll
  for (int r = 0; r < 16; ++r) rli[r] = __builtin_amdgcn_rcpf(li_l[crow(r, hi)]);
  bf16_t* Ow = d.O + (long)(wid * QBLK) * DM;
#pragma unroll
  for (int r = 0; r < 16; ++r) { int orow = crow(r, hi);
#pragma unroll
    for (int d0 = 0; d0 < 4; ++d0) Ow[(long)orow * DM + d0 * 32 + r32] = (bf16_t)(cvtpk(o[d0][r] * rli[r], 0.f) & 0xffffu); }
#undef SLOAD
#undef SWRITE
#undef SWAIT
#undef RESC
}
}

__device__ __forceinline__ void ada_item(const Params& p, int item, unsigned char* shm) {
  const int tid = tid_opaque(), wid = tid >> 6, lane = tid & 63;
  const int layer = item / 96, r = item % 96, kh = r / 48, cb = r % 48;
  float* sc = (float*)shm;
  float* red = (float*)shm + 9 * 1024;
  __syncthreads();
  for (int i = tid; i < 9 * 1024; i += 512) { const int rr = i >> 10, kk = i & 1023;
    const float v = rr < 8 ? p.in[I_C][rr * 2048 + kh * 1024 + kk] : p.in[I_CCTX][kh * 1024 + kk]; sc[i] = silu_f(v); }
  __syncthreads();
  const float* W = p.in[I_ADAW] + ((size_t)layer * 2048 + kh * 1024 + wid * 128) * 12288 + cb * 256 + lane * 4;
  f32x4 acc[9];
#pragma unroll
  for (int i = 0; i < 9; ++i) acc[i] = (f32x4){0.f, 0.f, 0.f, 0.f};
  for (int k = 0; k < 128; k += 8) {
    f32x4 w[8];
#pragma unroll
    for (int u = 0; u < 8; ++u) w[u] = *(const f32x4*)(W + (size_t)(k + u) * 12288);
#pragma unroll
    for (int u = 0; u < 8; ++u)
#pragma unroll
      for (int i = 0; i < 9; ++i) acc[i] += sc[i * 1024 + wid * 128 + k + u] * w[u];
  }
#pragma unroll
  for (int i = 0; i < 9; ++i) *(f32x4*)(red + ((size_t)wid * 9 + i) * 256 + lane * 4) = acc[i];
  __syncthreads();
  float* part = (float*)(p.ws + W_PART);
  for (int i = tid; i < 9 * 256; i += 512) { const int rr = i >> 8, c = i & 255; float s = 0.f;
#pragma unroll
    for (int w = 0; w < 8; ++w) s += red[((size_t)w * 9 + rr) * 256 + c];
    const int col = cb * 256 + c;
    if (kh == 0) s += p.in[I_ADAB][layer * 12288 + col];
    part[((size_t)(layer * 2 + kh) * 9 + rr) * 12288 + col] = s; }
}
template <int MAP> __device__ __forceinline__ void transpose_tile(const float* W, int ldw, int K, int k0, int n0, bf16_t* Wt, unsigned char* shm) {
  const int tid = tid_opaque(); float* tile = (float*)shm;
  __syncthreads();
  f32x4 v[8];
#pragma unroll
  for (int i = 0; i < 8; ++i) { const int kk = (tid >> 6) + i * 8, c4 = (tid & 63) * 4; v[i] = *(const f32x4*)(W + (size_t)(k0 + kk) * ldw + n0 + c4); }
#pragma unroll
  for (int i = 0; i < 8; ++i) { const int kk = (tid >> 6) + i * 8, c4 = (tid & 63) * 4; *(f32x4*)(tile + kk * 260 + c4) = v[i]; }
  __syncthreads();
  const int n = tid & 255, kq = tid >> 8; int col = n0 + n, row;
  if (MAP == 0) row = col;
  else { const int isg = col >= FF ? 1 : 0, ch = col - isg * FF; row = (ch >> 7) * 256 + isg * 128 + (ch & 127); }
  bf16_t* dst = Wt + (size_t)row * K + k0 + kq * 32;
#pragma unroll
  for (int s = 0; s < 4; ++s) { float f[8];
#pragma unroll
    for (int i = 0; i < 8; ++i) f[i] = tile[(kq * 32 + s * 8 + i) * 260 + n];
    u32x4 w = {cvtpk(f[0], f[1]), cvtpk(f[2], f[3]), cvtpk(f[4], f[5]), cvtpk(f[6], f[7])}; *(u32x4*)(dst + s * 8) = w; }
}
template <int J> __device__ __forceinline__ void fold_item(const float* W, int ldw, int colbase, const float* M, const float* cs, bf16_t* Wt, int rowbase, int kc, unsigned char* shm) {
  const int tid = tid_opaque(); float* wl = (float*)shm;
  constexpr int KPT = 32 * J / 512;
  __syncthreads();
#pragma unroll
  for (int i = 0; i < 2; ++i) { const int idx = tid + i * 512, kk = idx >> 5, c4 = (idx & 31) * 4;
    *(f32x4*)(wl + kk * 132 + c4) = *(const f32x4*)(W + (size_t)(kc * 32 + kk) * ldw + colbase + c4); }
  __syncthreads();
  const int j = tid % J, kq = tid / J;
  float acc[KPT];
#pragma unroll
  for (int i = 0; i < KPT; ++i) acc[i] = 0.f;
  for (int c = 0; c < 128; c += 4) {
    const float m0 = M[(c + 0) * J + j], m1 = M[(c + 1) * J + j], m2 = M[(c + 2) * J + j], m3 = M[(c + 3) * J + j];
#pragma unroll
    for (int i = 0; i < KPT; ++i) { const f32x4 wv = *(const f32x4*)(wl + (kq * KPT + i) * 132 + c); acc[i] += wv[0] * m0 + wv[1] * m1 + wv[2] * m2 + wv[3] * m3; }
  }
  const float s = cs ? cs[j] : 1.f;
  bf16_t* dst = Wt + (size_t)(rowbase + j) * DM + kc * 32 + kq * KPT;
#pragma unroll
  for (int i = 0; i < KPT; i += 8) { u32x4 w = {cvtpk(acc[i] * s, acc[i + 1] * s), cvtpk(acc[i + 2] * s, acc[i + 3] * s), cvtpk(acc[i + 4] * s, acc[i + 5] * s), cvtpk(acc[i + 6] * s, acc[i + 7] * s)};
    *(u32x4*)(dst + i) = w; }
}
__device__ __forceinline__ void fold_item2(const float* W, int ldw, int colbase, const float* M, int ldm, int mcol0, const float* cs, bf16_t* Wt, int rowbase, int kc, unsigned char* shm) {
  const int tid = tid_opaque(); float* wl = (float*)shm;
  float* ml = (float*)(shm + 16896);
  __syncthreads();
  f32x4 wr_[2], mr_[8];
#pragma unroll
  for (int i = 0; i < 2; ++i) { const int idx = tid + i * 512, kk = idx >> 5, c4 = (idx & 31) * 4; wr_[i] = *(const f32x4*)(W + (size_t)(kc * 32 + kk) * ldw + colbase + c4); }
#pragma unroll
  for (int i = 0; i < 8; ++i) { const int idx = tid + i * 512, c = idx >> 5, c4 = (idx & 31) * 4; mr_[i] = *(const f32x4*)(M + (size_t)c * ldm + mcol0 + c4); }
#pragma unroll
  for (int i = 0; i < 2; ++i) { const int idx = tid + i * 512, kk = idx >> 5, c4 = (idx & 31) * 4; *(f32x4*)(wl + kk * 132 + c4) = wr_[i]; }
#pragma unroll
  for (int i = 0; i < 8; ++i) { const int idx = tid + i * 512, c = idx >> 5, c4 = (idx & 31) * 4; *(f32x4*)(ml + c * 128 + c4) = mr_[i]; }
  __syncthreads();
  const int j = tid & 127, kq = tid >> 7;
  float acc[8];
#pragma unroll
  for (int i = 0; i < 8; ++i) acc[i] = 0.f;
#pragma unroll 4
  for (int c = 0; c < 128; c += 4) {
    const float m0 = ml[(c + 0) * 128 + j], m1 = ml[(c + 1) * 128 + j], m2 = ml[(c + 2) * 128 + j], m3 = ml[(c + 3) * 128 + j];
#pragma unroll
    for (int i = 0; i < 8; ++i) { const f32x4 wv = *(const f32x4*)(wl + (kq * 8 + i) * 132 + c); acc[i] += wv[0] * m0 + wv[1] * m1 + wv[2] * m2 + wv[3] * m3; }
  }
  const float sc_ = cs ? cs[j] : 1.f;
  u32x4 w = {cvtpk(acc[0] * sc_, acc[1] * sc_), cvtpk(acc[2] * sc_, acc[3] * sc_), cvtpk(acc[4] * sc_, acc[5] * sc_), cvtpk(acc[6] * sc_, acc[7] * sc_)};
  *(u32x4*)(Wt + (size_t)(rowbase + j) * DM + kc * 32 + kq * 8) = w;
}
template <int MODE, int NR> __device__ __forceinline__ void norm_rows(const Params& p, int row0, const float* xp, const float* xs, const float* g, int layer, int kshift, float* yout) {
  const int lane = tid_opaque() & 63;
  f32x4 v[NR][8]; float ss[NR];
#pragma unroll
  for (int r = 0; r < NR; ++r) { const int row = row0 + r * 8;
    const float* x = row < NP ? xp + (size_t)row * DM : xs + (size_t)(row - NP) * DM;
#pragma unroll
    for (int i = 0; i < 8; ++i) v[r][i] = *(const f32x4*)(x + (i * 64 + lane) * 4); }
#pragma unroll
  for (int r = 0; r < NR; ++r) { float s = 0.f;
#pragma unroll
    for (int i = 0; i < 8; ++i) s += v[r][i][0] * v[r][i][0] + v[r][i][1] * v[r][i][1] + v[r][i][2] * v[r][i][2] + v[r][i][3] * v[r][i][3];
    ss[r] = rsqrtf(wave_sum(s) * (1.f / 2048.f) + 1e-6f); }
  if (MODE == 0) {
    const int bidx = row0 < NP ? 8 : ((row0 - NP) >> 11);
    const float* part = (const float*)(p.ws + W_PART);
#pragma unroll
    for (int i = 0; i < 8; ++i) { const int c = (i * 64 + lane) * 4;
      const f32x4 gv = *(const f32x4*)(g + c), sh = modv4(part, layer, bidx, kshift, c), scl = modv4(part, layer, bidx, kshift + 1, c);
      const f32x4 gs = gv * (scl + 1.f);
#pragma unroll
      for (int r = 0; r < NR; ++r) { const f32x4 y = v[r][i] * ss[r] * gs + sh;
        u32x2 w = {cvtpk(y[0], y[1]), cvtpk(y[2], y[3])}; *(u32x2*)((bf16_t*)(p.ws + W_ACT) + (size_t)(row0 + r * 8) * DM + c) = w; } }
  } else {
#pragma unroll
    for (int i = 0; i < 8; ++i) { const int c = (i * 64 + lane) * 4; const f32x4 gv = *(const f32x4*)(g + c);
#pragma unroll
      for (int r = 0; r < NR; ++r) *(f32x4*)(yout + (size_t)(row0 + r * 8) * DM + c) = v[r][i] * ss[r] * gv; }
  }
}
template <int MODE, int NR> __device__ __forceinline__ void norm_rows_b(const Params& p, int row0, const float* g, int layer, int kshift, float* yout) {
  const int lane = tid_opaque() & 63;
  const bf16_t* xb = (const bf16_t*)(p.ws + W_XB);
  u32x4 v[NR][4]; float ss[NR];
#pragma unroll
  for (int r = 0; r < NR; ++r)
#pragma unroll
    for (int i = 0; i < 4; ++i) v[r][i] = *(const u32x4*)(xb + (size_t)(row0 + r * 8) * DM + (i * 64 + lane) * 8);
#pragma unroll
  for (int r = 0; r < NR; ++r) { float s = 0.f;
#pragma unroll
    for (int i = 0; i < 4; ++i)
#pragma unroll
      for (int e = 0; e < 4; ++e) { const float a = bflo(v[r][i][e]), b = bfhi(v[r][i][e]); s += a * a + b * b; }
    ss[r] = rsqrtf(wave_sum(s) * (1.f / 2048.f) + 1e-6f); }
  const int bidx = row0 < NP ? 8 : ((row0 - NP) >> 11);
  const float* part = (const float*)(p.ws + W_PART);
#pragma unroll
  for (int i = 0; i < 4; ++i) { const int c = (i * 64 + lane) * 8;
    f32x4 gs0 = *(const f32x4*)(g + c), gs1 = *(const f32x4*)(g + c + 4), sh0 = {0.f, 0.f, 0.f, 0.f}, sh1 = {0.f, 0.f, 0.f, 0.f};
    if (MODE == 0) { gs0 = gs0 * (modv4(part, layer, bidx, kshift + 1, c) + 1.f); gs1 = gs1 * (modv4(part, layer, bidx, kshift + 1, c + 4) + 1.f);
      sh0 = modv4(part, layer, bidx, kshift, c); sh1 = modv4(part, layer, bidx, kshift, c + 4); }
#pragma unroll
    for (int r = 0; r < NR; ++r) { const u32x4 w = v[r][i];
      const f32x4 x0 = {bflo(w[0]), bfhi(w[0]), bflo(w[1]), bfhi(w[1])}, x1 = {bflo(w[2]), bfhi(w[2]), bflo(w[3]), bfhi(w[3])};
      const f32x4 y0 = x0 * ss[r] * gs0 + sh0, y1 = x1 * ss[r] * gs1 + sh1;
      if (MODE == 0) { u32x4 o = {cvtpk(y0[0], y0[1]), cvtpk(y0[2], y0[3]), cvtpk(y1[0], y1[1]), cvtpk(y1[2], y1[3])};
        *(u32x4*)((bf16_t*)(p.ws + W_ACT) + (size_t)(row0 + r * 8) * DM + c) = o; }
      else { float* y = yout + (size_t)(row0 + r * 8) * DM + c; *(f32x4*)y = y0; *(f32x4*)(y + 4) = y1; } } }
}
__device__ __forceinline__ void fix_phase(const Params& p, int layer) {
  const float* UB = (const float*)(p.ws + W_UB); bf16_t* G = (bf16_t*)(p.ws + W_BIG);
  const float* cw = p.in[I_FFCW] + (size_t)layer * 3 * FF2; const float* cb = p.in[I_FFCB] + (size_t)layer * FF2;
  const long total = 768L * (FF / 4);
  for (long i = (long)blockIdx.x * 512 + tid_opaque(); i < total; i += (long)gridDim.x * 512) {
    const int rr = (int)(i / (FF / 4)), ch = (int)(i % (FF / 4)) * 4;
    const int chunk = rr >> 1, last = rr & 1, row = chunk * 64 + (last ? 63 : 0);
    const int seqlen = row < NP ? 256 : 2048; const int rel = row < NP ? row : row - NP;
    const int ubc = (ch >> 7) * 256 + (ch & 127);
    const float* pu; const float* cu; const float* nu; bool hp, hn;
    if (!last) { hp = (rel % seqlen) != 0; pu = UB + ((size_t)(chunk - 1) * 4 + 3) * FF2; cu = UB + ((size_t)chunk * 4 + 0) * FF2; nu = UB + ((size_t)chunk * 4 + 1) * FF2; hn = true; }
    else { hn = ((rel + 1) % seqlen) != 0; pu = UB + ((size_t)chunk * 4 + 2) * FF2; cu = UB + ((size_t)chunk * 4 + 3) * FF2; nu = UB + ((size_t)(chunk + 1) * 4 + 0) * FF2; hp = true; }
    const f32x4 z = {0.f, 0.f, 0.f, 0.f};
    const f32x4 pv = hp ? *(const f32x4*)(pu + ubc) : z, pg = hp ? *(const f32x4*)(pu + ubc + 128) : z;
    const f32x4 cv = *(const f32x4*)(cu + ubc), cgt = *(const f32x4*)(cu + ubc + 128);
    const f32x4 nv = hn ? *(const f32x4*)(nu + ubc) : z, ng = hn ? *(const f32x4*)(nu + ubc + 128) : z;
    const f32x4 val = *(const f32x4*)(cw + ch) * pv + *(const f32x4*)(cw + FF2 + ch) * cv + *(const f32x4*)(cw + 2 * FF2 + ch) * nv + *(const f32x4*)(cb + ch);
    const f32x4 gat = *(const f32x4*)(cw + FF + ch) * pg + *(const f32x4*)(cw + FF2 + FF + ch) * cgt + *(const f32x4*)(cw + 2 * FF2 + FF + ch) * ng + *(const f32x4*)(cb + FF + ch);
    u32x2 w = {cvtpk(silu_fast(gat[0]) * val[0], silu_fast(gat[1]) * val[1]), cvtpk(silu_fast(gat[2]) * val[2], silu_fast(gat[3]) * val[3])};
    *(u32x2*)(G + (size_t)row * FF + ch) = w;
  }
}
__device__ __forceinline__ void oddprep_row(const Params& p, int row) {
  const int lane = tid_opaque() & 63;
  bf16_t* pr = (bf16_t*)(p.ws + W_BIG) + (size_t)row * ODN;
  const bool lat = row >= NP; const int t = lat ? (row - NP) & 2047 : row & 255;
  const int grow = t >> 6, gcol = t & 63;
  const float* rope = (const float*)(p.ws + W_ROPE);
  unsigned raw[16];
#pragma unroll
  for (int v = 0; v < 16; ++v) raw[v] = *(const unsigned*)(pr + 512 + v * 128 + lane * 2);
  const int seqlen = lat ? 2048 : 256;
  const bf16_t* zb = pr + lane * 8;
  u32x4 zw[16];
#pragma unroll
  for (int si = 0; si < 16; ++si) { const int tc = min(max(t + si - 8, 0), seqlen - 1); zw[si] = *(const u32x4*)(zb + (long)(tc - t) * ODN); }
  const int e0 = lane * 2;
  const float gq0 = p.in[I_ODQG][e0], gq1 = p.in[I_ODQG][e0 + 1], gk0 = p.in[I_ODKG][e0], gk1 = p.in[I_ODKG][e0 + 1];
  const int pos = lane < 32 ? grow : gcol; const int i0 = e0 & 31;
  const float c0 = rope[(pos * 32 + i0) * 2], s0 = rope[(pos * 32 + i0) * 2 + 1], c1 = rope[(pos * 32 + i0 + 1) * 2], s1 = rope[(pos * 32 + i0 + 1) * 2 + 1];
  const bool isx1 = (lane & 16) == 0;
#pragma unroll
  for (int v = 0; v < 16; ++v) {
    float a = bflo(raw[v]), b = bfhi(raw[v]);
    const float ss = wave_sum(a * a + b * b);
    const float rinv = rsqrtf(ss * (1.f / 128.f) + 1e-6f);
    a = a * rinv * (v < 12 ? gq0 : gk0); b = b * rinv * (v < 12 ? gq1 : gk1);
    if (lat) {
      const float pa = __shfl_xor(a, 16), pb = __shfl_xor(b, 16);
      const float na = isx1 ? a * c0 - pa * s0 : a * c0 + pa * s0;
      const float nb = isx1 ? b * c1 - pb * s1 : b * c1 + pb * s1;
      a = na; b = nb;
    } else if (v >= 12) { float* o = p.out + O_GK + (size_t)row * 512 + (v - 12) * 128 + e0; o[0] = a; o[1] = b; }
    *(unsigned*)(pr + 512 + v * 128 + lane * 2) = cvtpk(a, b);
  }
  const int grp = lane >> 4; const int hw = 1 << grp;
  const int lo = max(t - hw, 0), hi = min(t + hw, seqlen);
  float acc[8];
#pragma unroll
  for (int i = 0; i < 8; ++i) acc[i] = 0.f;
#pragma unroll
  for (int si = 0; si < 16; ++si) { const int ts = t + si - 8; const float wgt = (ts >= lo && ts < hi) ? 1.f : 0.f;
#pragma unroll
    for (int i = 0; i < 4; ++i) { acc[2 * i] += wgt * bflo(zw[si][i]); acc[2 * i + 1] += wgt * bfhi(zw[si][i]); } }
  const u32x4 self = zw[8]; const float inv = 1.f / (float)(hi - lo);
  unsigned ow[4];
#pragma unroll
  for (int i = 0; i < 4; ++i) ow[i] = cvtpk(acc[2 * i] * inv - bflo(self[i]), acc[2 * i + 1] * inv - bfhi(self[i]));
  u32x4 w = {ow[0], ow[1], ow[2], ow[3]};
  *(u32x4*)((bf16_t*)(p.ws + W_ACT) + (size_t)row * DM + lane * 8) = w;
}

__device__ __forceinline__ void do_tile(const Params& p, int i, unsigned char* shm) {
  constexpr int T0 = 576, T1 = 256, T2 = 320, T3 = 256, T4 = 2816;
  if (i < T0) { const int kt = i / 18, nt = i % 18; transpose_tile<0>(p.in[I_EVWIN], 5120, DM, kt * 64, nt * 256, (bf16_t*)(p.ws + W_EVIN), shm); return; } i -= T0;
  if (i < T1) { const int kt = i / 8, nt = i % 8; transpose_tile<0>(p.in[I_EVWOUT], DM, DM, kt * 64, nt * 256, (bf16_t*)(p.ws + W_EVOUT), shm); return; } i -= T1;
  if (i < T2) { const int kt = i / 10, nt = i % 10; transpose_tile<0>(p.in[I_ODWIN], ODN, DM, kt * 64, 512 + nt * 256, (bf16_t*)(p.ws + W_ODIN), shm); return; } i -= T2;
  if (i < T3) { const int kt = i / 8, nt = i % 8; transpose_tile<0>(p.in[I_ODWOUT], DM, DM, kt * 64, nt * 256, (bf16_t*)(p.ws + W_ODOUT), shm); return; } i -= T3;
  if (i < T4) { const int l = i / 1408, r = i % 1408, kt = r / 44, nt = r % 44;
    transpose_tile<1>(p.in[I_FFUP] + (size_t)l * DM * FF2, FF2, DM, kt * 64, nt * 256, (bf16_t*)(p.ws + W_UP) + (size_t)l * FF2 * DM, shm); return; } i -= T4;
  { const int l = i / 704, r = i % 704, kt = r / 8, nt = r % 8;
    transpose_tile<0>(p.in[I_FFDN] + (size_t)l * FF * DM, DM, FF, kt * 64, nt * 256, (bf16_t*)(p.ws + W_DN) + (size_t)l * DM * FF, shm); }
}
__device__ __forceinline__ int tile_now(int j) { return j < 832 ? j : (j < 2240 ? 1408 + (j - 832) : 4224 + (j - 2240)); }
__device__ __forceinline__ int tile_def(int d) { return d < 576 ? 832 + d : (d < 1984 ? 2816 + (d - 576) : 4928 + (d - 1984)); }
__device__ __forceinline__ void prep_phase(const Params& p, unsigned char* shm) {
  const int G = gridDim.x, bid = blockIdx.x, tid = tid_opaque();
  {
    const bool defer = (G == 256);
    const int n_ada = defer ? 96 : 192, n_tiles = defer ? 2944 : 5632;
    unsigned* qctr = (unsigned*)(p.ws + W_BAR);
    volatile LAS unsigned* qslot = (volatile LAS unsigned*)((LAS unsigned char*)shm + (LDS_BYTES - 32));
    for (;;) {
      __syncthreads();
      if (tid == 0) *qslot = atomicAdd(qctr, 1u);
      __syncthreads();
      const int it0 = (int)*qslot;
      if (it0 >= n_ada + n_tiles) break;
      if (it0 < n_ada) { ada_item(p, it0, shm); continue; }
      do_tile(p, defer ? tile_now(it0 - n_ada) : it0 - n_ada, shm);
    }
  }
  const long gt = (long)bid * 512 + tid, gs = (long)G * 512;
  {
    const long n0 = 8L * 256 * 1536 / 8, n1 = 8L * 256 * 512 / 8;
    for (long i = gt; i < 2 * n0 + 2 * n1; i += gs) {
      const float* src; bf16_t* dst; long j = i;
      if (j < n0) { src = p.in[I_CNAK]; dst = (bf16_t*)(p.ws + W_CNAK); }
      else if (j < 2 * n0) { j -= n0; src = p.in[I_CNAV]; dst = (bf16_t*)(p.ws + W_CNAV); }
      else if (j < 2 * n0 + n1) { j -= 2 * n0; src = p.in[I_CGK]; dst = (bf16_t*)(p.ws + W_CGK); }
      else { j -= 2 * n0 + n1; src = p.in[I_CGV]; dst = (bf16_t*)(p.ws + W_CGV); }
      const f32x4 a = *(const f32x4*)(src + j * 8), b = *(const f32x4*)(src + j * 8 + 4);
      u32x4 w = {cvtpk(a[0], a[1]), cvtpk(a[2], a[3]), cvtpk(b[0], b[1]), cvtpk(b[2], b[3])}; *(u32x4*)(dst + j * 8) = w;
    }
  }
  {
    float* ct = (float*)shm;
    __syncthreads();
    for (int i = tid; i < 2048; i += 512) ct[i] = cospif((float)i * (2.f / 2048.f));
    __syncthreads();
    const long nS = 2048L * 4096 / 8, nC = 256L * 512 / 8;
    for (long i = gt; i < nS + nC; i += gs) {
      int npos, sh, ts; long j; bf16_t* dst;
      if (i < nS) { npos = 2048; sh = 11; ts = 0; j = i; dst = (bf16_t*)(p.ws + W_DFTS); } else { npos = 256; sh = 8; ts = 3; j = i - nS; dst = (bf16_t*)(p.ws + W_DFTC); }
      const int prow = (int)((j * 8) >> (sh + 1)), k0 = (int)((j * 8) & (2 * npos - 1));
      float f[8];
#pragma unroll
      for (int e = 0; e < 8; ++e) { const int k = k0 + e; const int kk = k & (npos - 1); const int m = ((prow * kk) & (npos - 1)) << ts;
        f[e] = (k < npos) ? ct[m] : -ct[(m - 512) & 2047]; }
      u32x4 w = {cvtpk(f[0], f[1]), cvtpk(f[2], f[3]), cvtpk(f[4], f[5]), cvtpk(f[6], f[7])}; *(u32x4*)(dst + j * 8) = w;
    }
    float* M = (float*)(p.ws + W_FOLDM);
    for (long i = gt; i < 4L * 128 * 256; i += gs) { const int j = (int)(i & 255), c = (int)((i >> 8) & 127), g = (int)(i >> 15);
      const float* fw = p.in[I_EVFNET] + (size_t)g * 128 * 128 + (j & 127); float s = 0.f; const int off = (j < 128) ? 0 : 2048 - 512;
#pragma unroll 8
      for (int c2 = 0; c2 < 128; ++c2) { const float tr = ct[((((c * c2) & 127) << 4) + off) & 2047]; s += tr * fw[c2 * 128]; }
      M[i] = s; }
  }
  {
    float* rope = (float*)(p.ws + W_ROPE);
    for (long i = gt; i < 64 * 32; i += gs) { const int pos = (int)(i >> 5), k = (int)(i & 31);
      const float invf = exp2f(-(float)k * (1.f / 32.f) * 13.287712379549449f);
      const float ang = (float)pos * invf; const float x = ang * 0.3183098861837907f;
      rope[i * 2] = cospif(x); rope[i * 2 + 1] = sinpif(x); }
  }
}

#define XB_TMO      128
#define XB_XCNT(j)  (256  + 64 * (j))
#define XB_XSUB(j)  (1280 + 64 * (j))
#define XB_XGEN(j)  (2304 + 64 * (j))
#define XB_TOP      3328
#define XB_TOPGEN   3392
#define XCD_BAR_WORDS 3456
#define XB_SPIN_CAP (1u << 18)
__device__ __forceinline__ unsigned xb_ld(unsigned* p)              { return __hip_atomic_load(p, __ATOMIC_RELAXED, __HIP_MEMORY_SCOPE_AGENT); }
__device__ __forceinline__ unsigned xb_add(unsigned* p, unsigned v) { return __hip_atomic_fetch_add(p, v, __ATOMIC_RELAXED, __HIP_MEMORY_SCOPE_AGENT); }
__device__ __forceinline__ unsigned xb_xcc_id() { return (unsigned)__builtin_amdgcn_s_getreg((3 << 11) | 20) & 0xFu; }
#define XB_SPIN(cond, bar) do { unsigned _sp = 0; while (cond) { __builtin_amdgcn_s_sleep(1); \
    if ((++_sp & 255u) == 0u) { if (xb_ld(&(bar)[XB_TMO])) break; if (_sp > XB_SPIN_CAP) { atomicAdd(&(bar)[XB_TMO], 1u); break; } } } } while (0)
struct XcdBarrier { unsigned* bar; unsigned x; volatile LAS unsigned* st; };
__device__ __forceinline__ XcdBarrier xcd_barrier_post(unsigned* bar, volatile LAS unsigned* st) {
    XcdBarrier b; b.bar = bar; b.x = xb_xcc_id(); b.st = st;
    if (threadIdx.x == 0) (void)xb_add(&bar[XB_XCNT(b.x)], 1u);
    return b;
}
__device__ __forceinline__ void xcd_barrier_complete(unsigned* bar, unsigned x, unsigned& nloc, unsigned& nx) {
    const unsigned G = gridDim.x * gridDim.y * gridDim.z;
    unsigned sum, cnt, mine, sp = 0u;
    for (;;) {
        sum = 0u; cnt = 0u; mine = 0u;
#pragma unroll
        for (unsigned j = 0; j < 16; ++j) { const unsigned c = xb_ld(&bar[XB_XCNT(j)]); sum += c; cnt += (c > 0u) ? 1u : 0u; mine = (j == x) ? c : mine; }
        if (sum == G) break;
        __builtin_amdgcn_s_sleep(1);
        if ((++sp & 255u) == 0u) { if (xb_ld(&bar[XB_TMO])) break; if (sp > XB_SPIN_CAP) { atomicAdd(&bar[XB_TMO], 1u); break; } }
    }
    nloc = mine > 0u ? mine : 1u; nx = cnt > 0u ? cnt : 1u;
}
__device__ __forceinline__ void xcd_barrier(const XcdBarrier& b) {
    asm volatile("s_waitcnt vmcnt(0)" ::: "memory");
    __syncthreads();
    if (threadIdx.x == 0) {
        unsigned* bar = b.bar;
        __builtin_amdgcn_s_waitcnt(0);
        unsigned nloc = b.st[0], nx = b.st[1];
        if (nloc == 0u) { xcd_barrier_complete(bar, b.x, nloc, nx); b.st[0] = nloc; b.st[1] = nx; }
        const unsigned old = xb_add(&bar[XB_XSUB(b.x)], 1u);
        const unsigned gen = old / nloc;
        if (old + 1u == (gen + 1u) * nloc) {
            __builtin_amdgcn_fence(__ATOMIC_RELEASE, "agent");
            asm volatile("s_waitcnt vmcnt(0)" ::: "memory");
            const unsigned og = xb_add(&bar[XB_TOP], 1u);
            const unsigned tg = og / nx;
            if (og + 1u == (tg + 1u) * nx) xb_add(&bar[XB_TOPGEN], 1u);
            else XB_SPIN(xb_ld(&bar[XB_TOPGEN]) == tg, bar);
            __builtin_amdgcn_fence(__ATOMIC_ACQUIRE, "agent");
            xb_add(&bar[XB_XGEN(b.x)], 1u);
            asm volatile("s_waitcnt vmcnt(0)" ::: "memory");
        } else {
            XB_SPIN(xb_ld(&bar[XB_XGEN(b.x)]) == gen, bar);
            __builtin_amdgcn_fence(__ATOMIC_ACQUIRE, "agent");
            asm volatile("s_waitcnt vmcnt(0)" ::: "memory");
        }
    }
    __syncthreads();
}

__global__ void __launch_bounds__(512, 2) mega(Params p_unused) {
  extern __shared__ __attribute__((aligned(16))) unsigned char shm[];
  cg::grid_group grid = cg::this_grid();
  typedef const Params __attribute__((address_space(4)))* KP;
  KP kp0 = (KP)__builtin_amdgcn_kernarg_segment_ptr();
  const int G = gridDim.x, bid = blockIdx.x;
  const int ph_lo = kp0->ph_lo, ph_hi = kp0->ph_hi;
  volatile LAS unsigned* xst = (volatile LAS unsigned*)((LAS unsigned char*)shm + (LDS_BYTES - 16));
  if (threadIdx.x == 0) { xst[0] = 0u; xst[1] = 0u; }
  __syncthreads();
  XcdBarrier xb = xcd_barrier_post((unsigned*)(kp0->ws + W_BAR), xst);
  for (int phx = ph_lo * 2; phx < ph_hi * 2; ++phx) {
    const int ph = phx >> 1;
    if ((phx & 1) && !((REPMASK >> ph) & 1)) continue;
    if (phx > ph_lo * 2) { if (ph_hi > 1000) grid.sync(); else xcd_barrier(xb); }
    KP kp = kp0; asm volatile("" : "+s"(kp));
    Params p;
#pragma unroll
    for (int i = 0; i < 27; ++i) p.in[i] = kp->in[i];
    p.out = kp->out; p.ws = kp->ws; p.ph_lo = 0; p.ph_hi = 0;
    float* xr = p.out + O_Y;
    bf16_t* ACT = (bf16_t*)(p.ws + W_ACT); bf16_t* BIG = (bf16_t*)(p.ws + W_BIG);
    const float* part = (const float*)(p.ws + W_PART);
    int kind, layer = ph >= 9 ? 1 : 0;
    switch (ph) {
      case 0: kind = 0; break;
      case 1: case 5: case 9: case 14: kind = 1; break;
      case 2: case 10: kind = 2; break;
      case 3: case 12: kind = 3; break;
      case 4: case 8: case 13: case 17: kind = 4; break;
      case 6: case 15: kind = 5; break;
      case 7: case 16: kind = 6; break;
      case 11: kind = 7; break;
      default: kind = 8; break;
    }
    if (kind == 0 && (KMASK & 1)) {
      prep_phase(p, shm);
    } else if (kind == 1 && (KMASK & 2)) {
      const bool first = (ph == 1);
      const float* xp = first ? p.in[I_XP] : xr; const float* xs = first ? p.in[I_XS] : xr + (size_t)NP * DM;
      const bool n2 = (ph == 5 || ph == 14);
      const float* g = (n2 ? p.in[I_N2G] : p.in[I_N1G]) + layer * DM;
      if (first) {
        for (int it = bid; it < 768; it += G) {
          if (it < 512) { const int gi = it >> 7, kc = (it >> 1) & 63, jh = it & 1;
            fold_item2(p.in[I_EVWIN], 5120, 4608 + gi * 128, (const float*)(p.ws + W_FOLDM) + (size_t)gi * 128 * 256, 256, jh * 128, nullptr, (bf16_t*)(p.ws + W_EVIN), 4608 + gi * 256 + jh * 128, kc, shm); }
          else { const int v = it - 512, gi = v >> 6, kc = v & 63;
            fold_item2(p.in[I_ODWIN], ODN, gi * 128, p.in[I_ODPOOLW] + (size_t)gi * 128 * 128, 128, 0, p.in[I_ODPOOLS] + gi * 128, (bf16_t*)(p.ws + W_ODIN), gi * 128, kc, shm); }
        }
      }
      const int wid = tid_opaque() >> 6;
      if (first) { for (int it = bid; it < NTOK / 32; it += G) norm_rows<0, 4>(p, it * 32 + wid, xp, xs, g, layer, n2 ? 3 : 0, nullptr); }
      else { for (int it = bid; it < NTOK / 32; it += G) norm_rows_b<0, 4>(p, it * 32 + wid, g, layer, n2 ? 3 : 0, nullptr); }
    } else if (kind == 2 && (KMASK & 4)) {
      pg8::Gemm gm; gm.A = ACT; gm.M = NTOK; gm.K = DM;
      EpiIn E; E.O = BIG; E.out = p.out; E.yts = (bf16_t*)(p.ws + W_YTS); E.ytc = (bf16_t*)(p.ws + W_YTC);
      if (layer == 0) { gm.Bt = (const bf16_t*)(p.ws + W_EVIN); gm.N = EVN; E.ldc = EVN; E.even = 1; }
      else { gm.Bt = (const bf16_t*)(p.ws + W_ODIN); gm.N = ODN; E.ldc = ODN; E.even = 0; }
      pg8::StaticOrder S; S.init(gm.M, gm.N, G, bid);
      pg8::gemm_phase<EpiIn>((LAS unsigned char*)shm, gm, S, E);
      if (layer == 0 && G == 256 && bid >= 64) { for (int d = bid - 64; d < 2112; d += 192) do_tile(p, tile_def(d), shm); }
    } else if (kind == 3 && (KMASK & 8)) {
      const int nunits = 768 + 384;
      const bool bal = (layer == 0 && G == 256);
      const int nloc = bal ? (bid < 128 ? 6 : 3) : (nunits - bid + G - 1) / G;
      for (int iu = 0; iu < nloc; ++iu) {
        int u;
        if (bal) { if (bid < 128) u = iu < 4 ? bid * 4 + iu : 768 + bid * 2 + (iu - 4); else u = iu < 2 ? 512 + (bid - 128) * 2 + iu : 768 + 256 + (bid - 128); }
        else if (layer == 1 && G == 256 && iu < 3) u = (bid & 7) * 96 + iu * 32 + (bid >> 3);
        else u = bid + iu * G;
        at::Desc d; int masked = 0, head = 0;
        if (layer == 0) {
          if (u < 768) { const int b = u / 96, rem = u % 96, h = rem >> 3, rg = rem & 7; head = h; masked = 1;
            const size_t qrow = (size_t)NP + b * 2048 + rg * 256; const bool edge = (rg == 0 || rg == 7); const int ks = edge ? (rg ? 24 : 0) : min(max(4 * rg - 4, 0), 20);
            d.Q = BIG + qrow * EVN + h * 128; d.ldq = EVN;
            d.K0 = (const bf16_t*)(p.ws + W_CNAK) + (size_t)b * 256 * 1536 + h * 128; d.V0 = (const bf16_t*)(p.ws + W_CNAV) + (size_t)b * 256 * 1536 + h * 128; d.ld0 = 1536; d.n0 = 256;
            const size_t krow = (size_t)NP + b * 2048 + ks * 64;
            d.K1 = BIG + krow * EVN + 1536 + h * 128; d.V1 = BIG + krow * EVN + 3072 + h * 128; d.ld1 = EVN; d.seq = edge ? 768 : 1024;
            d.O = ACT + qrow * DM + h * 128; d.ldo = DM; d.ks = ks; d.qrow0 = 4 * rg;
          } else { const int v = u - 768, b = v / 12, h = v % 12; const size_t qrow = (size_t)b * 256;
            d.Q = BIG + qrow * EVN + h * 128; d.ldq = EVN;
            d.K0 = BIG + qrow * EVN + 1536 + h * 128; d.V0 = BIG + qrow * EVN + 3072 + h * 128; d.ld0 = EVN; d.n0 = 256;
            d.K1 = d.K0; d.V1 = d.V0; d.ld1 = EVN; d.seq = 256; d.O = ACT + qrow * DM + h * 128; d.ldo = DM; d.ks = 0; d.qrow0 = 0; }
        } else {
          if (u < 768) { const int b = u / 96, rem = u % 96, h = rem >> 3, qb = rem & 7, kvh = h / 3;
            const size_t qrow = (size_t)NP + b * 2048 + qb * 256;
            d.Q = BIG + qrow * ODN + 512 + h * 128; d.ldq = ODN;
            d.K0 = (const bf16_t*)(p.ws + W_CGK) + (size_t)b * 256 * 512 + kvh * 128; d.V0 = (const bf16_t*)(p.ws + W_CGV) + (size_t)b * 256 * 512 + kvh * 128; d.ld0 = 512; d.n0 = 256;
            const size_t krow = (size_t)NP + b * 2048;
            d.K1 = BIG + krow * ODN + 2048 + kvh * 128; d.V1 = BIG + krow * ODN + 2560 + kvh * 128; d.ld1 = ODN; d.seq = 2304;
            d.O = ACT + qrow * DM + 512 + h * 128; d.ldo = DM; d.ks = 0; d.qrow0 = 0;
          } else { const int v = u - 768, b = v / 12, h = v % 12, kvh = h / 3; const size_t qrow = (size_t)b * 256;
            d.Q = BIG + qrow * ODN + 512 + h * 128; d.ldq = ODN;
            d.K0 = BIG + qrow * ODN + 2048 + kvh * 128; d.V0 = BIG + qrow * ODN + 2560 + kvh * 128; d.ld0 = ODN; d.n0 = 256;
            d.K1 = d.K0; d.V1 = d.V0; d.ld1 = ODN; d.seq = 256; d.O = ACT + qrow * DM + 512 + h * 128; d.ldo = DM; d.ks = 0; d.qrow0 = 0; }
        }
        __syncthreads();
        if (masked && (AMASK & 1)) {
          float* btab = (float*)(shm + at::SHM_ATTN) + 64;
          const int tid = tid_opaque();
          if (tid < 465) btab[tid] = p.in[I_EVBIAS][head * 465 + tid] * (1.f / at::SCALE);
          at::attn_body<1>(d, (char*)shm);
        } else if (AMASK & 2) at::attn_body<0>(d, (char*)shm);
      }
      if (layer == 0 && (AMASK & 4)) {
        __syncthreads();
#pragma unroll 1
        for (int v = 0; v < 2; ++v) {
          pg8::Gemm gm; EpiFourier E; E.mix = ACT;
          if (v == 0) { gm.A = (const bf16_t*)(p.ws + W_DFTS); gm.Bt = (const bf16_t*)(p.ws + W_YTS); gm.M = 2048; gm.N = 4096; gm.K = 4096; E.rowbase = NP; E.npos = 2048; E.scale = 0.001953125f; }
          else { gm.A = (const bf16_t*)(p.ws + W_DFTC); gm.Bt = (const bf16_t*)(p.ws + W_YTC); gm.M = 256; gm.N = 16384; gm.K = 512; E.rowbase = 0; E.npos = 256; E.scale = 0.005524271728019903f; }
          pg8::StaticOrder S; S.init(gm.M, gm.N, G, (bid + 128) % G);
          pg8::gemm_phase<EpiFourier>((LAS unsigned char*)shm, gm, S, E);
          __syncthreads();
        }
      }
    } else if (kind == 4 && (KMASK & 16)) {
      pg8::Gemm gm; gm.M = NTOK; gm.N = DM; EpiRes E; E.xb = (bf16_t*)(p.ws + W_XB); E.xo = (phx & 1) ? ACT : E.xb; E.part = part; E.layer = layer; E.xp = p.in[I_XP]; E.xs = p.in[I_XS]; E.from_in = 0;
      if (ph == 4) { gm.A = ACT; gm.Bt = (const bf16_t*)(p.ws + W_EVOUT); gm.K = DM; E.gk = 2; E.from_in = 1; }
      else if (ph == 13) { gm.A = ACT; gm.Bt = (const bf16_t*)(p.ws + W_ODOUT); gm.K = DM; E.gk = 2; }
      else { gm.A = BIG; gm.Bt = layer ? (const bf16_t*)(p.ws + W_DN + (size_t)DM * FF * 2) : (const bf16_t*)(p.ws + W_DN); gm.K = FF; E.gk = 5; }
      pg8::StaticOrder S; S.init(gm.M, gm.N, G, bid);
      pg8::gemm_phase<EpiRes>((LAS unsigned char*)shm, gm, S, E);
    } else if (kind == 5 && (KMASK & 32)) {
      pg8::Gemm gm; gm.A = ACT; gm.Bt = (const bf16_t*)(p.ws + W_UP) + (size_t)layer * FF2 * DM; gm.M = NTOK; gm.N = FF2; gm.K = DM;
      EpiUp E; E.G = BIG; E.UB = (float*)(p.ws + W_UB); E.cw = p.in[I_FFCW] + (size_t)layer * 3 * FF2; E.cb = p.in[I_FFCB] + (size_t)layer * FF2;
      pg8::StaticOrder S; S.init(gm.M, gm.N, G, bid);
      pg8::gemm_phase<EpiUp>((LAS unsigned char*)shm, gm, S, E);
      if (layer == 0 && G == 256 && bid >= 128) { if (bid < 224) ada_item(p, 96 + (bid - 128), shm); for (int d = 2112 + (bid - 128); d < 2688; d += 128) do_tile(p, tile_def(d), shm); }
    } else if (kind == 6 && (KMASK & 64)) {
      fix_phase(p, layer);
    } else if (kind == 7 && (KMASK & 128)) {
      const int wid = tid_opaque() >> 6;
      for (int it = bid; it < NTOK / 8; it += G) oddprep_row(p, it * 8 + wid);
    } else if (KMASK & 256) {
      for (int e = 0; e < EXTRA_SYNCS; ++e) xcd_barrier(xb);
      const int wid = tid_opaque() >> 6;
      for (int it = bid; it < NTOK / 32; it += G) norm_rows_b<1, 4>(p, it * 32 + wid, p.in[I_FING], 0, 0, xr);
    }
  }
}

extern "C" void kernel_launch(void* const* d_in, const int* in_sizes, int n_in, void* d_out, int out_size, void* d_ws, size_t ws_size, hipStream_t stream) {
  static int grid = 0;
  if (grid == 0) {
    if (n_in != 27 || out_size != 83886080 || ws_size < W_END) { fprintf(stderr, "kernel_launch: unexpected shapes: n_in %d out %d ws %zu (need %zu)\n", n_in, out_size, ws_size, (size_t)W_END); grid = -1; return; }
    int dev = 0, cus = 0, per_cu = 0;
    if (hipGetDevice(&dev) != hipSuccess || hipDeviceGetAttribute(&cus, hipDeviceAttributeMultiprocessorCount, dev) != hipSuccess) { grid = -1; return; }
    if (hipFuncSetAttribute((const void*)mega, hipFuncAttributeMaxDynamicSharedMemorySize, LDS_BYTES) != hipSuccess) { fprintf(stderr, "kernel_launch: hipFuncSetAttribute failed\n"); grid = -1; return; }
    if (hipOccupancyMaxActiveBlocksPerMultiprocessor(&per_cu, (const void*)mega, 512, LDS_BYTES) != hipSuccess || per_cu < 1) { fprintf(stderr, "kernel_launch: occupancy query says %d\n", per_cu); per_cu = 1; }
    (void)hipGetLastError();
    grid = cus * per_cu;
  }
  if (grid < 0) return;
  Params p{};
  for (int i = 0; i < 27; ++i) p.in[i] = (const float*)d_in[i];
  p.out = (float*)d_out; p.ws = (unsigned char*)d_ws;
#if N_LAUNCH_SPLIT
  for (int ph = 0; ph < PH_LIMIT; ++ph) { if (ph == SKIP_PH) continue; p.ph_lo = ph; p.ph_hi = ph + 1; hipLaunchKernelGGL(mega, dim3(grid), dim3(512), LDS_BYTES, stream, p); }
#else
  p.ph_lo = 0; p.ph_hi = NPH;
  (void)hipMemsetAsync((unsigned char*)d_ws + W_BAR, 0, 16384, stream);
  void* args[] = {&p};
  hipError_t e = hipLaunchCooperativeKernel((const void*)mega, dim3(grid), dim3(512), args, LDS_BYTES, stream);
  if (e != hipSuccess) fprintf(stderr, "kernel_launch: cooperative launch failed: %s (grid %d)\n", hipGetErrorString(e), grid);
#endif
}
```

```cpp
#include <hip/hip_runtime.h>
#include <hip/hip_cooperative_groups.h>
#include <cstdio>
#include <cstdint>
namespace cg = cooperative_groups;

#ifndef PH_LIMIT
#define PH_LIMIT 19
#endif
#ifndef SKIP_PH
#define SKIP_PH 99
#endif
#ifndef DBG_L0
#define DBG_L0 0
#endif
#ifndef DBG_SRC0
#define DBG_SRC0 0
#endif
#ifndef REPMASK
#define REPMASK 0
#endif
#ifndef EXTRA_SYNCS
#define EXTRA_SYNCS 0
#endif
#ifndef AMASK
#define AMASK 7
#endif
#ifndef KMASK
#define KMASK 511
#endif
#ifndef N_LAUNCH_SPLIT
#define N_LAUNCH_SPLIT 0
#endif

typedef unsigned short bf16_t;
typedef short bf16x8 __attribute__((ext_vector_type(8)));
typedef short s16x4 __attribute__((ext_vector_type(4)));
typedef float f32x4 __attribute__((ext_vector_type(4)));
typedef float f32x16 __attribute__((ext_vector_type(16)));
typedef unsigned u32x4 __attribute__((ext_vector_type(4)));
typedef unsigned u32x2 __attribute__((ext_vector_type(2)));
#define LAS __attribute__((address_space(3)))

constexpr int DM = 2048, NP = 8192, NS = 16384, NTOK = 24576;
constexpr int EVN = 5632, ODN = 3072, FF = 5632, FF2 = 11264;
constexpr int NPH = 19;
constexpr int LDS_BYTES = 135168;

enum { I_XP = 0, I_XS, I_C, I_CNAK, I_CNAV, I_CGK, I_CGV, I_CCTX, I_N1G, I_N2G, I_ADAW, I_ADAB, I_EVWIN, I_EVBIAS, I_EVFNET, I_EVWOUT,
       I_ODWIN, I_ODPOOLW, I_ODPOOLS, I_ODQG, I_ODKG, I_ODWOUT, I_FFUP, I_FFCW, I_FFCB, I_FFDN, I_FING };
constexpr size_t O_Y = 0, O_NAK = 50331648, O_NAV = 62914560, O_GK = 75497472, O_GV = 79691776;
constexpr size_t al256(size_t x) { return (x + 255) / 256 * 256; }
constexpr size_t W_PART = 0;
constexpr size_t W_FOLDM = W_PART + al256((size_t)2 * 2 * 9 * 12288 * 4);
constexpr size_t W_ROPE = W_FOLDM + al256((size_t)4 * 128 * 256 * 4);
constexpr size_t W_EVOUT = W_ROPE + al256((size_t)64 * 32 * 2 * 4);
constexpr size_t W_ODIN = W_EVOUT + (size_t)DM * DM * 2;
constexpr size_t W_ODOUT = W_ODIN + (size_t)ODN * DM * 2;
constexpr size_t W_UP = W_ODOUT + (size_t)DM * DM * 2;
constexpr size_t W_CGK = W_UP + (size_t)2 * FF2 * DM * 2;
constexpr size_t W_CGV = W_CGK + (size_t)8 * 256 * 512 * 2;
constexpr size_t W_EVIN = W_CGV + (size_t)8 * 256 * 512 * 2;
constexpr size_t W_XB = W_EVIN;
constexpr size_t W_DFTS = W_EVIN + (size_t)EVN * DM * 2;
constexpr size_t W_DFTC = W_DFTS + (size_t)2048 * 4096 * 2;
constexpr size_t W_CNAK = W_DFTC + (size_t)256 * 512 * 2;
constexpr size_t W_CNAV = W_CNAK + (size_t)8 * 256 * 1536 * 2;
constexpr size_t W_YTS = W_CNAV + (size_t)8 * 256 * 1536 * 2;
constexpr size_t W_YTC = W_YTS + (size_t)4096 * 4096 * 2;
static_assert(W_YTC + (size_t)16384 * 512 * 2 - W_XB >= (size_t)NTOK * DM * 2, "XB alias region too small");
constexpr size_t W_ACT = W_YTC + (size_t)16384 * 512 * 2;
constexpr size_t W_BIG = W_ACT + (size_t)NTOK * DM * 2;
constexpr size_t W_UB = W_BIG + (size_t)NTOK * EVN * 2;
constexpr size_t W_DN = W_UB + (size_t)384 * 4 * FF2 * 4;
constexpr size_t W_BAR = W_DN + (size_t)2 * DM * FF * 2;
constexpr size_t W_END = W_BAR + 16384;

struct Params { const float* in[27]; float* out; unsigned char* ws; int ph_lo, ph_hi; };

__device__ __forceinline__ unsigned cvtpk(float lo, float hi) { unsigned r; asm volatile("v_cvt_pk_bf16_f32 %0, %1, %2" : "=v"(r) : "v"(lo), "v"(hi)); return r; }
__device__ __forceinline__ float bf2f(bf16_t b) { return __uint_as_float(((unsigned)b) << 16); }
__device__ __forceinline__ float bflo(unsigned w) { return __uint_as_float(w << 16); }
__device__ __forceinline__ float bfhi(unsigned w) { return __uint_as_float(w & 0xffff0000u); }
__device__ __forceinline__ float wave_sum(float v) {
#pragma unroll
  for (int o = 32; o > 0; o >>= 1) v += __shfl_xor(v, o);
  return v;
}
__device__ __forceinline__ int tid_opaque() { int t = threadIdx.x; asm volatile("" : "+v"(t)); return t; }
__device__ __forceinline__ float silu_f(float x) { return x / (1.f + __expf(-x)); }
__device__ __forceinline__ float silu_fast(float x) { return x * __builtin_amdgcn_rcpf(1.f + __builtin_amdgcn_exp2f(x * -1.4426950408889634f)); }
__device__ __forceinline__ f32x4 modv4(const float* part, int l, int bidx, int k, int col) {
  const float* p0 = part + ((size_t)(l * 2 + 0) * 9 + bidx) * 12288 + k * 2048 + col;
  const float* p1 = part + ((size_t)(l * 2 + 1) * 9 + bidx) * 12288 + k * 2048 + col;
  return *(const f32x4*)p0 + *(const f32x4*)p1;
}

namespace pg8 {
constexpr int BM = 256, BK = 64, HALF = 128, HTB = HALF * BK * 2, STAGE_BYTES = 8 * HTB, NXCD = 8, WGM = 8;
__host__ __device__ __forceinline__ int lds_byte(int r, int c) { const int st = (r >> 4) * 2 + (c >> 5), rr = r & 15, cc = c & 31, ob = rr * 64 + cc * 2; return st * 1024 + (ob ^ (((ob >> 9) & 1) << 5)); }
__host__ __device__ __forceinline__ void stage_rc(int b, int& R, int& C) { const int st = b / 1024, sb = b % 1024, swz = sb ^ (((sb >> 9) & 1) << 5); R = (st >> 1) * 16 + swz / 64; C = (st & 1) * 32 + (swz % 64) / 2; }
__host__ __device__ __forceinline__ int perm32(int rho) { const int n = rho >> 4, i = rho & 15; return 8 * (i >> 2) + 4 * n + (i & 3); }
struct Unit { int pm, pn; };
struct Gemm { const bf16_t* A; const bf16_t* Bt; int M, N, K; };
struct StaticOrder {
  int nM, nN, nwg, G, c;
  __device__ void init(int M, int N, int G_, int c_) { nM = M / BM; nN = N / BM; nwg = nM * nN; G = G_; c = c_; }
  __device__ bool next(int i, Unit& u) const {
    const long L = (long)i * G + c; if (L >= nwg) return false;
    int wgid = (int)L; { const int q = nwg / NXCD, r = nwg % NXCD, xcd = wgid % NXCD, off = wgid / NXCD; wgid = (xcd < r ? xcd * (q + 1) : r * (q + 1) + (xcd - r) * q) + off; }
    const int nig = WGM * nN, gid = wgid / nig, fm = gid * WGM, gsz = (nM - fm) < WGM ? (nM - fm) : WGM;
    u.pm = fm + ((wgid % nig) % gsz); u.pn = (wgid % nig) / gsz; return true;
  }
};

template <class Epi>
__device__ __forceinline__ void gemm_phase(LAS unsigned char* lds, const Gemm g, const StaticOrder& S, const Epi& E) {
  const int tid = tid_opaque(), wid = __builtin_amdgcn_readfirstlane(tid >> 6), lane = tid & 63, wr = wid >> 2, wc = wid & 3, fr = lane & 15, fq = lane >> 4;
  const int K = g.K, nt = K / BK;
  unsigned voffA[2], voffB[2];
#pragma unroll
  for (int i = 0; i < 2; ++i) { int R, C; stage_rc(tid * 16 + i * 8192, R, C); const int Rb = Epi::PERM ? ((R & ~31) + perm32(R & 31)) : R;
    const int Ra = Epi::APERM ? ((R & ~63) + 4 * (R & 15) + ((R >> 4) & 3)) : R;
    voffA[i] = (unsigned)(Ra * K + C) * 2u; voffB[i] = (unsigned)(Rb * K + C) * 2u; }
  const size_t kstep = (size_t)(BK * 2);
  const size_t hstep = (size_t)HALF * K * 2;
  const size_t tstep = 2 * hstep;
  const unsigned ldsw = (unsigned)wid * 1024u;
  const int aoff = lds_byte(wr * 64 + fr, fq * 8), boff = lds_byte(wc * 32 + fr, fq * 8);
#define PG8_SA(b, h) (((b) * 2 + (h)) * HTB)
#define PG8_SB(b, h) ((4 + (b) * 2 + (h)) * HTB)
#define PG8_STAGE(bufoff, gbase, voff) do { _Pragma("unroll") for (int _i = 0; _i < 2; ++_i) \
    __builtin_amdgcn_global_load_lds((const unsigned*)((const char*)(gbase) + (voff)[_i]), (LAS unsigned*)(lds + (bufoff) + ldsw + _i * 8192), 16, 0, 0); } while (0)
#define PG8_LDA(dst, b, h) do { _Pragma("unroll") for (int m = 0; m < 4; ++m) _Pragma("unroll") for (int k = 0; k < 2; ++k) dst[m][k] = *(const LAS bf16x8*)(lds + PG8_SA(b, h) + aoff + m * 2048 + k * 1024); } while (0)
#define PG8_LDB(dst, b, h) do { _Pragma("unroll") for (int n = 0; n < 2; ++n) _Pragma("unroll") for (int k = 0; k < 2; ++k) dst[n][k] = *(const LAS bf16x8*)(lds + PG8_SB(b, h) + boff + n * 2048 + k * 1024); } while (0)
#define PG8_MMA(ai, bj, At, Bt) do { __builtin_amdgcn_s_setprio(1); _Pragma("unroll") for (int m = 0; m < 4; ++m) _Pragma("unroll") for (int n = 0; n < 2; ++n) _Pragma("unroll") for (int k = 0; k < 2; ++k) \
    acc[ai][bj][m][n] = __builtin_amdgcn_mfma_f32_16x16x32_bf16(Bt[n][k], At[m][k], acc[ai][bj][m][n], 0, 0, 0); __builtin_amdgcn_s_setprio(0); } while (0)
#define PG8_WAIT_V(n) asm volatile("s_waitcnt vmcnt(" #n ")" ::: "memory")
#define PG8_WAIT_L(n) asm volatile("s_waitcnt lgkmcnt(" #n ")" ::: "memory")
#define PG8_BAR __builtin_amdgcn_s_barrier()
#define PG8_SCHED __builtin_amdgcn_sched_barrier(0)
  Unit cur, nxt; int ui = 0;
  if (!S.next(0, cur)) return;
  f32x4 acc[2][2][4][2];
#pragma unroll
  for (int a = 0; a < 2; ++a)
#pragma unroll
    for (int b = 0; b < 2; ++b)
#pragma unroll
      for (int m = 0; m < 4; ++m)
#pragma unroll
        for (int n = 0; n < 2; ++n) acc[a][b][m][n] = (f32x4){0.f, 0.f, 0.f, 0.f};
  bf16x8 At[4][2], B0[2][2], B1[2][2];
  const char* cA = (const char*)g.A + (size_t)cur.pm * tstep; const char* cB = (const char*)g.Bt + (size_t)cur.pn * tstep;
  PG8_STAGE(PG8_SB(0, 0), cB, voffB); PG8_STAGE(PG8_SA(0, 0), cA, voffA); PG8_STAGE(PG8_SB(0, 1), cB + hstep, voffB); PG8_STAGE(PG8_SA(0, 1), cA + hstep, voffA);
  if (wr == 1) PG8_BAR;
  PG8_WAIT_V(4); PG8_BAR;
  PG8_STAGE(PG8_SB(1, 0), cB + kstep, voffB); PG8_STAGE(PG8_SA(1, 0), cA + kstep, voffA); PG8_STAGE(PG8_SB(1, 1), cB + hstep + kstep, voffB);
  PG8_WAIT_V(6); PG8_BAR;
  for (;;) {
    const bool has_next = S.next(ui + 1, nxt);
    const char* nA = has_next ? (const char*)g.A + (size_t)nxt.pm * tstep : cA; const char* nB = has_next ? (const char*)g.Bt + (size_t)nxt.pn * tstep : cB;
    for (int t = 0; t < nt; t += 2) {
      const bool last = (t == nt - 2);
      const char* a1 = cA + (size_t)(t + 1) * kstep;
      const char* a2 = last ? nA : cA + (size_t)(t + 2) * kstep; const char* b2 = last ? nB : cB + (size_t)(t + 2) * kstep;
      const char* a3 = a2 + kstep; const char* b3 = b2 + kstep;
      PG8_LDB(B0, 0, 0); PG8_SCHED; PG8_LDA(At, 0, 0); PG8_STAGE(PG8_SA(1, 1), a1 + hstep, voffA);
      PG8_WAIT_L(8); PG8_BAR; PG8_WAIT_L(0); PG8_MMA(0, 0, At, B0); PG8_BAR; PG8_SCHED;
      PG8_LDB(B1, 0, 1); PG8_STAGE(PG8_SB(0, 0), b2, voffB);
      PG8_BAR; PG8_WAIT_L(0); PG8_MMA(0, 1, At, B1); PG8_BAR;
      PG8_LDA(At, 0, 1); PG8_STAGE(PG8_SA(0, 0), a2, voffA);
      PG8_BAR; PG8_WAIT_L(0); PG8_MMA(1, 0, At, B0); PG8_BAR; PG8_SCHED;
      PG8_STAGE(PG8_SB(0, 1), b2 + hstep, voffB);
      PG8_WAIT_V(6); PG8_BAR; PG8_MMA(1, 1, At, B1); PG8_BAR;
      PG8_LDB(B0, 1, 0); PG8_SCHED; PG8_LDA(At, 1, 0); PG8_STAGE(PG8_SA(0, 1), a2 + hstep, voffA);
      PG8_WAIT_L(8); PG8_BAR; PG8_WAIT_L(0); PG8_MMA(0, 0, At, B0); PG8_BAR; PG8_SCHED;
      PG8_LDB(B1, 1, 1); PG8_STAGE(PG8_SB(1, 0), b3, voffB);
      PG8_BAR; PG8_WAIT_L(0); PG8_MMA(0, 1, At, B1); PG8_BAR;
      PG8_LDA(At, 1, 1); PG8_STAGE(PG8_SA(1, 0), a3, voffA);
      PG8_BAR; PG8_WAIT_L(0); PG8_MMA(1, 0, At, B0); PG8_BAR; PG8_SCHED;
      PG8_STAGE(PG8_SB(1, 1), b3 + hstep, voffB);
      PG8_WAIT_V(6); PG8_BAR; PG8_MMA(1, 1, At, B1); PG8_BAR;
    }
    E(acc, cur, wr, wc, fr, fq);
    if (!has_next) break;
#pragma unroll
    for (int a = 0; a < 2; ++a)
#pragma unroll
      for (int b = 0; b < 2; ++b)
#pragma unroll
        for (int m = 0; m < 4; ++m)
#pragma unroll
          for (int n = 0; n < 2; ++n) acc[a][b][m][n] = (f32x4){0.f, 0.f, 0.f, 0.f};
    cur = nxt; cA = nA; cB = nB; ++ui;
  }
  PG8_WAIT_V(0);
  if (wr == 0) PG8_BAR;
  PG8_BAR;
#undef PG8_SA
#undef PG8_SB
#undef PG8_STAGE
#undef PG8_LDA
#undef PG8_LDB
#undef PG8_MMA
#undef PG8_WAIT_V
#undef PG8_WAIT_L
#undef PG8_BAR
#undef PG8_SCHED
}
}
using pg8::Unit;
typedef f32x4 AccT[2][2][4][2];

struct EpiIn {
  static constexpr bool PERM = true; static constexpr bool APERM = false;
  bf16_t* O; int ldc; int even; float* out; bf16_t* yts; bf16_t* ytc;
  __device__ __forceinline__ void operator()(const AccT& acc, const Unit& u, int wr, int wc, int fr, int fq) const {
    const int row0 = u.pm * 256 + wr * 64 + fr;
    if (even && u.pn >= 18) {
      const int g = u.pn - 18;
      bf16_t* base; size_t rs; int half, pos0;
      if (u.pm < 32) { base = ytc + (size_t)((u.pm * 4 + g) * 128) * 512; rs = 512; half = 256; pos0 = wr * 64 + fr; }
      else { const int b = (u.pm - 32) >> 3; base = yts + (size_t)((b * 4 + g) * 128) * 4096; rs = 4096; half = 2048; pos0 = ((u.pm - 32) & 7) * 256 + wr * 64 + fr; }
#pragma unroll
      for (int ai = 0; ai < 2; ++ai)
#pragma unroll
        for (int m = 0; m < 4; ++m) { const int pos = pos0 + ai * 128 + m * 16;
#pragma unroll
          for (int bj = 0; bj < 2; ++bj)
#pragma unroll
            for (int n = 0; n < 2; ++n)
#pragma unroll
              for (int j = 0; j < 4; ++j) { const int d = wc * 32 + 8 * fq + 4 * n + j;
                base[(size_t)d * rs + bj * half + pos] = (bf16_t)(cvtpk(acc[ai][bj][m][n][j], 0.f) & 0xffffu); } }
      return;
    }
    const int col0 = u.pn * 256 + wc * 32 + 8 * fq;
    float* side = nullptr; int sld = 0;
    if (u.pm < 32) {
      if (even) { if (u.pn >= 6 && u.pn < 12) { side = out + O_NAK + (col0 - 1536); sld = 1536; } else if (u.pn >= 12) { side = out + O_NAV + (col0 - 3072); sld = 1536; } }
      else if (u.pn >= 10) { side = out + O_GV + (col0 - 2560); sld = 512; }
    }
#pragma unroll
    for (int ai = 0; ai < 2; ++ai)
#pragma unroll
      for (int m = 0; m < 4; ++m) { const int row = row0 + ai * 128 + m * 16; bf16_t* rowp = O + (size_t)row * ldc + col0;
#pragma unroll
        for (int bj = 0; bj < 2; ++bj) { const f32x4 v0 = acc[ai][bj][m][0], v1 = acc[ai][bj][m][1];
          u32x4 w = {cvtpk(v0[0], v0[1]), cvtpk(v0[2], v0[3]), cvtpk(v1[0], v1[1]), cvtpk(v1[2], v1[3])};
          *(u32x4*)(rowp + bj * 128) = w;
          if (side) { float* sp = side + (size_t)row * sld + bj * 128; *(f32x4*)sp = v0; *(f32x4*)(sp + 4) = v1; } } }
  }
};
struct EpiRes {
  static constexpr bool PERM = true; static constexpr bool APERM = false;
  const float* xp; const float* xs; bf16_t* xb; bf16_t* xo; const float* part; int layer, gk; int from_in;
  __device__ __forceinline__ void operator()(const AccT& acc, const Unit& u, int wr, int wc, int fr, int fq) const {
    const int bidx = u.pm < 32 ? 8 : ((u.pm - 32) >> 3);
    const int row0 = u.pm * 256 + wr * 64 + fr, col0 = u.pn * 256 + wc * 32 + 8 * fq;
    const float* xin = u.pm < 32 ? xp : (xs - (size_t)NP * DM);
    f32x4 gv[2][2];
#pragma unroll
    for (int bj = 0; bj < 2; ++bj)
#pragma unroll
      for (int n = 0; n < 2; ++n) gv[bj][n] = modv4(part, layer, bidx, gk, col0 + bj * 128 + n * 4);
#pragma unroll
    for (int ai = 0; ai < 2; ++ai)
#pragma unroll
      for (int m = 0; m < 4; ++m) { const size_t ro = (size_t)(row0 + ai * 128 + m * 16) * DM + col0;
#pragma unroll
        for (int bj = 0; bj < 2; ++bj) { f32x4 x0, x1;
          if (from_in) { x0 = *(const f32x4*)(xin + ro + bj * 128); x1 = *(const f32x4*)(xin + ro + bj * 128 + 4); }
          else { const u32x4 w = *(const u32x4*)(xb + ro + bj * 128); x0 = (f32x4){bflo(w[0]), bfhi(w[0]), bflo(w[1]), bfhi(w[1])}; x1 = (f32x4){bflo(w[2]), bfhi(w[2]), bflo(w[3]), bfhi(w[3])}; }
          x0 = x0 + gv[bj][0] * acc[ai][bj][m][0]; x1 = x1 + gv[bj][1] * acc[ai][bj][m][1];
          u32x4 o = {cvtpk(x0[0], x0[1]), cvtpk(x0[2], x0[3]), cvtpk(x1[0], x1[1]), cvtpk(x1[2], x1[3])};
          *(u32x4*)(xo + ro + bj * 128) = o; } }
  }
};
__device__ __forceinline__ float dpp_ror1(float v) { return __builtin_bit_cast(float, __builtin_amdgcn_update_dpp(0, __builtin_bit_cast(int, v), 0x121, 0xf, 0xf, false)); }
__device__ __forceinline__ float dpp_rol1(float v) { return __builtin_bit_cast(float, __builtin_amdgcn_update_dpp(0, __builtin_bit_cast(int, v), 0x12F, 0xf, 0xf, false)); }
struct EpiUp {
  static constexpr bool PERM = true; static constexpr bool APERM = true;
  bf16_t* G; float* UB; const float* cw; const float* cb;
  __device__ __forceinline__ void operator()(const AccT& acc, const Unit& u, int wr, int wc, int fr, int fq) const {
    const int cc0 = wc * 32 + 8 * fq;
    const int chv = u.pn * 128 + cc0;
    unsigned gp[2][4][4];
#pragma unroll
    for (int n = 0; n < 2; ++n) {
      const int ch = chv + 4 * n;
      f32x4 cwv[1][8];
      cwv[0][0] = *(const f32x4*)(cw + ch); cwv[0][1] = *(const f32x4*)(cw + FF2 + ch); cwv[0][2] = *(const f32x4*)(cw + 2 * FF2 + ch); cwv[0][3] = *(const f32x4*)(cb + ch);
      cwv[0][4] = *(const f32x4*)(cw + FF + ch); cwv[0][5] = *(const f32x4*)(cw + FF2 + FF + ch); cwv[0][6] = *(const f32x4*)(cw + 2 * FF2 + FF + ch); cwv[0][7] = *(const f32x4*)(cb + FF + ch);
      const f32x4 v0 = cwv[0][0] * -0.6931471805599453f, v1 = cwv[0][1] * -0.6931471805599453f, v2 = cwv[0][2] * -0.6931471805599453f, vb = cwv[0][3] * -0.6931471805599453f;
      const f32x4 g0 = cwv[0][4] * -1.4426950408889634f, g1 = cwv[0][5] * -1.4426950408889634f, g2 = cwv[0][6] * -1.4426950408889634f, gb = cwv[0][7] * -1.4426950408889634f;
#pragma unroll
      for (int ai = 0; ai < 2; ++ai) {
        const int chunk = u.pm * 4 + ai * 2 + wr;
        f32x4 o[4];
        {
          const f32x4 a0 = acc[ai][0][0][n], a1 = acc[ai][0][1][n], a2 = acc[ai][0][2][n], a3 = acc[ai][0][3][n];
          const f32x4 b0 = acc[ai][1][0][n], b1 = acc[ai][1][1][n], b2 = acc[ai][1][2][n], b3 = acc[ai][1][3][n];
          f32x4 au, ad, bu, bd;
#pragma unroll
          for (int j = 0; j < 4; ++j) { au[j] = dpp_ror1(a3[j]); ad[j] = dpp_rol1(a0[j]); bu[j] = dpp_ror1(b3[j]); bd[j] = dpp_rol1(b0[j]); }
          f32x4 vv[4], gg[4];
          vv[0] = v0 * au + v1 * a0 + v2 * a1 + vb; vv[1] = v0 * a0 + v1 * a1 + v2 * a2 + vb; vv[2] = v0 * a1 + v1 * a2 + v2 * a3 + vb; vv[3] = v0 * a2 + v1 * a3 + v2 * ad + vb;
          gg[0] = g0 * bu + g1 * b0 + g2 * b1 + gb; gg[1] = g0 * b0 + g1 * b1 + g2 * b2 + gb; gg[2] = g0 * b1 + g1 * b2 + g2 * b3 + gb; gg[3] = g0 * b2 + g1 * b3 + g2 * bd + gb;
#pragma unroll
          for (int m = 0; m < 4; ++m) { f32x4 e, r;
#pragma unroll
            for (int j = 0; j < 4; ++j) e[j] = __builtin_amdgcn_exp2f(gg[m][j]);
            e = e + 1.f;
#pragma unroll
            for (int j = 0; j < 4; ++j) r[j] = __builtin_amdgcn_rcpf(e[j]);
            o[m] = (vv[m] * gg[m]) * r; }
        }
#pragma unroll
        for (int m = 0; m < 4; ++m) { gp[ai][m][n * 2 + 0] = cvtpk(o[m][0], o[m][1]); gp[ai][m][n * 2 + 1] = cvtpk(o[m][2], o[m][3]); }
        if (fr == 0 || fr == 15) {
          float* ub = UB + ((size_t)chunk * 4 + (fr ? 2 : 0)) * FF2 + u.pn * 256 + cc0 + 4 * n;
          if (fr == 0) { *(f32x4*)ub = acc[ai][0][0][n]; *(f32x4*)(ub + 128) = acc[ai][1][0][n]; *(f32x4*)(ub + FF2) = acc[ai][0][1][n]; *(f32x4*)(ub + FF2 + 128) = acc[ai][1][1][n]; }
          else { *(f32x4*)ub = acc[ai][0][2][n]; *(f32x4*)(ub + 128) = acc[ai][1][2][n]; *(f32x4*)(ub + FF2) = acc[ai][0][3][n]; *(f32x4*)(ub + FF2 + 128) = acc[ai][1][3][n]; }
        }
      }
    }
#pragma unroll
    for (int ai = 0; ai < 2; ++ai) {
      const int rowc = (u.pm * 4 + ai * 2 + wr) * 64;
#pragma unroll
      for (int m = 0; m < 4; ++m) {
        const bool skip = (m == 0 && fr == 0) || (m == 3 && fr == 15);
        if (!skip) { u32x4 w = {gp[ai][m][0], gp[ai][m][1], gp[ai][m][2], gp[ai][m][3]}; *(u32x4*)(G + (size_t)(rowc + 4 * fr + m) * FF + chv) = w; }
      }
    }
  }
};
struct EpiFourier {
  static constexpr bool PERM = true; static constexpr bool APERM = false;
  bf16_t* mix; int rowbase, npos; float scale;
  __device__ __forceinline__ void operator()(const AccT& acc, const Unit& u, int wr, int wc, int fr, int fq) const {
    const int pos0 = u.pm * 256 + wr * 64 + fr;
#pragma unroll
    for (int bj = 0; bj < 2; ++bj) {
      const int col = u.pn * 256 + bj * 128 + wc * 32 + 8 * fq; const int b = col >> 9, gd = col & 511;
      bf16_t* basep = mix + (size_t)(rowbase + b * npos) * DM + 1536 + gd;
#pragma unroll
      for (int ai = 0; ai < 2; ++ai)
#pragma unroll
        for (int m = 0; m < 4; ++m) { const f32x4 v0 = acc[ai][bj][m][0] * scale, v1 = acc[ai][bj][m][1] * scale;
          u32x4 w = {cvtpk(v0[0], v0[1]), cvtpk(v0[2], v0[3]), cvtpk(v1[0], v1[1]), cvtpk(v1[2], v1[3])};
          *(u32x4*)(basep + (size_t)(pos0 + ai * 128 + m * 16) * DM) = w; }
    }
  }
};

namespace at {
constexpr int D = 128, NW = 8, QBLK = 32, KVBLK = 64;
constexpr float SCALE = 0.088388347648318440f;
constexpr float THR = 8.f;
constexpr size_t SHM_V = KVBLK * D * 2, SHM_K = KVBLK * D * 2, SHM_ATTN = 2 * SHM_V + 2 * SHM_K + NW * 64 * 4;
#define KSWZ(row, colB) ((row) * 256 + ((colB) ^ (((row) & 7) << 4)))
#define SBAR() __builtin_amdgcn_sched_barrier(0)
__device__ __forceinline__ int crow(int r, int hi) { return (r & 3) + 8 * (r >> 2) + 4 * hi; }
__device__ __forceinline__ void partialSM(f32x16& p0, f32x16& p1, float& m_reg, float& mn, float& alpha) {
  constexpr float C = SCALE * 1.4426950408889634f;
  float pmax = p0[0];
#pragma unroll
  for (int r = 1; r < 16; ++r) pmax = fmaxf(pmax, p0[r]);
#pragma unroll
  for (int r = 0; r < 16; ++r) pmax = fmaxf(pmax, p1[r]);
  { auto rr = __builtin_amdgcn_permlane32_swap(__float_as_uint(pmax), __float_as_uint(pmax), false, false);
    pmax = fmaxf(__uint_as_float(rr[0]), __uint_as_float(rr[1])); }
  if (__builtin_expect(__all(pmax - m_reg <= THR / SCALE), 1)) { mn = m_reg; alpha = 1.f; }
  else { mn = fmaxf(m_reg, pmax); alpha = __builtin_amdgcn_exp2f((m_reg - mn) * C); m_reg = mn; }
  float mnC = -mn * C;
  p0 = p0 * C + mnC; p1 = p1 * C + mnC;
#pragma unroll
  for (int r = 0; r < 16; ++r) p0[r] = __builtin_amdgcn_exp2f(p0[r]);
}
__device__ __forceinline__ void finishSM(f32x16& p0, f32x16& p1, float alpha, float& l_reg, bf16x8& pa0, bf16x8& pa1, bf16x8& pa2, bf16x8& pa3) {
#pragma unroll
  for (int r = 0; r < 16; ++r) p1[r] = __builtin_amdgcn_exp2f(p1[r]);
  float ps;
  { typedef float f32x8 __attribute__((ext_vector_type(8))); typedef float f32x2v __attribute__((ext_vector_type(2)));
    const f32x16 s16 = p0 + p1; const f32x8 s8 = s16.lo + s16.hi; const f32x4 s4 = s8.lo + s8.hi; const f32x2v s2 = s4.lo + s4.hi; ps = s2.x + s2.y; }
  { auto rr = __builtin_amdgcn_permlane32_swap(__float_as_uint(ps), __float_as_uint(ps), false, false);
    ps = __uint_as_float(rr[0]) + __uint_as_float(rr[1]); }
  l_reg = l_reg * alpha + ps;
#define PK4(P, BASE, OUT) do { unsigned a0 = cvtpk(P[BASE + 0], P[BASE + 1]), a1 = cvtpk(P[BASE + 2], P[BASE + 3]);   \
    unsigned b0 = cvtpk(P[BASE + 4], P[BASE + 5]), b1 = cvtpk(P[BASE + 6], P[BASE + 7]);                              \
    auto r0 = __builtin_amdgcn_permlane32_swap(a0, b0, false, false); auto r1 = __builtin_amdgcn_permlane32_swap(a1, b1, false, false); \
    u32x4 w = {r0[0], r1[0], r0[1], r1[1]}; OUT = *reinterpret_cast<bf16x8*>(&w); } while (0)
  PK4(p0, 0, pa0); PK4(p0, 8, pa1); PK4(p1, 0, pa2); PK4(p1, 8, pa3);
#undef PK4
}
__device__ __forceinline__ void qkt(f32x16& p0, f32x16& p1, const char* Ks, const bf16x8* qr, int r32, int hi) {
  p0 = f32x16{}; p1 = f32x16{};
#pragma unroll
  for (int d0 = 0; d0 < 8; ++d0) { int cb = (d0 * 16 + hi * 8) * 2;
    bf16x8 b0 = *reinterpret_cast<const bf16x8*>(Ks + KSWZ(r32, cb));
    bf16x8 b1 = *reinterpret_cast<const bf16x8*>(Ks + KSWZ(32 + r32, cb));
    p0 = __builtin_amdgcn_mfma_f32_32x32x16_bf16(b0, qr[d0], p0, 0, 0, 0);
    p1 = __builtin_amdgcn_mfma_f32_32x32x16_bf16(b1, qr[d0], p1, 0, 0, 0); }
}
__device__ __forceinline__ int v_st(int k, int c) { const int kk = (k & ~0xC) | ((k & 4) << 1) | ((k & 8) >> 1); return ((kk >> 3) * 4 + (c >> 5)) * 512 + ((kk & 7) * 32 + (c & 31)) * 2; }
__device__ __forceinline__ int v_rd_base(int lane) { return ((lane & 3) << 3) | (((lane >> 2) & 3) << 6) | (((lane >> 4) & 1) << 5) | (((lane >> 5) & 1) << 8); }
constexpr int v_rd_off(int d0, int ks, int half) { return d0 * 512 + ks * 4096 + half * 2048; }
template <int OFF> __device__ __forceinline__ s16x4 tr_read(int vb) {
  s16x4 r; asm volatile("ds_read_b64_tr_b16 %0, %1 offset:%2" : "=&v"(r) : "v"(vb), "i"(OFF) : "memory"); return r;
}
template <int D0> __device__ __forceinline__ void pv_one(f32x16& od, int vb, bf16x8 pa0, bf16x8 pa1, bf16x8 pa2, bf16x8 pa3) {
  const s16x4 l0 = tr_read<v_rd_off(D0, 0, 0)>(vb), h0 = tr_read<v_rd_off(D0, 0, 1)>(vb), l1 = tr_read<v_rd_off(D0, 1, 0)>(vb), h1 = tr_read<v_rd_off(D0, 1, 1)>(vb);
  const s16x4 l2 = tr_read<v_rd_off(D0, 2, 0)>(vb), h2 = tr_read<v_rd_off(D0, 2, 1)>(vb), l3 = tr_read<v_rd_off(D0, 3, 0)>(vb), h3 = tr_read<v_rd_off(D0, 3, 1)>(vb);
  asm volatile("s_waitcnt lgkmcnt(0)" ::: "memory"); SBAR();
#define PK(L, H) (bf16x8){L[0], L[1], L[2], L[3], H[0], H[1], H[2], H[3]}
  od = __builtin_amdgcn_mfma_f32_32x32x16_bf16(pa0, PK(l0, h0), od, 0, 0, 0);
  od = __builtin_amdgcn_mfma_f32_32x32x16_bf16(pa1, PK(l1, h1), od, 0, 0, 0);
  od = __builtin_amdgcn_mfma_f32_32x32x16_bf16(pa2, PK(l2, h2), od, 0, 0, 0);
  od = __builtin_amdgcn_mfma_f32_32x32x16_bf16(pa3, PK(l3, h3), od, 0, 0, 0);
#undef PK
}
__device__ __forceinline__ void pv_d0(f32x16* o, int vb, bf16x8 pa0, bf16x8 pa1, bf16x8 pa2, bf16x8 pa3) {
  pv_one<0>(o[0], vb, pa0, pa1, pa2, pa3); pv_one<1>(o[1], vb, pa0, pa1, pa2, pa3); pv_one<2>(o[2], vb, pa0, pa1, pa2, pa3); pv_one<3>(o[3], vb, pa0, pa1, pa2, pa3);
}
struct Desc {
  const bf16_t* Q; int ldq;
  const bf16_t* K0; const bf16_t* V0; int ld0, n0;
  const bf16_t* K1; const bf16_t* V1; int ld1;
  int seq;
  bf16_t* O; int ldo;
  int ks, qrow0;
};
template <int MODE> __device__ __forceinline__ void na_mask(f32x16& p0, f32x16& p1, int t, const Desc& d, int wid, int r32, int hi, const float* btab) {
  if constexpr (MODE == 1) {
    if (t >= 4) {
      const int kr = d.ks + t - 4, qrow = d.qrow0 + (wid >> 1), qc = (wid & 1) * 32 + r32;
      const int r0q = min(max(qrow - 4, 0), 24);
      const bool rowok = (kr >= r0q) && (kr < r0q + 8);
      if (rowok) {
        const int qs = min(max(qc - 8, 0), 48);
        const float* brow = btab + (kr - qrow + 7) * 31 + (15 - qc + 4 * hi);
        const int kb = 4 * hi - qs;
#pragma unroll
        for (int rg = 0; rg < 4; ++rg) {
#pragma unroll
          for (int r = rg * 4; r < rg * 4 + 4; ++r) {
            const int kc = (r & 3) + 8 * (r >> 2);
            const bool ok0 = ((unsigned)(kc + kb) < 16u);
            const float b0 = brow[kc];
            p0[r] = ok0 ? p0[r] + b0 : -1e30f;
          }
          SBAR();
        }
#pragma unroll
        for (int rg = 0; rg < 4; ++rg) {
#pragma unroll
          for (int r = rg * 4; r < rg * 4 + 4; ++r) {
            const int kc = (r & 3) + 8 * (r >> 2);
            const bool ok1 = ((unsigned)(kc + 32 + kb) < 16u);
            const float b1 = brow[kc + 32];
            p1[r] = ok1 ? p1[r] + b1 : -1e30f;
          }
          SBAR();
        }
      } else {
#pragma unroll
        for (int r = 0; r < 16; ++r) { p0[r] = -1e30f; p1[r] = -1e30f; }
      }
    }
  }
}
template <int MODE>
__device__ __forceinline__ void attn_body(const Desc& d, char* lds) {
  const int tid = tid_opaque(), wid = tid >> 6, lane = tid & 63, r32 = lane & 31, hi = lane >> 5;
  char* V_lds = lds; char* K_lds = lds + 2 * SHM_V;
  float* ws = (float*)(lds + 2 * SHM_V + 2 * SHM_K) + wid * 64; float* li_l = ws; float* al_l = ws + 32;
  const float* btab = (const float*)(lds + SHM_ATTN) + 64;
  float m_reg = -1e30f, l_reg = 0; f32x16 o[4] = {}; bf16x8 qr[8];
  const bf16_t* Qw = d.Q + (long)(wid * QBLK + r32) * d.ldq + hi * 8;
#pragma unroll
  for (int d0 = 0; d0 < 8; ++d0) qr[d0] = *reinterpret_cast<const bf16x8*>(Qw + d0 * 16);
  const int sr = tid >> 4, sc = (tid & 15) * 8, vst0 = v_st(sr, sc), vst1 = v_st(32 + sr, sc);
  const int vb0 = (int)(uintptr_t)V_lds + v_rd_base(lane);
  constexpr int SDEPTH = (MODE == 1) ? 1 : 2;
  struct { bf16x8 vs0, vs1, ks0, ks1; } sr_[SDEPTH];
  const unsigned vo0a = (unsigned)(sr * d.ld0 + sc) * 2u, vo0b = (unsigned)((sr + 32) * d.ld0 + sc) * 2u, vo1a = (unsigned)(sr * d.ld1 + sc) * 2u, vo1b = (unsigned)((sr + 32) * d.ld1 + sc) * 2u;
#define SLOAD(i, k0) do { const bool s0_ = (k0) < d.n0; \
    const char* kb_ = s0_ ? (const char*)d.K0 + (size_t)(k0) * d.ld0 * 2 : (const char*)d.K1 + (size_t)((k0) - d.n0) * d.ld1 * 2; \
    const char* vb_ = s0_ ? (const char*)d.V0 + (size_t)(k0) * d.ld0 * 2 : (const char*)d.V1 + (size_t)((k0) - d.n0) * d.ld1 * 2; \
    const unsigned oa_ = s0_ ? vo0a : vo1a, ob_ = s0_ ? vo0b : vo1b; \
    sr_[i].vs0 = *reinterpret_cast<const bf16x8*>(vb_ + oa_); sr_[i].vs1 = *reinterpret_cast<const bf16x8*>(vb_ + ob_); \
    sr_[i].ks0 = *reinterpret_cast<const bf16x8*>(kb_ + oa_); sr_[i].ks1 = *reinterpret_cast<const bf16x8*>(kb_ + ob_); } while (0)
#define SWRITE(b, i) do { *(bf16x8*)(V_lds + (b) * SHM_V + vst0) = sr_[i].vs0;          \
    *(bf16x8*)(V_lds + (b) * SHM_V + vst1) = sr_[i].vs1; int kc = sc * 2;               \
    *(bf16x8*)(K_lds + (b) * SHM_K + KSWZ(sr, kc)) = sr_[i].ks0;                       \
    *(bf16x8*)(K_lds + (b) * SHM_K + KSWZ(32 + sr, kc)) = sr_[i].ks1; } while (0)
#define SWAIT() do { if constexpr (SDEPTH == 2) asm volatile("s_waitcnt vmcnt(4)" ::: "memory"); else asm volatile("s_waitcnt vmcnt(0)" ::: "memory"); } while (0)
#define RESC(a) do { if (__any((a) < 1.f)) { if (hi == 0) al_l[r32] = (a); asm volatile("s_waitcnt lgkmcnt(0)" ::: "memory"); \
    _Pragma("unroll") for (int dd = 0; dd < 4; ++dd) _Pragma("unroll") for (int r = 0; r < 16; ++r) o[dd][r] *= al_l[crow(r, hi)]; } } while (0)
  f32x16 pA0, pA1, pB0, pB1; float mnA, mnB, alA, alB; bf16x8 pa0, pa1, pa2, pa3; const int NT = d.seq / KVBLK;
  constexpr int SE = 0, SO = SDEPTH - 1;
  SLOAD(SE, 0); asm volatile("s_waitcnt vmcnt(0)" ::: "memory"); SWRITE(0, SE); __syncthreads();
  qkt(pA0, pA1, K_lds, qr, r32, hi); na_mask<MODE>(pA0, pA1, 0, d, wid, r32, hi, btab); partialSM(pA0, pA1, m_reg, mnA, alA);
  SLOAD(SO, KVBLK); if constexpr (SDEPTH == 2) { if (2 < NT) SLOAD(SE, 2 * KVBLK); }
  SWAIT(); SWRITE(1, SO); if constexpr (SDEPTH == 1) { if (2 < NT) SLOAD(SE, 2 * KVBLK); } __syncthreads();
  for (int j = 1; j + 1 < NT; j += 2) {
    SBAR(); qkt(pB0, pB1, K_lds + SHM_K, qr, r32, hi); na_mask<MODE>(pB0, pB1, j, d, wid, r32, hi, btab);
    finishSM(pA0, pA1, alA, l_reg, pa0, pa1, pa2, pa3); SBAR();
    if constexpr (SDEPTH == 2) SLOAD(SO, (j + SDEPTH) * KVBLK); SBAR();
    pv_d0(o, vb0, pa0, pa1, pa2, pa3); partialSM(pB0, pB1, m_reg, mnB, alB);
    __syncthreads(); SWAIT(); SWRITE(0, SE); if constexpr (SDEPTH == 1) SLOAD(SE, (j + 2) * KVBLK);
    RESC(alB); __syncthreads();
    SBAR(); qkt(pA0, pA1, K_lds, qr, r32, hi); na_mask<MODE>(pA0, pA1, j + 1, d, wid, r32, hi, btab);
    finishSM(pB0, pB1, alB, l_reg, pa0, pa1, pa2, pa3); SBAR();
    if constexpr (SDEPTH == 2) { if (j + 3 < NT) SLOAD(SE, (j + 3) * KVBLK); } SBAR();
    pv_d0(o, vb0 + (int)SHM_V, pa0, pa1, pa2, pa3); partialSM(pA0, pA1, m_reg, mnA, alA);
    __syncthreads(); SWAIT(); SWRITE(1, SO); if constexpr (SDEPTH == 1) { if (j + 3 < NT) SLOAD(SO, (j + 3) * KVBLK); }
    RESC(alA); __syncthreads();
  }
  SBAR(); qkt(pB0, pB1, K_lds + SHM_K, qr, r32, hi); na_mask<MODE>(pB0, pB1, NT - 1, d, wid, r32, hi, btab);
  finishSM(pA0, pA1, alA, l_reg, pa0, pa1, pa2, pa3); SBAR();
  pv_d0(o, vb0, pa0, pa1, pa2, pa3); partialSM(pB0, pB1, m_reg, mnB, alB);
  __syncthreads(); RESC(alB);
  finishSM(pB0, pB1, alB, l_reg, pa0, pa1, pa2, pa3); SBAR();
  pv_d0(o, vb0 + (int)SHM_V, pa0, pa1, pa2, pa3);
  if (hi == 0) li_l[r32] = l_reg; asm volatile("s_waitcnt lgkmcnt(0)" ::: "memory");
  float rli[16];
#pragma unroll
  for (int r = 0; r < 16; ++r) rli[r] = __builtin_amdgcn_rcpf(li_l[crow(r, hi)]);
  bf16_t* Ow = d.O + (long)(wid * QBLK) * DM;
#pragma unroll
  for (int r = 0; r < 16; ++r) { int orow = crow(r, hi);
#pragma unroll
    for (int d0 = 0; d0 < 4; ++d0) Ow[(long)orow * DM + d0 * 32 + r32] = (bf16_t)(cvtpk(o[d0][r] * rli[r], 0.f) & 0xffffu); }
#undef SLOAD
#undef SWRITE
#undef SWAIT
#undef RESC
}
}

__device__ __forceinline__ void ada_item(const Params& p, int item, unsigned char* shm) {
  const int tid = tid_opaque(), wid = tid >> 6, lane = tid & 63;
  const int layer = item / 96, r = item % 96, kh = r / 48, cb = r % 48;
  float* sc = (float*)shm;
  float* red = (float*)shm + 9 * 1024;
  __syncthreads();
  for (int i = tid; i < 9 * 1024; i += 512) { const int rr = i >> 10, kk = i & 1023;
    const float v = rr < 8 ? p.in[I_C][rr * 2048 + kh * 1024 + kk] : p.in[I_CCTX][kh * 1024 + kk]; sc[i] = silu_f(v); }
  __syncthreads();
  const float* W = p.in[I_ADAW] + ((size_t)layer * 2048 + kh * 1024 + wid * 128) * 12288 + cb * 256 + lane * 4;
  f32x4 acc[9];
#pragma unroll
  for (int i = 0; i < 9; ++i) acc[i] = (f32x4){0.f, 0.f, 0.f, 0.f};
  for (int k = 0; k < 128; k += 8) {
    f32x4 w[8];
#pragma unroll
    for (int u = 0; u < 8; ++u) w[u] = *(const f32x4*)(W + (size_t)(k + u) * 12288);
#pragma unroll
    for (int u = 0; u < 8; ++u)
#pragma unroll
      for (int i = 0; i < 9; ++i) acc[i] += sc[i * 1024 + wid * 128 + k + u] * w[u];
  }
#pragma unroll
  for (int i = 0; i < 9; ++i) *(f32x4*)(red + ((size_t)wid * 9 + i) * 256 + lane * 4) = acc[i];
  __syncthreads();
  float* part = (float*)(p.ws + W_PART);
  for (int i = tid; i < 9 * 256; i += 512) { const int rr = i >> 8, c = i & 255; float s = 0.f;
#pragma unroll
    for (int w = 0; w < 8; ++w) s += red[((size_t)w * 9 + rr) * 256 + c];
    const int col = cb * 256 + c;
    if (kh == 0) s += p.in[I_ADAB][layer * 12288 + col];
    part[((size_t)(layer * 2 + kh) * 9 + rr) * 12288 + col] = s; }
}
template <int MAP> __device__ __forceinline__ void transpose_tile(const float* W, int ldw, int K, int k0, int n0, bf16_t* Wt, unsigned char* shm) {
  const int tid = tid_opaque(); float* tile = (float*)shm;
  __syncthreads();
  f32x4 v[8];
#pragma unroll
  for (int i = 0; i < 8; ++i) { const int kk = (tid >> 6) + i * 8, c4 = (tid & 63) * 4; v[i] = *(const f32x4*)(W + (size_t)(k0 + kk) * ldw + n0 + c4); }
#pragma unroll
  for (int i = 0; i < 8; ++i) { const int kk = (tid >> 6) + i * 8, c4 = (tid & 63) * 4; *(f32x4*)(tile + kk * 260 + c4) = v[i]; }
  __syncthreads();
  const int n = tid & 255, kq = tid >> 8; int col = n0 + n, row;
  if (MAP == 0) row = col;
  else { const int isg = col >= FF ? 1 : 0, ch = col - isg * FF; row = (ch >> 7) * 256 + isg * 128 + (ch & 127); }
  bf16_t* dst = Wt + (size_t)row * K + k0 + kq * 32;
#pragma unroll
  for (int s = 0; s < 4; ++s) { float f[8];
#pragma unroll
    for (int i = 0; i < 8; ++i) f[i] = tile[(kq * 32 + s * 8 + i) * 260 + n];
    u32x4 w = {cvtpk(f[0], f[1]), cvtpk(f[2], f[3]), cvtpk(f[4], f[5]), cvtpk(f[6], f[7])}; *(u32x4*)(dst + s * 8) = w; }
}
template <int J> __device__ __forceinline__ void fold_item(const float* W, int ldw, int colbase, const float* M, const float* cs, bf16_t* Wt, int rowbase, int kc, unsigned char* shm) {
  const int tid = tid_opaque(); float* wl = (float*)shm;
  constexpr int KPT = 32 * J / 512;
  __syncthreads();
#pragma unroll
  for (int i = 0; i < 2; ++i) { const int idx = tid + i * 512, kk = idx >> 5, c4 = (idx & 31) * 4;
    *(f32x4*)(wl + kk * 132 + c4) = *(const f32x4*)(W + (size_t)(kc * 32 + kk) * ldw + colbase + c4); }
  __syncthreads();
  const int j = tid % J, kq = tid / J;
  float acc[KPT];
#pragma unroll
  for (int i = 0; i < KPT; ++i) acc[i] = 0.f;
  for (int c = 0; c < 128; c += 4) {
    const float m0 = M[(c + 0) * J + j], m1 = M[(c + 1) * J + j], m2 = M[(c + 2) * J + j], m3 = M[(c + 3) * J + j];
#pragma unroll
    for (int i = 0; i < KPT; ++i) { const f32x4 wv = *(const f32x4*)(wl + (kq * KPT + i) * 132 + c); acc[i] += wv[0] * m0 + wv[1] * m1 + wv[2] * m2 + wv[3] * m3; }
  }
  const float s = cs ? cs[j] : 1.f;
  bf16_t* dst = Wt + (size_t)(rowbase + j) * DM + kc * 32 + kq * KPT;
#pragma unroll
  for (int i = 0; i < KPT; i += 8) { u32x4 w = {cvtpk(acc[i] * s, acc[i + 1] * s), cvtpk(acc[i + 2] * s, acc[i + 3] * s), cvtpk(acc[i + 4] * s, acc[i + 5] * s), cvtpk(acc[i + 6] * s, acc[i + 7] * s)};
    *(u32x4*)(dst + i) = w; }
}
__device__ __forceinline__ void fold_item2(const float* W, int ldw, int colbase, const float* M, int ldm, int mcol0, const float* cs, bf16_t* Wt, int rowbase, int kc, unsigned char* shm) {
  const int tid = tid_opaque(); float* wl = (float*)shm;
  float* ml = (float*)(shm + 16896);
  __syncthreads();
  f32x4 wr_[2], mr_[8];
#pragma unroll
  for (int i = 0; i < 2; ++i) { const int idx = tid + i * 512, kk = idx >> 5, c4 = (idx & 31) * 4; wr_[i] = *(const f32x4*)(W + (size_t)(kc * 32 + kk) * ldw + colbase + c4); }
#pragma unroll
  for (int i = 0; i < 8; ++i) { const int idx = tid + i * 512, c = idx >> 5, c4 = (idx & 31) * 4; mr_[i] = *(const f32x4*)(M + (size_t)c * ldm + mcol0 + c4); }
#pragma unroll
  for (int i = 0; i < 2; ++i) { const int idx = tid + i * 512, kk = idx >> 5, c4 = (idx & 31) * 4; *(f32x4*)(wl + kk * 132 + c4) = wr_[i]; }
#pragma unroll
  for (int i = 0; i < 8; ++i) { const int idx = tid + i * 512, c = idx >> 5, c4 = (idx & 31) * 4; *(f32x4*)(ml + c * 128 + c4) = mr_[i]; }
  __syncthreads();
  const int j = tid & 127, kq = tid >> 7;
  float acc[8];
#pragma unroll
  for (int i = 0; i < 8; ++i) acc[i] = 0.f;
#pragma unroll 4
  for (int c = 0; c < 128; c += 4) {
    const float m0 = ml[(c + 0) * 128 + j], m1 = ml[(c + 1) * 128 + j], m2 = ml[(c + 2) * 128 + j], m3 = ml[(c + 3) * 128 + j];
#pragma unroll
    for (int i = 0; i < 8; ++i) { const f32x4 wv = *(const f32x4*)(wl + (kq * 8 + i) * 132 + c); acc[i] += wv[0] * m0 + wv[1] * m1 + wv[2] * m2 + wv[3] * m3; }
  }
  const float sc_ = cs ? cs[j] : 1.f;
  u32x4 w = {cvtpk(acc[0] * sc_, acc[1] * sc_), cvtpk(acc[2] * sc_, acc[3] * sc_), cvtpk(acc[4] * sc_, acc[5] * sc_), cvtpk(acc[6] * sc_, acc[7] * sc_)};
  *(u32x4*)(Wt + (size_t)(rowbase + j) * DM + kc * 32 + kq * 8) = w;
}
template <int MODE, int NR> __device__ __forceinline__ void norm_rows(const Params& p, int row0, const float* xp, const float* xs, const float* g, int layer, int kshift, float* yout) {
  const int lane = tid_opaque() & 63;
  f32x4 v[NR][8]; float ss[NR];
#pragma unroll
  for (int r = 0; r < NR; ++r) { const int row = row0 + r * 8;
    const float* x = row < NP ? xp + (size_t)row * DM : xs + (size_t)(row - NP) * DM;
#pragma unroll
    for (int i = 0; i < 8; ++i) v[r][i] = *(const f32x4*)(x + (i * 64 + lane) * 4); }
#pragma unroll
  for (int r = 0; r < NR; ++r) { float s = 0.f;
#pragma unroll
    for (int i = 0; i < 8; ++i) s += v[r][i][0] * v[r][i][0] + v[r][i][1] * v[r][i][1] + v[r][i][2] * v[r][i][2] + v[r][i][3] * v[r][i][3];
    ss[r] = rsqrtf(wave_sum(s) * (1.f / 2048.f) + 1e-6f); }
  if (MODE == 0) {
    const int bidx = row0 < NP ? 8 : ((row0 - NP) >> 11);
    const float* part = (const float*)(p.ws + W_PART);
#pragma unroll
    for (int i = 0; i < 8; ++i) { const int c = (i * 64 + lane) * 4;
      const f32x4 gv = *(const f32x4*)(g + c), sh = modv4(part, layer, bidx, kshift, c), scl = modv4(part, layer, bidx, kshift + 1, c);
      const f32x4 gs = gv * (scl + 1.f);
#pragma unroll
      for (int r = 0; r < NR; ++r) { const f32x4 y = v[r][i] * ss[r] * gs + sh;
        u32x2 w = {cvtpk(y[0], y[1]), cvtpk(y[2], y[3])}; *(u32x2*)((bf16_t*)(p.ws + W_ACT) + (size_t)(row0 + r * 8) * DM + c) = w; } }
  } else {
#pragma unroll
    for (int i = 0; i < 8; ++i) { const int c = (i * 64 + lane) * 4; const f32x4 gv = *(const f32x4*)(g + c);
#pragma unroll
      for (int r = 0; r < NR; ++r) *(f32x4*)(yout + (size_t)(row0 + r * 8) * DM + c) = v[r][i] * ss[r] * gv; }
  }
}
template <int MODE, int NR> __device__ __forceinline__ void norm_rows_b(const Params& p, int row0, const float* g, int layer, int kshift, float* yout) {
  const int lane = tid_opaque() & 63;
  const bf16_t* xb = (const bf16_t*)(p.ws + W_XB);
  u32x4 v[NR][4]; float ss[NR];
#pragma unroll
  for (int r = 0; r < NR; ++r)
#pragma unroll
    for (int i = 0; i < 4; ++i) v[r][i] = *(const u32x4*)(xb + (size_t)(row0 + r * 8) * DM + (i * 64 + lane) * 8);
#pragma unroll
  for (int r = 0; r < NR; ++r) { float s = 0.f;
#pragma unroll
    for (int i = 0; i < 4; ++i)
#pragma unroll
      for (int e = 0; e < 4; ++e) { const float a = bflo(v[r][i][e]), b = bfhi(v[r][i][e]); s += a * a + b * b; }
    ss[r] = rsqrtf(wave_sum(s) * (1.f / 2048.f) + 1e-6f); }
  const int bidx = row0 < NP ? 8 : ((row0 - NP) >> 11);
  const float* part = (const float*)(p.ws + W_PART);
#pragma unroll
  for (int i = 0; i < 4; ++i) { const int c = (i * 64 + lane) * 8;
    f32x4 gs0 = *(const f32x4*)(g + c), gs1 = *(const f32x4*)(g + c + 4), sh0 = {0.f, 0.f, 0.f, 0.f}, sh1 = {0.f, 0.f, 0.f, 0.f};
    if (MODE == 0) { gs0 = gs0 * (modv4(part, layer, bidx, kshift + 1, c) + 1.f); gs1 = gs1 * (modv4(part, layer, bidx, kshift + 1, c + 4) + 1.f);
      sh0 = modv4(part, layer, bidx, kshift, c); sh1 = modv4(part, layer, bidx, kshift, c + 4); }
#pragma unroll
    for (int r = 0; r < NR; ++r) { const u32x4 w = v[r][i];
      const f32x4 x0 = {bflo(w[0]), bfhi(w[0]), bflo(w[1]), bfhi(w[1])}, x1 = {bflo(w[2]), bfhi(w[2]), bflo(w[3]), bfhi(w[3])};
      const f32x4 y0 = x0 * ss[r] * gs0 + sh0, y1 = x1 * ss[r] * gs1 + sh1;
      if (MODE == 0) { u32x4 o = {cvtpk(y0[0], y0[1]), cvtpk(y0[2], y0[3]), cvtpk(y1[0], y1[1]), cvtpk(y1[2], y1[3])};
        *(u32x4*)((bf16_t*)(p.ws + W_ACT) + (size_t)(row0 + r * 8) * DM + c) = o; }
      else { float* y = yout + (size_t)(row0 + r * 8) * DM + c; *(f32x4*)y = y0; *(f32x4*)(y + 4) = y1; } } }
}
__device__ __forceinline__ void fix_phase(const Params& p, int layer) {
  const float* UB = (const float*)(p.ws + W_UB); bf16_t* G = (bf16_t*)(p.ws + W_BIG);
  const float* cw = p.in[I_FFCW] + (size_t)layer * 3 * FF2; const float* cb = p.in[I_FFCB] + (size_t)layer * FF2;
  const long total = 768L * (FF / 4), stride = (long)gridDim.x * 512;
  for (long i0 = (long)blockIdx.x * 512 + tid_opaque(); i0 < total; i0 += 2 * stride) {
    f32x4 pv[2], pg[2], cv[2], cg[2], nv[2], ng[2], w[2][8]; float wp[2], wn[2]; int rowq[2], chq[2]; bool ok[2];
#pragma unroll
    for (int q = 0; q < 2; ++q) {
      const long iq = i0 + q * stride; ok[q] = iq < total; const long i = ok[q] ? iq : i0;
      const int rr = (int)(i / (FF / 4)), ch = (int)(i % (FF / 4)) * 4;
      const int chunk = rr >> 1, last = rr & 1, row = chunk * 64 + (last ? 63 : 0);
      const int seqlen = row < NP ? 256 : 2048; const int rel = row < NP ? row : row - NP;
      const int ubc = (ch >> 7) * 256 + (ch & 127);
      const bool hp = last ? true : (rel % seqlen) != 0, hn = last ? ((rel + 1) % seqlen) != 0 : true;
      const int pc = last ? chunk : max(chunk - 1, 0), nc = last ? min(chunk + 1, 383) : chunk;
      const float* pu = UB + ((size_t)pc * 4 + (last ? 2 : 3)) * FF2 + ubc;
      const float* cu = UB + ((size_t)chunk * 4 + (last ? 3 : 0)) * FF2 + ubc;
      const float* nu = UB + ((size_t)nc * 4 + (last ? 0 : 1)) * FF2 + ubc;
      pv[q] = *(const f32x4*)pu; pg[q] = *(const f32x4*)(pu + 128); cv[q] = *(const f32x4*)cu; cg[q] = *(const f32x4*)(cu + 128); nv[q] = *(const f32x4*)nu; ng[q] = *(const f32x4*)(nu + 128);
      w[q][0] = *(const f32x4*)(cw + ch); w[q][1] = *(const f32x4*)(cw + FF2 + ch); w[q][2] = *(const f32x4*)(cw + 2 * FF2 + ch); w[q][3] = *(const f32x4*)(cb + ch);
      w[q][4] = *(const f32x4*)(cw + FF + ch); w[q][5] = *(const f32x4*)(cw + FF2 + FF + ch); w[q][6] = *(const f32x4*)(cw + 2 * FF2 + FF + ch); w[q][7] = *(const f32x4*)(cb + FF + ch);
      wp[q] = hp ? 1.f : 0.f; wn[q] = hn ? 1.f : 0.f; rowq[q] = row; chq[q] = ch;
    }
#pragma unroll
    for (int q = 0; q < 2; ++q) {
      const f32x4 val = w[q][0] * (pv[q] * wp[q]) + w[q][1] * cv[q] + w[q][2] * (nv[q] * wn[q]) + w[q][3];
      const f32x4 gat = w[q][4] * (pg[q] * wp[q]) + w[q][5] * cg[q] + w[q][6] * (ng[q] * wn[q]) + w[q][7];
      u32x2 o = {cvtpk(silu_fast(gat[0]) * val[0], silu_fast(gat[1]) * val[1]), cvtpk(silu_fast(gat[2]) * val[2], silu_fast(gat[3]) * val[3])};
      if (ok[q]) *(u32x2*)(G + (size_t)rowq[q] * FF + chq[q]) = o;
    }
  }
}
__device__ __forceinline__ void oddprep_row(const Params& p, int row) {
  const int lane = tid_opaque() & 63;
  bf16_t* pr = (bf16_t*)(p.ws + W_BIG) + (size_t)row * ODN;
  const bool lat = row >= NP; const int t = lat ? (row - NP) & 2047 : row & 255;
  const int grow = t >> 6, gcol = t & 63;
  const float* rope = (const float*)(p.ws + W_ROPE);
  unsigned raw[16];
#pragma unroll
  for (int v = 0; v < 16; ++v) raw[v] = *(const unsigned*)(pr + 512 + v * 128 + lane * 2);
  const int seqlen = lat ? 2048 : 256;
  const bf16_t* zb = pr + lane * 8;
  u32x4 zw[16];
#pragma unroll
  for (int si = 0; si < 16; ++si) { const int tc = min(max(t + si - 8, 0), seqlen - 1); zw[si] = *(const u32x4*)(zb + (long)(tc - t) * ODN); }
  const int e0 = lane * 2;
  const float gq0 = p.in[I_ODQG][e0], gq1 = p.in[I_ODQG][e0 + 1], gk0 = p.in[I_ODKG][e0], gk1 = p.in[I_ODKG][e0 + 1];
  const int pos = lane < 32 ? grow : gcol; const int i0 = e0 & 31;
  const float c0 = rope[(pos * 32 + i0) * 2], s0 = rope[(pos * 32 + i0) * 2 + 1], c1 = rope[(pos * 32 + i0 + 1) * 2], s1 = rope[(pos * 32 + i0 + 1) * 2 + 1];
  const bool isx1 = (lane & 16) == 0;
#pragma unroll
  for (int v = 0; v < 16; ++v) {
    float a = bflo(raw[v]), b = bfhi(raw[v]);
    const float ss = wave_sum(a * a + b * b);
    const float rinv = rsqrtf(ss * (1.f / 128.f) + 1e-6f);
    a = a * rinv * (v < 12 ? gq0 : gk0); b = b * rinv * (v < 12 ? gq1 : gk1);
    if (lat) {
      const float pa = __shfl_xor(a, 16), pb = __shfl_xor(b, 16);
      const float na = isx1 ? a * c0 - pa * s0 : a * c0 + pa * s0;
      const float nb = isx1 ? b * c1 - pb * s1 : b * c1 + pb * s1;
      a = na; b = nb;
    } else if (v >= 12) { float* o = p.out + O_GK + (size_t)row * 512 + (v - 12) * 128 + e0; o[0] = a; o[1] = b; }
    *(unsigned*)(pr + 512 + v * 128 + lane * 2) = cvtpk(a, b);
  }
  const int grp = lane >> 4; const int hw = 1 << grp;
  const int lo = max(t - hw, 0), hi = min(t + hw, seqlen);
  float acc[8];
#pragma unroll
  for (int i = 0; i < 8; ++i) acc[i] = 0.f;
#pragma unroll
  for (int si = 0; si < 16; ++si) { const int ts = t + si - 8; const float wgt = (ts >= lo && ts < hi) ? 1.f : 0.f;
#pragma unroll
    for (int i = 0; i < 4; ++i) { acc[2 * i] += wgt * bflo(zw[si][i]); acc[2 * i + 1] += wgt * bfhi(zw[si][i]); } }
  const u32x4 self = zw[8]; const float inv = 1.f / (float)(hi - lo);
  unsigned ow[4];
#pragma unroll
  for (int i = 0; i < 4; ++i) ow[i] = cvtpk(acc[2 * i] * inv - bflo(self[i]), acc[2 * i + 1] * inv - bfhi(self[i]));
  u32x4 w = {ow[0], ow[1], ow[2], ow[3]};
  *(u32x4*)((bf16_t*)(p.ws + W_ACT) + (size_t)row * DM + lane * 8) = w;
}

__device__ __forceinline__ void do_tile(const Params& p, int i, unsigned char* shm) {
  constexpr int T0 = 576, T1 = 256, T2 = 320, T3 = 256, T4 = 2816;
  if (i < T0) { const int kt = i / 18, nt = i % 18; transpose_tile<0>(p.in[I_EVWIN], 5120, DM, kt * 64, nt * 256, (bf16_t*)(p.ws + W_EVIN), shm); return; } i -= T0;
  if (i < T1) { const int kt = i / 8, nt = i % 8; transpose_tile<0>(p.in[I_EVWOUT], DM, DM, kt * 64, nt * 256, (bf16_t*)(p.ws + W_EVOUT), shm); return; } i -= T1;
  if (i < T2) { const int kt = i / 10, nt = i % 10; transpose_tile<0>(p.in[I_ODWIN], ODN, DM, kt * 64, 512 + nt * 256, (bf16_t*)(p.ws + W_ODIN), shm); return; } i -= T2;
  if (i < T3) { const int kt = i / 8, nt = i % 8; transpose_tile<0>(p.in[I_ODWOUT], DM, DM, kt * 64, nt * 256, (bf16_t*)(p.ws + W_ODOUT), shm); return; } i -= T3;
  if (i < T4) { const int l = i / 1408, r = i % 1408, kt = r / 44, nt = r % 44;
    transpose_tile<1>(p.in[I_FFUP] + (size_t)l * DM * FF2, FF2, DM, kt * 64, nt * 256, (bf16_t*)(p.ws + W_UP) + (size_t)l * FF2 * DM, shm); return; } i -= T4;
  { const int l = i / 704, r = i % 704, kt = r / 8, nt = r % 8;
    transpose_tile<0>(p.in[I_FFDN] + (size_t)l * FF * DM, DM, FF, kt * 64, nt * 256, (bf16_t*)(p.ws + W_DN) + (size_t)l * DM * FF, shm); }
}
__device__ __forceinline__ int tile_now(int j) { return j < 832 ? j : (j < 2240 ? 1408 + (j - 832) : 4224 + (j - 2240)); }
__device__ __forceinline__ int tile_def(int d) { return d < 576 ? 832 + d : (d < 1984 ? 2816 + (d - 576) : 4928 + (d - 1984)); }
__device__ __forceinline__ void prep_phase(const Params& p, unsigned char* shm) {
  const int G = gridDim.x, bid = blockIdx.x, tid = tid_opaque();
  {
    const bool defer = (G == 256);
    const int n_ada = defer ? 96 : 192, n_tiles = defer ? 2944 : 5632;
    unsigned* qctr = (unsigned*)(p.ws + W_BAR);
    volatile LAS unsigned* qslot = (volatile LAS unsigned*)((LAS unsigned char*)shm + (LDS_BYTES - 32));
    for (;;) {
      __syncthreads();
      if (tid == 0) *qslot = atomicAdd(qctr, 1u);
      __syncthreads();
      const int it0 = (int)*qslot;
      if (it0 >= n_ada + n_tiles) break;
      if (it0 < n_ada) { ada_item(p, it0, shm); continue; }
      do_tile(p, defer ? tile_now(it0 - n_ada) : it0 - n_ada, shm);
    }
  }
  const long gt = (long)bid * 512 + tid, gs = (long)G * 512;
  {
    const long n0 = 8L * 256 * 1536 / 8, n1 = 8L * 256 * 512 / 8;
    const long ntot = 2 * n0 + 2 * n1;
    for (long ib = gt; ib < ntot; ib += 4 * gs) {
      f32x4 va[4], vb[4]; bf16_t* dq[4]; bool okq[4];
#pragma unroll
      for (int q = 0; q < 4; ++q) { const long iq = ib + q * gs; okq[q] = iq < ntot; long j = okq[q] ? iq : ib;
        const float* src; bf16_t* dst;
        if (j < n0) { src = p.in[I_CNAK]; dst = (bf16_t*)(p.ws + W_CNAK); }
        else if (j < 2 * n0) { j -= n0; src = p.in[I_CNAV]; dst = (bf16_t*)(p.ws + W_CNAV); }
        else if (j < 2 * n0 + n1) { j -= 2 * n0; src = p.in[I_CGK]; dst = (bf16_t*)(p.ws + W_CGK); }
        else { j -= 2 * n0 + n1; src = p.in[I_CGV]; dst = (bf16_t*)(p.ws + W_CGV); }
        va[q] = *(const f32x4*)(src + j * 8); vb[q] = *(const f32x4*)(src + j * 8 + 4); dq[q] = dst + j * 8; }
#pragma unroll
      for (int q = 0; q < 4; ++q) { u32x4 w = {cvtpk(va[q][0], va[q][1]), cvtpk(va[q][2], va[q][3]), cvtpk(vb[q][0], vb[q][1]), cvtpk(vb[q][2], vb[q][3])}; if (okq[q]) *(u32x4*)dq[q] = w; }
    }
  }
  {
    float* ct = (float*)shm;
    __syncthreads();
    for (int i = tid; i < 2048; i += 512) ct[i] = cospif((float)i * (2.f / 2048.f));
    __syncthreads();
    const long nS = 2048L * 4096 / 8, nC = 256L * 512 / 8;
    for (long i = gt; i < nS + nC; i += gs) {
      int npos, sh, ts; long j; bf16_t* dst;
      if (i < nS) { npos = 2048; sh = 11; ts = 0; j = i; dst = (bf16_t*)(p.ws + W_DFTS); } else { npos = 256; sh = 8; ts = 3; j = i - nS; dst = (bf16_t*)(p.ws + W_DFTC); }
      const int prow = (int)((j * 8) >> (sh + 1)), k0 = (int)((j * 8) & (2 * npos - 1));
      float f[8];
#pragma unroll
      for (int e = 0; e < 8; ++e) { const int k = k0 + e; const int kk = k & (npos - 1); const int m = ((prow * kk) & (npos - 1)) << ts;
        f[e] = (k < npos) ? ct[m] : -ct[(m - 512) & 2047]; }
      u32x4 w = {cvtpk(f[0], f[1]), cvtpk(f[2], f[3]), cvtpk(f[4], f[5]), cvtpk(f[6], f[7])}; *(u32x4*)(dst + j * 8) = w;
    }
    float* M = (float*)(p.ws + W_FOLDM);
    for (long i = gt; i < 4L * 128 * 256; i += gs) { const int j = (int)(i & 255), c = (int)((i >> 8) & 127), g = (int)(i >> 15);
      const float* fw = p.in[I_EVFNET] + (size_t)g * 128 * 128 + (j & 127); float s = 0.f; const int off = (j < 128) ? 0 : 2048 - 512;
#pragma unroll 8
      for (int c2 = 0; c2 < 128; ++c2) { const float tr = ct[((((c * c2) & 127) << 4) + off) & 2047]; s += tr * fw[c2 * 128]; }
      M[i] = s; }
  }
  {
    float* rope = (float*)(p.ws + W_ROPE);
    for (long i = gt; i < 64 * 32; i += gs) { const int pos = (int)(i >> 5), k = (int)(i & 31);
      const float invf = exp2f(-(float)k * (1.f / 32.f) * 13.287712379549449f);
      const float ang = (float)pos * invf; const float x = ang * 0.3183098861837907f;
      rope[i * 2] = cospif(x); rope[i * 2 + 1] = sinpif(x); }
  }
}

#define XB_TMO      128
#define XB_XCNT(j)  (256  + 64 * (j))
#define XB_XSUB(j)  (1280 + 64 * (j))
#define XB_XGEN(j)  (2304 + 64 * (j))
#define XB_TOP      3328
#define XB_TOPGEN   3392
#define XCD_BAR_WORDS 3456
#define XB_SPIN_CAP (1u << 18)
__device__ __forceinline__ unsigned xb_ld(unsigned* p)              { return __hip_atomic_load(p, __ATOMIC_RELAXED, __HIP_MEMORY_SCOPE_AGENT); }
__device__ __forceinline__ unsigned xb_add(unsigned* p, unsigned v) { return __hip_atomic_fetch_add(p, v, __ATOMIC_RELAXED, __HIP_MEMORY_SCOPE_AGENT); }
__device__ __forceinline__ unsigned xb_xcc_id() { return (unsigned)__builtin_amdgcn_s_getreg((3 << 11) | 20) & 0xFu; }
#define XB_SPIN(cond, bar) do { unsigned _sp = 0; while (cond) { __builtin_amdgcn_s_sleep(1); \
    if ((++_sp & 255u) == 0u) { if (xb_ld(&(bar)[XB_TMO])) break; if (_sp > XB_SPIN_CAP) { atomicAdd(&(bar)[XB_TMO], 1u); break; } } } } while (0)
struct XcdBarrier { unsigned* bar; unsigned x; volatile LAS unsigned* st; };
__device__ __forceinline__ XcdBarrier xcd_barrier_post(unsigned* bar, volatile LAS unsigned* st) {
    XcdBarrier b; b.bar = bar; b.x = xb_xcc_id(); b.st = st;
    if (threadIdx.x == 0) (void)xb_add(&bar[XB_XCNT(b.x)], 1u);
    return b;
}
__device__ __forceinline__ void xcd_barrier_complete(unsigned* bar, unsigned x, unsigned& nloc, unsigned& nx) {
    const unsigned G = gridDim.x * gridDim.y * gridDim.z;
    unsigned sum, cnt, mine, sp = 0u;
    for (;;) {
        sum = 0u; cnt = 0u; mine = 0u;
#pragma unroll
        for (unsigned j = 0; j < 16; ++j) { const unsigned c = xb_ld(&bar[XB_XCNT(j)]); sum += c; cnt += (c > 0u) ? 1u : 0u; mine = (j == x) ? c : mine; }
        if (sum == G) break;
        __builtin_amdgcn_s_sleep(1);
        if ((++sp & 255u) == 0u) { if (xb_ld(&bar[XB_TMO])) break; if (sp > XB_SPIN_CAP) { atomicAdd(&bar[XB_TMO], 1u); break; } }
    }
    nloc = mine > 0u ? mine : 1u; nx = cnt > 0u ? cnt : 1u;
}
__device__ __forceinline__ void xcd_barrier(const XcdBarrier& b) {
    asm volatile("s_waitcnt vmcnt(0)" ::: "memory");
    __syncthreads();
    if (threadIdx.x == 0) {
        unsigned* bar = b.bar;
        __builtin_amdgcn_s_waitcnt(0);
        unsigned nloc = b.st[0], nx = b.st[1];
        if (nloc == 0u) { xcd_barrier_complete(bar, b.x, nloc, nx); b.st[0] = nloc; b.st[1] = nx; }
        const unsigned old = xb_add(&bar[XB_XSUB(b.x)], 1u);
        const unsigned gen = old / nloc;
        if (old + 1u == (gen + 1u) * nloc) {
            __builtin_amdgcn_fence(__ATOMIC_RELEASE, "agent");
            asm volatile("s_waitcnt vmcnt(0)" ::: "memory");
            const unsigned og = xb_add(&bar[XB_TOP], 1u);
            const unsigned tg = og / nx;
            if (og + 1u == (tg + 1u) * nx) xb_add(&bar[XB_TOPGEN], 1u);
            else XB_SPIN(xb_ld(&bar[XB_TOPGEN]) == tg, bar);
            __builtin_amdgcn_fence(__ATOMIC_ACQUIRE, "agent");
            xb_add(&bar[XB_XGEN(b.x)], 1u);
            asm volatile("s_waitcnt vmcnt(0)" ::: "memory");
        } else {
            XB_SPIN(xb_ld(&bar[XB_XGEN(b.x)]) == gen, bar);
            __builtin_amdgcn_fence(__ATOMIC_ACQUIRE, "agent");
            asm volatile("s_waitcnt vmcnt(0)" ::: "memory");
        }
    }
    __syncthreads();
}

__global__ void __launch_bounds__(512, 2) mega(Params p_unused) {
  extern __shared__ __attribute__((aligned(16))) unsigned char shm[];
  cg::grid_group grid = cg::this_grid();
  typedef const Params __attribute__((address_space(4)))* KP;
  KP kp0 = (KP)__builtin_amdgcn_kernarg_segment_ptr();
  const int G = gridDim.x, bid = blockIdx.x;
  const int ph_lo = kp0->ph_lo, ph_hi = kp0->ph_hi;
  volatile LAS unsigned* xst = (volatile LAS unsigned*)((LAS unsigned char*)shm + (LDS_BYTES - 16));
  if (threadIdx.x == 0) { xst[0] = 0u; xst[1] = 0u; }
  __syncthreads();
  XcdBarrier xb = xcd_barrier_post((unsigned*)(kp0->ws + W_BAR), xst);
  for (int phx = ph_lo * 2; phx < ph_hi * 2; ++phx) {
    const int ph = phx >> 1;
    if ((phx & 1) && !((REPMASK >> ph) & 1)) continue;
    if (phx > ph_lo * 2) { if (ph_hi > 1000) grid.sync(); else xcd_barrier(xb); }
    KP kp = kp0; asm volatile("" : "+s"(kp));
    Params p;
#pragma unroll
    for (int i = 0; i < 27; ++i) p.in[i] = kp->in[i];
    p.out = kp->out; p.ws = kp->ws; p.ph_lo = 0; p.ph_hi = 0;
    float* xr = p.out + O_Y;
    bf16_t* ACT = (bf16_t*)(p.ws + W_ACT); bf16_t* BIG = (bf16_t*)(p.ws + W_BIG);
    const float* part = (const float*)(p.ws + W_PART);
    int kind, layer = ph >= 9 ? 1 : 0;
    switch (ph) {
      case 0: kind = 0; break;
      case 1: case 5: case 9: case 14: kind = 1; break;
      case 2: case 10: kind = 2; break;
      case 3: case 12: kind = 3; break;
      case 4: case 8: case 13: case 17: kind = 4; break;
      case 6: case 15: kind = 5; break;
      case 7: case 16: kind = 6; break;
      case 11: kind = 7; break;
      default: kind = 8; break;
    }
    if (kind == 0 && (KMASK & 1)) {
      prep_phase(p, shm);
    } else if (kind == 1 && (KMASK & 2)) {
      const bool first = (ph == 1);
      const float* xp = first ? p.in[I_XP] : xr; const float* xs = first ? p.in[I_XS] : xr + (size_t)NP * DM;
      const bool n2 = (ph == 5 || ph == 14);
      const float* g = (n2 ? p.in[I_N2G] : p.in[I_N1G]) + layer * DM;
      if (first) {
        for (int it = bid; it < 768; it += G) {
          if (it < 512) { const int gi = it >> 7, kc = (it >> 1) & 63, jh = it & 1;
            fold_item2(p.in[I_EVWIN], 5120, 4608 + gi * 128, (const float*)(p.ws + W_FOLDM) + (size_t)gi * 128 * 256, 256, jh * 128, nullptr, (bf16_t*)(p.ws + W_EVIN), 4608 + gi * 256 + jh * 128, kc, shm); }
          else { const int v = it - 512, gi = v >> 6, kc = v & 63;
            fold_item2(p.in[I_ODWIN], ODN, gi * 128, p.in[I_ODPOOLW] + (size_t)gi * 128 * 128, 128, 0, p.in[I_ODPOOLS] + gi * 128, (bf16_t*)(p.ws + W_ODIN), gi * 128, kc, shm); }
        }
      }
      const int wid = tid_opaque() >> 6;
      if (first) { for (int it = bid; it < NTOK / 32; it += G) norm_rows<0, 4>(p, it * 32 + wid, xp, xs, g, layer, n2 ? 3 : 0, nullptr); }
      else { for (int it = bid; it < NTOK / 32; it += G) norm_rows_b<0, 4>(p, it * 32 + wid, g, layer, n2 ? 3 : 0, nullptr); }
    } else if (kind == 2 && (KMASK & 4)) {
      pg8::Gemm gm; gm.A = ACT; gm.M = NTOK; gm.K = DM;
      EpiIn E; E.O = BIG; E.out = p.out; E.yts = (bf16_t*)(p.ws + W_YTS); E.ytc = (bf16_t*)(p.ws + W_YTC);
      if (layer == 0) { gm.Bt = (const bf16_t*)(p.ws + W_EVIN); gm.N = EVN; E.ldc = EVN; E.even = 1; }
      else { gm.Bt = (const bf16_t*)(p.ws + W_ODIN); gm.N = ODN; E.ldc = ODN; E.even = 0; }
      pg8::StaticOrder S; S.init(gm.M, gm.N, G, bid);
      pg8::gemm_phase<EpiIn>((LAS unsigned char*)shm, gm, S, E);
      if (layer == 0 && G == 256 && bid >= 64) { for (int d = bid - 64; d < 2112; d += 192) do_tile(p, tile_def(d), shm); }
    } else if (kind == 3 && (KMASK & 8)) {
      const int nunits = 768 + 384;
      const bool bal = (layer == 0 && G == 256);
      const int nloc = bal ? (bid < 128 ? 6 : 3) : (nunits - bid + G - 1) / G;
      for (int iu = 0; iu < nloc; ++iu) {
        int u;
        if (bal) { if (bid < 128) u = iu < 4 ? bid * 4 + iu : 768 + bid * 2 + (iu - 4); else u = iu < 2 ? 512 + (bid - 128) * 2 + iu : 768 + 256 + (bid - 128); }
        else if (layer == 1 && G == 256 && iu < 3) u = (bid & 7) * 96 + iu * 32 + (bid >> 3);
        else u = bid + iu * G;
        at::Desc d; int masked = 0, head = 0;
        if (layer == 0) {
          if (u < 768) { const int b = u / 96, rem = u % 96, h = rem >> 3, rg = rem & 7; head = h; masked = 1;
            const size_t qrow = (size_t)NP + b * 2048 + rg * 256; const bool edge = (rg == 0 || rg == 7); const int ks = edge ? (rg ? 24 : 0) : min(max(4 * rg - 4, 0), 20);
            d.Q = BIG + qrow * EVN + h * 128; d.ldq = EVN;
            d.K0 = (const bf16_t*)(p.ws + W_CNAK) + (size_t)b * 256 * 1536 + h * 128; d.V0 = (const bf16_t*)(p.ws + W_CNAV) + (size_t)b * 256 * 1536 + h * 128; d.ld0 = 1536; d.n0 = 256;
            const size_t krow = (size_t)NP + b * 2048 + ks * 64;
            d.K1 = BIG + krow * EVN + 1536 + h * 128; d.V1 = BIG + krow * EVN + 3072 + h * 128; d.ld1 = EVN; d.seq = edge ? 768 : 1024;
            d.O = ACT + qrow * DM + h * 128; d.ldo = DM; d.ks = ks; d.qrow0 = 4 * rg;
          } else { const int v = u - 768, b = v / 12, h = v % 12; const size_t qrow = (size_t)b * 256;
            d.Q = BIG + qrow * EVN + h * 128; d.ldq = EVN;
            d.K0 = BIG + qrow * EVN + 1536 + h * 128; d.V0 = BIG + qrow * EVN + 3072 + h * 128; d.ld0 = EVN; d.n0 = 256;
            d.K1 = d.K0; d.V1 = d.V0; d.ld1 = EVN; d.seq = 256; d.O = ACT + qrow * DM + h * 128; d.ldo = DM; d.ks = 0; d.qrow0 = 0; }
        } else {
          if (u < 768) { const int b = u / 96, rem = u % 96, h = rem >> 3, qb = rem & 7, kvh = h / 3;
            const size_t qrow = (size_t)NP + b * 2048 + qb * 256;
            d.Q = BIG + qrow * ODN + 512 + h * 128; d.ldq = ODN;
            d.K0 = (const bf16_t*)(p.ws + W_CGK) + (size_t)b * 256 * 512 + kvh * 128; d.V0 = (const bf16_t*)(p.ws + W_CGV) + (size_t)b * 256 * 512 + kvh * 128; d.ld0 = 512; d.n0 = 256;
            const size_t krow = (size_t)NP + b * 2048;
            d.K1 = BIG + krow * ODN + 2048 + kvh * 128; d.V1 = BIG + krow * ODN + 2560 + kvh * 128; d.ld1 = ODN; d.seq = 2304;
            d.O = ACT + qrow * DM + 512 + h * 128; d.ldo = DM; d.ks = 0; d.qrow0 = 0;
          } else { const int v = u - 768, b = v / 12, h = v % 12, kvh = h / 3; const size_t qrow = (size_t)b * 256;
            d.Q = BIG + qrow * ODN + 512 + h * 128; d.ldq = ODN;
            d.K0 = BIG + qrow * ODN + 2048 + kvh * 128; d.V0 = BIG + qrow * ODN + 2560 + kvh * 128; d.ld0 = ODN; d.n0 = 256;
            d.K1 = d.K0; d.V1 = d.V0; d.ld1 = ODN; d.seq = 256; d.O = ACT + qrow * DM + 512 + h * 128; d.ldo = DM; d.ks = 0; d.qrow0 = 0; }
        }
        __syncthreads();
        if (masked && (AMASK & 1)) {
          float* btab = (float*)(shm + at::SHM_ATTN) + 64;
          const int tid = tid_opaque();
          if (tid < 465) btab[tid] = p.in[I_EVBIAS][head * 465 + tid] * (1.f / at::SCALE);
          at::attn_body<1>(d, (char*)shm);
        } else if (AMASK & 2) at::attn_body<0>(d, (char*)shm);
      }
      if (layer == 0 && (AMASK & 4)) {
        __syncthreads();
#pragma unroll 1
        for (int v = 0; v < 2; ++v) {
          pg8::Gemm gm; EpiFourier E; E.mix = ACT;
          if (v == 0) { gm.A = (const bf16_t*)(p.ws + W_DFTS); gm.Bt = (const bf16_t*)(p.ws + W_YTS); gm.M = 2048; gm.N = 4096; gm.K = 4096; E.rowbase = NP; E.npos = 2048; E.scale = 0.001953125f; }
          else { gm.A = (const bf16_t*)(p.ws + W_DFTC); gm.Bt = (const bf16_t*)(p.ws + W_YTC); gm.M = 256; gm.N = 16384; gm.K = 512; E.rowbase = 0; E.npos = 256; E.scale = 0.005524271728019903f; }
          pg8::StaticOrder S; S.init(gm.M, gm.N, G, (bid + 128) % G);
          pg8::gemm_phase<EpiFourier>((LAS unsigned char*)shm, gm, S, E);
          __syncthreads();
        }
      }
    } else if (kind == 4 && (KMASK & 16)) {
      pg8::Gemm gm; gm.M = NTOK; gm.N = DM; EpiRes E; E.xb = (bf16_t*)(p.ws + W_XB); E.xo = (phx & 1) ? ACT : E.xb; E.part = part; E.layer = layer; E.xp = p.in[I_XP]; E.xs = p.in[I_XS]; E.from_in = 0;
      if (ph == 4) { gm.A = ACT; gm.Bt = (const bf16_t*)(p.ws + W_EVOUT); gm.K = DM; E.gk = 2; E.from_in = 1; }
      else if (ph == 13) { gm.A = ACT; gm.Bt = (const bf16_t*)(p.ws + W_ODOUT); gm.K = DM; E.gk = 2; }
      else { gm.A = BIG; gm.Bt = layer ? (const bf16_t*)(p.ws + W_DN + (size_t)DM * FF * 2) : (const bf16_t*)(p.ws + W_DN); gm.K = FF; E.gk = 5; }
      pg8::StaticOrder S; S.init(gm.M, gm.N, G, bid);
      pg8::gemm_phase<EpiRes>((LAS unsigned char*)shm, gm, S, E);
    } else if (kind == 5 && (KMASK & 32)) {
      pg8::Gemm gm; gm.A = ACT; gm.Bt = (const bf16_t*)(p.ws + W_UP) + (size_t)layer * FF2 * DM; gm.M = NTOK; gm.N = FF2; gm.K = DM;
      EpiUp E; E.G = BIG; E.UB = (float*)(p.ws + W_UB); E.cw = p.in[I_FFCW] + (size_t)layer * 3 * FF2; E.cb = p.in[I_FFCB] + (size_t)layer * FF2;
      pg8::StaticOrder S; S.init(gm.M, gm.N, G, bid);
      pg8::gemm_phase<EpiUp>((LAS unsigned char*)shm, gm, S, E);
      if (layer == 0 && G == 256 && bid >= 128) { if (bid < 224) ada_item(p, 96 + (bid - 128), shm); for (int d = 2112 + (bid - 128); d < 2688; d += 128) do_tile(p, tile_def(d), shm); }
    } else if (kind == 6 && (KMASK & 64)) {
      fix_phase(p, layer);
    } else if (kind == 7 && (KMASK & 128)) {
      const int wid = tid_opaque() >> 6;
      for (int it = bid; it < NTOK / 8; it += G) oddprep_row(p, it * 8 + wid);
    } else if (KMASK & 256) {
      for (int e = 0; e < EXTRA_SYNCS; ++e) xcd_barrier(xb);
      const int wid = tid_opaque() >> 6;
      for (int it = bid; it < NTOK / 32; it += G) norm_rows_b<1, 4>(p, it * 32 + wid, p.in[I_FING], 0, 0, xr);
    }
  }
}

extern "C" void kernel_launch(void* const* d_in, const int* in_sizes, int n_in, void* d_out, int out_size, void* d_ws, size_t ws_size, hipStream_t stream) {
  static int grid = 0;
  if (grid == 0) {
    if (n_in != 27 || out_size != 83886080 || ws_size < W_END) { fprintf(stderr, "kernel_launch: unexpected shapes: n_in %d out %d ws %zu (need %zu)\n", n_in, out_size, ws_size, (size_t)W_END); grid = -1; return; }
    int dev = 0, cus = 0, per_cu = 0;
    if (hipGetDevice(&dev) != hipSuccess || hipDeviceGetAttribute(&cus, hipDeviceAttributeMultiprocessorCount, dev) != hipSuccess) { grid = -1; return; }
    if (hipFuncSetAttribute((const void*)mega, hipFuncAttributeMaxDynamicSharedMemorySize, LDS_BYTES) != hipSuccess) { fprintf(stderr, "kernel_launch: hipFuncSetAttribute failed\n"); grid = -1; return; }
    if (hipOccupancyMaxActiveBlocksPerMultiprocessor(&per_cu, (const void*)mega, 512, LDS_BYTES) != hipSuccess || per_cu < 1) { fprintf(stderr, "kernel_launch: occupancy query says %d\n", per_cu); per_cu = 1; }
    (void)hipGetLastError();
    grid = cus * per_cu;
  }
  if (grid < 0) return;
  Params p{};
  for (int i = 0; i < 27; ++i) p.in[i] = (const float*)d_in[i];
  p.out = (float*)d_out; p.ws = (unsigned char*)d_ws;
#if N_LAUNCH_SPLIT
  for (int ph = 0; ph < PH_LIMIT; ++ph) { if (ph == SKIP_PH) continue; p.ph_lo = ph; p.ph_hi = ph + 1; hipLaunchKernelGGL(mega, dim3(grid), dim3(512), LDS_BYTES, stream, p); }
#else
  p.ph_lo = 0; p.ph_hi = NPH;
  (void)hipMemsetAsync((unsigned char*)d_ws + W_BAR, 0, 16384, stream);
  void* args[] = {&p};
  hipError_t e = hipLaunchCooperativeKernel((const void*)mega, dim3(grid), dim3(512), args, LDS_BYTES, stream);
  if (e != hipSuccess) fprintf(stderr, "kernel_launch: cooperative launch failed: %s (grid %d)\n", hipGetErrorString(e), grid);
#endif
}
```

```cpp
#include <hip/hip_runtime.h>
#include <hip/hip_cooperative_groups.h>
#include <cstdio>
#include <cstdint>
namespace cg = cooperative_groups;

#ifndef PH_LIMIT
#define PH_LIMIT 19
#endif
#ifndef SKIP_PH
#define SKIP_PH 99
#endif
#ifndef DBG_L0
#define DBG_L0 0
#endif
#ifndef DBG_SRC0
#define DBG_SRC0 0
#endif
#ifndef REPMASK
#define REPMASK 0
#endif
#ifndef EXTRA_SYNCS
#define EXTRA_SYNCS 0
#endif
#ifndef AMASK
#define AMASK 7
#endif
#ifndef KMASK
#define KMASK 511
#endif
#ifndef N_LAUNCH_SPLIT
#define N_LAUNCH_SPLIT 0
#endif

typedef unsigned short bf16_t;
typedef short bf16x8 __attribute__((ext_vector_type(8)));
typedef short s16x4 __attribute__((ext_vector_type(4)));
typedef float f32x4 __attribute__((ext_vector_type(4)));
typedef float f32x16 __attribute__((ext_vector_type(16)));
typedef unsigned u32x4 __attribute__((ext_vector_type(4)));
typedef unsigned u32x2 __attribute__((ext_vector_type(2)));
#define LAS __attribute__((address_space(3)))

constexpr int DM = 2048, NP = 8192, NS = 16384, NTOK = 24576;
constexpr int EVN = 5632, ODN = 3072, FF = 5632, FF2 = 11264;
constexpr int NPH = 19;
constexpr int LDS_BYTES = 135168;

enum { I_XP = 0, I_XS, I_C, I_CNAK, I_CNAV, I_CGK, I_CGV, I_CCTX, I_N1G, I_N2G, I_ADAW, I_ADAB, I_EVWIN, I_EVBIAS, I_EVFNET, I_EVWOUT,
       I_ODWIN, I_ODPOOLW, I_ODPOOLS, I_ODQG, I_ODKG, I_ODWOUT, I_FFUP, I_FFCW, I_FFCB, I_FFDN, I_FING };
constexpr size_t O_Y = 0, O_NAK = 50331648, O_NAV = 62914560, O_GK = 75497472, O_GV = 79691776;
constexpr size_t al256(size_t x) { return (x + 255) / 256 * 256; }
constexpr size_t W_PART = 0;
constexpr size_t W_FOLDM = W_PART + al256((size_t)2 * 2 * 9 * 12288 * 4);
constexpr size_t W_ROPE = W_FOLDM + al256((size_t)4 * 128 * 256 * 4);
constexpr size_t W_EVOUT = W_ROPE + al256((size_t)64 * 32 * 2 * 4);
constexpr size_t W_ODIN = W_EVOUT + (size_t)DM * DM * 2;
constexpr size_t W_ODOUT = W_ODIN + (size_t)ODN * DM * 2;
constexpr size_t W_UP = W_ODOUT + (size_t)DM * DM * 2;
constexpr size_t W_CGK = W_UP + (size_t)2 * FF2 * DM * 2;
constexpr size_t W_CGV = W_CGK + (size_t)8 * 256 * 512 * 2;
constexpr size_t W_EVIN = W_CGV + (size_t)8 * 256 * 512 * 2;
constexpr size_t W_XB = W_EVIN;
constexpr size_t W_DFTS = W_EVIN + (size_t)EVN * DM * 2;
constexpr size_t W_DFTC = W_DFTS + (size_t)2048 * 4096 * 2;
constexpr size_t W_CNAK = W_DFTC + (size_t)256 * 512 * 2;
constexpr size_t W_CNAV = W_CNAK + (size_t)8 * 256 * 1536 * 2;
constexpr size_t W_YTS = W_CNAV + (size_t)8 * 256 * 1536 * 2;
constexpr size_t W_YTC = W_YTS + (size_t)4096 * 4096 * 2;
static_assert(W_YTC + (size_t)16384 * 512 * 2 - W_XB >= (size_t)NTOK * DM * 2, "XB alias region too small");
constexpr size_t W_ACT = W_YTC + (size_t)16384 * 512 * 2;
constexpr size_t W_BIG = W_ACT + (size_t)NTOK * DM * 2;
constexpr size_t W_UB = W_BIG + (size_t)NTOK * EVN * 2;
constexpr size_t W_DN = W_UB + (size_t)384 * 4 * FF2 * 4;
constexpr size_t W_BAR = W_DN + (size_t)2 * DM * FF * 2;
constexpr size_t W_END = W_BAR + 16384;

struct Params { const float* in[27]; float* out; unsigned char* ws; int ph_lo, ph_hi; };

__device__ __forceinline__ unsigned cvtpk(float lo, float hi) { unsigned r; asm volatile("v_cvt_pk_bf16_f32 %0, %1, %2" : "=v"(r) : "v"(lo), "v"(hi)); return r; }
__device__ __forceinline__ float bf2f(bf16_t b) { return __uint_as_float(((unsigned)b) << 16); }
__device__ __forceinline__ float bflo(unsigned w) { return __uint_as_float(w << 16); }
__device__ __forceinline__ float bfhi(unsigned w) { return __uint_as_float(w & 0xffff0000u); }
__device__ __forceinline__ float wave_sum(float v) {
#pragma unroll
  for (int o = 32; o > 0; o >>= 1) v += __shfl_xor(v, o);
  return v;
}
__device__ __forceinline__ float wave_sum_dpp(float v) {
#define WS_DPP(x, ctrl, rm, bc) __builtin_bit_cast(float, __builtin_amdgcn_update_dpp(0, __builtin_bit_cast(int, x), ctrl, rm, 0xf, bc))
  v += WS_DPP(v, 0x111, 0xf, true); v += WS_DPP(v, 0x112, 0xf, true); v += WS_DPP(v, 0x114, 0xf, true); v += WS_DPP(v, 0x118, 0xf, true);
  v += WS_DPP(v, 0x142, 0xa, false);
  v += WS_DPP(v, 0x143, 0xc, false);
#undef WS_DPP
  return __builtin_bit_cast(float, __builtin_amdgcn_readlane(__builtin_bit_cast(int, v), 63));
}
__device__ __forceinline__ int tid_opaque() { int t = threadIdx.x; asm volatile("" : "+v"(t)); return t; }
__device__ __forceinline__ float silu_f(float x) { return x / (1.f + __expf(-x)); }
__device__ __forceinline__ float silu_fast(float x) { return x * __builtin_amdgcn_rcpf(1.f + __builtin_amdgcn_exp2f(x * -1.4426950408889634f)); }
__device__ __forceinline__ f32x4 modv4(const float* part, int l, int bidx, int k, int col) {
  const float* p0 = part + ((size_t)(l * 2 + 0) * 9 + bidx) * 12288 + k * 2048 + col;
  const float* p1 = part + ((size_t)(l * 2 + 1) * 9 + bidx) * 12288 + k * 2048 + col;
  return *(const f32x4*)p0 + *(const f32x4*)p1;
}

namespace pg8 {
constexpr int BM = 256, BK = 64, HALF = 128, HTB = HALF * BK * 2, STAGE_BYTES = 8 * HTB, NXCD = 8, WGM = 8;
__host__ __device__ __forceinline__ int lds_byte(int r, int c) { const int st = (r >> 4) * 2 + (c >> 5), rr = r & 15, cc = c & 31, ob = rr * 64 + cc * 2; return st * 1024 + (ob ^ (((ob >> 9) & 1) << 5)); }
__host__ __device__ __forceinline__ void stage_rc(int b, int& R, int& C) { const int st = b / 1024, sb = b % 1024, swz = sb ^ (((sb >> 9) & 1) << 5); R = (st >> 1) * 16 + swz / 64; C = (st & 1) * 32 + (swz % 64) / 2; }
__host__ __device__ __forceinline__ int perm32(int rho) { const int n = rho >> 4, i = rho & 15; return 8 * (i >> 2) + 4 * n + (i & 3); }
struct Unit { int pm, pn; };
struct Gemm { const bf16_t* A; const bf16_t* Bt; int M, N, K; };
struct StaticOrder {
  int nM, nN, nwg, G, c;
  __device__ void init(int M, int N, int G_, int c_) { nM = M / BM; nN = N / BM; nwg = nM * nN; G = G_; c = c_; }
  __device__ bool next(int i, Unit& u) const {
    const long L = (long)i * G + c; if (L >= nwg) return false;
    int wgid = (int)L; { const int q = nwg / NXCD, r = nwg % NXCD, xcd = wgid % NXCD, off = wgid / NXCD; wgid = (xcd < r ? xcd * (q + 1) : r * (q + 1) + (xcd - r) * q) + off; }
    const int nig = WGM * nN, gid = wgid / nig, fm = gid * WGM, gsz = (nM - fm) < WGM ? (nM - fm) : WGM;
    u.pm = fm + ((wgid % nig) % gsz); u.pn = (wgid % nig) / gsz; return true;
  }
};

template <class Epi>
__device__ __forceinline__ void gemm_phase(LAS unsigned char* lds, const Gemm g, const StaticOrder& S, const Epi& E) {
  const int tid = tid_opaque(), wid = __builtin_amdgcn_readfirstlane(tid >> 6), lane = tid & 63, wr = wid >> 2, wc = wid & 3, fr = lane & 15, fq = lane >> 4;
  const int K = g.K, nt = K / BK;
  unsigned voffA[2], voffB[2];
#pragma unroll
  for (int i = 0; i < 2; ++i) { int R, C; stage_rc(tid * 16 + i * 8192, R, C); const int Rb = Epi::PERM ? ((R & ~31) + perm32(R & 31)) : R;
    const int Ra = Epi::APERM ? ((R & ~63) + 4 * (R & 15) + ((R >> 4) & 3)) : R;
    voffA[i] = (unsigned)(Ra * K + C) * 2u; voffB[i] = (unsigned)(Rb * K + C) * 2u; }
  const size_t kstep = (size_t)(BK * 2);
  const size_t hstep = (size_t)HALF * K * 2;
  const size_t tstep = 2 * hstep;
  const unsigned ldsw = (unsigned)wid * 1024u;
  const int aoff = lds_byte(wr * 64 + fr, fq * 8), boff = lds_byte(wc * 32 + fr, fq * 8);
#define PG8_SA(b, h) (((b) * 2 + (h)) * HTB)
#define PG8_SB(b, h) ((4 + (b) * 2 + (h)) * HTB)
#define PG8_STAGE(bufoff, gbase, voff) do { _Pragma("unroll") for (int _i = 0; _i < 2; ++_i) \
    __builtin_amdgcn_global_load_lds((const unsigned*)((const char*)(gbase) + (voff)[_i]), (LAS unsigned*)(lds + (bufoff) + ldsw + _i * 8192), 16, 0, 0); } while (0)
#define PG8_LDA(dst, b, h) do { _Pragma("unroll") for (int m = 0; m < 4; ++m) _Pragma("unroll") for (int k = 0; k < 2; ++k) dst[m][k] = *(const LAS bf16x8*)(lds + PG8_SA(b, h) + aoff + m * 2048 + k * 1024); } while (0)
#define PG8_LDB(dst, b, h) do { _Pragma("unroll") for (int n = 0; n < 2; ++n) _Pragma("unroll") for (int k = 0; k < 2; ++k) dst[n][k] = *(const LAS bf16x8*)(lds + PG8_SB(b, h) + boff + n * 2048 + k * 1024); } while (0)
#define PG8_MMA(ai, bj, At, Bt) do { __builtin_amdgcn_s_setprio(1); _Pragma("unroll") for (int m = 0; m < 4; ++m) _Pragma("unroll") for (int n = 0; n < 2; ++n) _Pragma("unroll") for (int k = 0; k < 2; ++k) \
    acc[ai][bj][m][n] = __builtin_amdgcn_mfma_f32_16x16x32_bf16(Bt[n][k], At[m][k], acc[ai][bj][m][n], 0, 0, 0); __builtin_amdgcn_s_setprio(0); } while (0)
#define PG8_WAIT_V(n) asm volatile("s_waitcnt vmcnt(" #n ")" ::: "memory")
#define PG8_WAIT_L(n) asm volatile("s_waitcnt lgkmcnt(" #n ")" ::: "memory")
#define PG8_BAR __builtin_amdgcn_s_barrier()
#define PG8_SCHED __builtin_amdgcn_sched_barrier(0)
  Unit cur, nxt; int ui = 0;
  if (!S.next(0, cur)) return;
  f32x4 acc[2][2][4][2];
#pragma unroll
  for (int a = 0; a < 2; ++a)
#pragma unroll
    for (int b = 0; b < 2; ++b)
#pragma unroll
      for (int m = 0; m < 4; ++m)
#pragma unroll
        for (int n = 0; n < 2; ++n) acc[a][b][m][n] = (f32x4){0.f, 0.f, 0.f, 0.f};
  bf16x8 At[4][2], B0[2][2], B1[2][2];
  const char* cA = (const char*)g.A + (size_t)cur.pm * tstep; const char* cB = (const char*)g.Bt + (size_t)cur.pn * tstep;
  PG8_STAGE(PG8_SB(0, 0), cB, voffB); PG8_STAGE(PG8_SA(0, 0), cA, voffA); PG8_STAGE(PG8_SB(0, 1), cB + hstep, voffB); PG8_STAGE(PG8_SA(0, 1), cA + hstep, voffA);
  if (wr == 1) PG8_BAR;
  PG8_WAIT_V(4); PG8_BAR;
  PG8_STAGE(PG8_SB(1, 0), cB + kstep, voffB); PG8_STAGE(PG8_SA(1, 0), cA + kstep, voffA); PG8_STAGE(PG8_SB(1, 1), cB + hstep + kstep, voffB);
  PG8_WAIT_V(6); PG8_BAR;
  for (;;) {
    const bool has_next = S.next(ui + 1, nxt);
    const char* nA = has_next ? (const char*)g.A + (size_t)nxt.pm * tstep : cA; const char* nB = has_next ? (const char*)g.Bt + (size_t)nxt.pn * tstep : cB;
    for (int t = 0; t < nt; t += 2) {
      const bool last = (t == nt - 2);
      const char* a1 = cA + (size_t)(t + 1) * kstep;
      const char* a2 = last ? nA : cA + (size_t)(t + 2) * kstep; const char* b2 = last ? nB : cB + (size_t)(t + 2) * kstep;
      const char* a3 = a2 + kstep; const char* b3 = b2 + kstep;
      PG8_LDB(B0, 0, 0); PG8_SCHED; PG8_LDA(At, 0, 0); PG8_STAGE(PG8_SA(1, 1), a1 + hstep, voffA);
      PG8_WAIT_L(8); PG8_BAR; PG8_WAIT_L(0); PG8_MMA(0, 0, At, B0); PG8_BAR; PG8_SCHED;
      PG8_LDB(B1, 0, 1); PG8_STAGE(PG8_SB(0, 0), b2, voffB);
      PG8_BAR; PG8_WAIT_L(0); PG8_MMA(0, 1, At, B1); PG8_BAR;
      PG8_LDA(At, 0, 1); PG8_STAGE(PG8_SA(0, 0), a2, voffA);
      PG8_BAR; PG8_WAIT_L(0); PG8_MMA(1, 0, At, B0); PG8_BAR; PG8_SCHED;
      PG8_STAGE(PG8_SB(0, 1), b2 + hstep, voffB);
      PG8_WAIT_V(6); PG8_BAR; PG8_MMA(1, 1, At, B1); PG8_BAR;
      PG8_LDB(B0, 1, 0); PG8_SCHED; PG8_LDA(At, 1, 0); PG8_STAGE(PG8_SA(0, 1), a2 + hstep, voffA);
      PG8_WAIT_L(8); PG8_BAR; PG8_WAIT_L(0); PG8_MMA(0, 0, At, B0); PG8_BAR; PG8_SCHED;
      PG8_LDB(B1, 1, 1); PG8_STAGE(PG8_SB(1, 0), b3, voffB);
      PG8_BAR; PG8_WAIT_L(0); PG8_MMA(0, 1, At, B1); PG8_BAR;
      PG8_LDA(At, 1, 1); PG8_STAGE(PG8_SA(1, 0), a3, voffA);
      PG8_BAR; PG8_WAIT_L(0); PG8_MMA(1, 0, At, B0); PG8_BAR; PG8_SCHED;
      PG8_STAGE(PG8_SB(1, 1), b3 + hstep, voffB);
      PG8_WAIT_V(6); PG8_BAR; PG8_MMA(1, 1, At, B1); PG8_BAR;
    }
    E(acc, cur, wr, wc, fr, fq);
    if (!has_next) break;
#pragma unroll
    for (int a = 0; a < 2; ++a)
#pragma unroll
      for (int b = 0; b < 2; ++b)
#pragma unroll
        for (int m = 0; m < 4; ++m)
#pragma unroll
          for (int n = 0; n < 2; ++n) acc[a][b][m][n] = (f32x4){0.f, 0.f, 0.f, 0.f};
    cur = nxt; cA = nA; cB = nB; ++ui;
  }
  PG8_WAIT_V(0);
  if (wr == 0) PG8_BAR;
  PG8_BAR;
#undef PG8_SA
#undef PG8_SB
#undef PG8_STAGE
#undef PG8_LDA
#undef PG8_LDB
#undef PG8_MMA
#undef PG8_WAIT_V
#undef PG8_WAIT_L
#undef PG8_BAR
#undef PG8_SCHED
}
}
using pg8::Unit;
typedef f32x4 AccT[2][2][4][2];

struct EpiIn {
  static constexpr bool PERM = true; static constexpr bool APERM = false;
  bf16_t* O; int ldc; int even; float* out; bf16_t* yts; bf16_t* ytc;
  __device__ __forceinline__ void operator()(const AccT& acc, const Unit& u, int wr, int wc, int fr, int fq) const {
    const int row0 = u.pm * 256 + wr * 64 + fr;
    if (even && u.pn >= 18) {
      const int g = u.pn - 18;
      bf16_t* base; size_t rs; int half, pos0;
      if (u.pm < 32) { base = ytc + (size_t)((u.pm * 4 + g) * 128) * 512; rs = 512; half = 256; pos0 = wr * 64 + fr; }
      else { const int b = (u.pm - 32) >> 3; base = yts + (size_t)((b * 4 + g) * 128) * 4096; rs = 4096; half = 2048; pos0 = ((u.pm - 32) & 7) * 256 + wr * 64 + fr; }
#pragma unroll
      for (int ai = 0; ai < 2; ++ai)
#pragma unroll
        for (int m = 0; m < 4; ++m) { const int pos = pos0 + ai * 128 + m * 16;
#pragma unroll
          for (int bj = 0; bj < 2; ++bj)
#pragma unroll
            for (int n = 0; n < 2; ++n)
#pragma unroll
              for (int j = 0; j < 4; ++j) { const int d = wc * 32 + 8 * fq + 4 * n + j;
                base[(size_t)d * rs + bj * half + pos] = (bf16_t)(cvtpk(acc[ai][bj][m][n][j], 0.f) & 0xffffu); } }
      return;
    }
    const int col0 = u.pn * 256 + wc * 32 + 8 * fq;
    float* side = nullptr; int sld = 0;
    if (u.pm < 32) {
      if (even) { if (u.pn >= 6 && u.pn < 12) { side = out + O_NAK + (col0 - 1536); sld = 1536; } else if (u.pn >= 12) { side = out + O_NAV + (col0 - 3072); sld = 1536; } }
      else if (u.pn >= 10) { side = out + O_GV + (col0 - 2560); sld = 512; }
    }
#pragma unroll
    for (int ai = 0; ai < 2; ++ai)
#pragma unroll
      for (int m = 0; m < 4; ++m) { const int row = row0 + ai * 128 + m * 16; bf16_t* rowp = O + (size_t)row * ldc + col0;
#pragma unroll
        for (int bj = 0; bj < 2; ++bj) { const f32x4 v0 = acc[ai][bj][m][0], v1 = acc[ai][bj][m][1];
          u32x4 w = {cvtpk(v0[0], v0[1]), cvtpk(v0[2], v0[3]), cvtpk(v1[0], v1[1]), cvtpk(v1[2], v1[3])};
          *(u32x4*)(rowp + bj * 128) = w;
          if (side) { float* sp = side + (size_t)row * sld + bj * 128; *(f32x4*)sp = v0; *(f32x4*)(sp + 4) = v1; } } }
  }
};
struct EpiRes {
  static constexpr bool PERM = true; static constexpr bool APERM = false;
  const float* xp; const float* xs; bf16_t* xb; bf16_t* xo; const float* part; int layer, gk; int from_in;
  __device__ __forceinline__ void operator()(const AccT& acc, const Unit& u, int wr, int wc, int fr, int fq) const {
    const int bidx = u.pm < 32 ? 8 : ((u.pm - 32) >> 3);
    const int row0 = u.pm * 256 + wr * 64 + fr, col0 = u.pn * 256 + wc * 32 + 8 * fq;
    const float* xin = u.pm < 32 ? xp : (xs - (size_t)NP * DM);
    f32x4 gv[2][2];
#pragma unroll
    for (int bj = 0; bj < 2; ++bj)
#pragma unroll
      for (int n = 0; n < 2; ++n) gv[bj][n] = modv4(part, layer, bidx, gk, col0 + bj * 128 + n * 4);
#pragma unroll
    for (int ai = 0; ai < 2; ++ai)
#pragma unroll
      for (int m = 0; m < 4; ++m) { const size_t ro = (size_t)(row0 + ai * 128 + m * 16) * DM + col0;
#pragma unroll
        for (int bj = 0; bj < 2; ++bj) { f32x4 x0, x1;
          if (from_in) { x0 = *(const f32x4*)(xin + ro + bj * 128); x1 = *(const f32x4*)(xin + ro + bj * 128 + 4); }
          else { const u32x4 w = *(const u32x4*)(xb + ro + bj * 128); x0 = (f32x4){bflo(w[0]), bfhi(w[0]), bflo(w[1]), bfhi(w[1])}; x1 = (f32x4){bflo(w[2]), bfhi(w[2]), bflo(w[3]), bfhi(w[3])}; }
          x0 = x0 + gv[bj][0] * acc[ai][bj][m][0]; x1 = x1 + gv[bj][1] * acc[ai][bj][m][1];
          u32x4 o = {cvtpk(x0[0], x0[1]), cvtpk(x0[2], x0[3]), cvtpk(x1[0], x1[1]), cvtpk(x1[2], x1[3])};
          *(u32x4*)(xo + ro + bj * 128) = o; } }
  }
};
__device__ __forceinline__ float dpp_ror1(float v) { return __builtin_bit_cast(float, __builtin_amdgcn_update_dpp(0, __builtin_bit_cast(int, v), 0x121, 0xf, 0xf, false)); }
__device__ __forceinline__ float dpp_rol1(float v) { return __builtin_bit_cast(float, __builtin_amdgcn_update_dpp(0, __builtin_bit_cast(int, v), 0x12F, 0xf, 0xf, false)); }
struct EpiUp {
  static constexpr bool PERM = true; static constexpr bool APERM = true;
  bf16_t* G; float* UB; const float* cw; const float* cb;
  __device__ __forceinline__ void operator()(const AccT& acc, const Unit& u, int wr, int wc, int fr, int fq) const {
    const int cc0 = wc * 32 + 8 * fq;
    const int chv = u.pn * 128 + cc0;
    unsigned gp[2][4][4];
#pragma unroll
    for (int n = 0; n < 2; ++n) {
      const int ch = chv + 4 * n;
      f32x4 cwv[1][8];
      cwv[0][0] = *(const f32x4*)(cw + ch); cwv[0][1] = *(const f32x4*)(cw + FF2 + ch); cwv[0][2] = *(const f32x4*)(cw + 2 * FF2 + ch); cwv[0][3] = *(const f32x4*)(cb + ch);
      cwv[0][4] = *(const f32x4*)(cw + FF + ch); cwv[0][5] = *(const f32x4*)(cw + FF2 + FF + ch); cwv[0][6] = *(const f32x4*)(cw + 2 * FF2 + FF + ch); cwv[0][7] = *(const f32x4*)(cb + FF + ch);
      const f32x4 v0 = cwv[0][0] * -0.6931471805599453f, v1 = cwv[0][1] * -0.6931471805599453f, v2 = cwv[0][2] * -0.6931471805599453f, vb = cwv[0][3] * -0.6931471805599453f;
      const f32x4 g0 = cwv[0][4] * -1.4426950408889634f, g1 = cwv[0][5] * -1.4426950408889634f, g2 = cwv[0][6] * -1.4426950408889634f, gb = cwv[0][7] * -1.4426950408889634f;
#pragma unroll
      for (int ai = 0; ai < 2; ++ai) {
        const int chunk = u.pm * 4 + ai * 2 + wr;
        f32x4 o[4];
        {
          const f32x4 a0 = acc[ai][0][0][n], a1 = acc[ai][0][1][n], a2 = acc[ai][0][2][n], a3 = acc[ai][0][3][n];
          const f32x4 b0 = acc[ai][1][0][n], b1 = acc[ai][1][1][n], b2 = acc[ai][1][2][n], b3 = acc[ai][1][3][n];
          f32x4 au, ad, bu, bd;
#pragma unroll
          for (int j = 0; j < 4; ++j) { au[j] = dpp_ror1(a3[j]); ad[j] = dpp_rol1(a0[j]); bu[j] = dpp_ror1(b3[j]); bd[j] = dpp_rol1(b0[j]); }
          f32x4 vv[4], gg[4];
          vv[0] = v0 * au + v1 * a0 + v2 * a1 + vb; vv[1] = v0 * a0 + v1 * a1 + v2 * a2 + vb; vv[2] = v0 * a1 + v1 * a2 + v2 * a3 + vb; vv[3] = v0 * a2 + v1 * a3 + v2 * ad + vb;
          gg[0] = g0 * bu + g1 * b0 + g2 * b1 + gb; gg[1] = g0 * b0 + g1 * b1 + g2 * b2 + gb; gg[2] = g0 * b1 + g1 * b2 + g2 * b3 + gb; gg[3] = g0 * b2 + g1 * b3 + g2 * bd + gb;
#pragma unroll
          for (int m = 0; m < 4; ++m) { f32x4 e, r;
#pragma unroll
            for (int j = 0; j < 4; ++j) e[j] = __builtin_amdgcn_exp2f(gg[m][j]);
            e = e + 1.f;
#pragma unroll
            for (int j = 0; j < 4; ++j) r[j] = __builtin_amdgcn_rcpf(e[j]);
            o[m] = (vv[m] * gg[m]) * r; }
        }
#pragma unroll
        for (int m = 0; m < 4; ++m) { gp[ai][m][n * 2 + 0] = cvtpk(o[m][0], o[m][1]); gp[ai][m][n * 2 + 1] = cvtpk(o[m][2], o[m][3]); }
        if (fr == 0 || fr == 15) {
          float* ub = UB + ((size_t)chunk * 4 + (fr ? 2 : 0)) * FF2 + u.pn * 256 + cc0 + 4 * n;
          if (fr == 0) { *(f32x4*)ub = acc[ai][0][0][n]; *(f32x4*)(ub + 128) = acc[ai][1][0][n]; *(f32x4*)(ub + FF2) = acc[ai][0][1][n]; *(f32x4*)(ub + FF2 + 128) = acc[ai][1][1][n]; }
          else { *(f32x4*)ub = acc[ai][0][2][n]; *(f32x4*)(ub + 128) = acc[ai][1][2][n]; *(f32x4*)(ub + FF2) = acc[ai][0][3][n]; *(f32x4*)(ub + FF2 + 128) = acc[ai][1][3][n]; }
        }
      }
    }
#pragma unroll
    for (int ai = 0; ai < 2; ++ai) {
      const int rowc = (u.pm * 4 + ai * 2 + wr) * 64;
#pragma unroll
      for (int m = 0; m < 4; ++m) {
        const bool skip = (m == 0 && fr == 0) || (m == 3 && fr == 15);
        if (!skip) { u32x4 w = {gp[ai][m][0], gp[ai][m][1], gp[ai][m][2], gp[ai][m][3]}; *(u32x4*)(G + (size_t)(rowc + 4 * fr + m) * FF + chv) = w; }
      }
    }
  }
};
struct EpiFourier {
  static constexpr bool PERM = true; static constexpr bool APERM = false;
  bf16_t* mix; int rowbase, npos; float scale;
  __device__ __forceinline__ void operator()(const AccT& acc, const Unit& u, int wr, int wc, int fr, int fq) const {
    const int pos0 = u.pm * 256 + wr * 64 + fr;
#pragma unroll
    for (int bj = 0; bj < 2; ++bj) {
      const int col = u.pn * 256 + bj * 128 + wc * 32 + 8 * fq; const int b = col >> 9, gd = col & 511;
      bf16_t* basep = mix + (size_t)(rowbase + b * npos) * DM + 1536 + gd;
#pragma unroll
      for (int ai = 0; ai < 2; ++ai)
#pragma unroll
        for (int m = 0; m < 4; ++m) { const f32x4 v0 = acc[ai][bj][m][0] * scale, v1 = acc[ai][bj][m][1] * scale;
          u32x4 w = {cvtpk(v0[0], v0[1]), cvtpk(v0[2], v0[3]), cvtpk(v1[0], v1[1]), cvtpk(v1[2], v1[3])};
          *(u32x4*)(basep + (size_t)(pos0 + ai * 128 + m * 16) * DM) = w; }
    }
  }
};

namespace at {
constexpr int D = 128, NW = 8, QBLK = 32, KVBLK = 64;
constexpr float SCALE = 0.088388347648318440f;
constexpr float THR = 8.f;
constexpr size_t SHM_V = KVBLK * D * 2, SHM_K = KVBLK * D * 2, SHM_ATTN = 2 * SHM_V + 2 * SHM_K + NW * 64 * 4;
#define KSWZ(row, colB) ((row) * 256 + ((colB) ^ (((row) & 7) << 4)))
#define SBAR() __builtin_amdgcn_sched_barrier(0)
__device__ __forceinline__ int crow(int r, int hi) { return (r & 3) + 8 * (r >> 2) + 4 * hi; }
__device__ __forceinline__ void partialSM(f32x16& p0, f32x16& p1, float& m_reg, float& mn, float& alpha) {
  constexpr float C = SCALE * 1.4426950408889634f;
  float pmax = p0[0];
#pragma unroll
  for (int r = 1; r < 16; ++r) pmax = fmaxf(pmax, p0[r]);
#pragma unroll
  for (int r = 0; r < 16; ++r) pmax = fmaxf(pmax, p1[r]);
  { auto rr = __builtin_amdgcn_permlane32_swap(__float_as_uint(pmax), __float_as_uint(pmax), false, false);
    pmax = fmaxf(__uint_as_float(rr[0]), __uint_as_float(rr[1])); }
  if (__builtin_expect(__all(pmax - m_reg <= THR / SCALE), 1)) { mn = m_reg; alpha = 1.f; }
  else { mn = fmaxf(m_reg, pmax); alpha = __builtin_amdgcn_exp2f((m_reg - mn) * C); m_reg = mn; }
  float mnC = -mn * C;
  p0 = p0 * C + mnC; p1 = p1 * C + mnC;
#pragma unroll
  for (int r = 0; r < 16; ++r) p0[r] = __builtin_amdgcn_exp2f(p0[r]);
}
__device__ __forceinline__ void finishSM(f32x16& p0, f32x16& p1, float alpha, float& l_reg, bf16x8& pa0, bf16x8& pa1, bf16x8& pa2, bf16x8& pa3) {
#pragma unroll
  for (int r = 0; r < 16; ++r) p1[r] = __builtin_amdgcn_exp2f(p1[r]);
  float ps;
  { typedef float f32x8 __attribute__((ext_vector_type(8))); typedef float f32x2v __attribute__((ext_vector_type(2)));
    const f32x16 s16 = p0 + p1; const f32x8 s8 = s16.lo + s16.hi; const f32x4 s4 = s8.lo + s8.hi; const f32x2v s2 = s4.lo + s4.hi; ps = s2.x + s2.y; }
  { auto rr = __builtin_amdgcn_permlane32_swap(__float_as_uint(ps), __float_as_uint(ps), false, false);
    ps = __uint_as_float(rr[0]) + __uint_as_float(rr[1]); }
  l_reg = l_reg * alpha + ps;
#define PK4(P, BASE, OUT) do { unsigned a0 = cvtpk(P[BASE + 0], P[BASE + 1]), a1 = cvtpk(P[BASE + 2], P[BASE + 3]);   \
    unsigned b0 = cvtpk(P[BASE + 4], P[BASE + 5]), b1 = cvtpk(P[BASE + 6], P[BASE + 7]);                              \
    auto r0 = __builtin_amdgcn_permlane32_swap(a0, b0, false, false); auto r1 = __builtin_amdgcn_permlane32_swap(a1, b1, false, false); \
    u32x4 w = {r0[0], r1[0], r0[1], r1[1]}; OUT = *reinterpret_cast<bf16x8*>(&w); } while (0)
  PK4(p0, 0, pa0); PK4(p0, 8, pa1); PK4(p1, 0, pa2); PK4(p1, 8, pa3);
#undef PK4
}
__device__ __forceinline__ void qkt(f32x16& p0, f32x16& p1, const char* Ks, const bf16x8* qr, int r32, int hi) {
  p0 = f32x16{}; p1 = f32x16{};
#pragma unroll
  for (int d0 = 0; d0 < 8; ++d0) { int cb = (d0 * 16 + hi * 8) * 2;
    bf16x8 b0 = *reinterpret_cast<const bf16x8*>(Ks + KSWZ(r32, cb));
    bf16x8 b1 = *reinterpret_cast<const bf16x8*>(Ks + KSWZ(32 + r32, cb));
    p0 = __builtin_amdgcn_mfma_f32_32x32x16_bf16(b0, qr[d0], p0, 0, 0, 0);
    p1 = __builtin_amdgcn_mfma_f32_32x32x16_bf16(b1, qr[d0], p1, 0, 0, 0); }
}
__device__ __forceinline__ int v_st(int k, int c) { const int kk = (k & ~0xC) | ((k & 4) << 1) | ((k & 8) >> 1); return ((kk >> 3) * 4 + (c >> 5)) * 512 + ((kk & 7) * 32 + (c & 31)) * 2; }
__device__ __forceinline__ int v_rd_base(int lane) { return ((lane & 3) << 3) | (((lane >> 2) & 3) << 6) | (((lane >> 4) & 1) << 5) | (((lane >> 5) & 1) << 8); }
constexpr int v_rd_off(int d0, int ks, int half) { return d0 * 512 + ks * 4096 + half * 2048; }
template <int OFF> __device__ __forceinline__ s16x4 tr_read(int vb) {
  s16x4 r; asm volatile("ds_read_b64_tr_b16 %0, %1 offset:%2" : "=&v"(r) : "v"(vb), "i"(OFF) : "memory"); return r;
}
template <int D0> __device__ __forceinline__ void pv_one(f32x16& od, int vb, bf16x8 pa0, bf16x8 pa1, bf16x8 pa2, bf16x8 pa3) {
  const s16x4 l0 = tr_read<v_rd_off(D0, 0, 0)>(vb), h0 = tr_read<v_rd_off(D0, 0, 1)>(vb), l1 = tr_read<v_rd_off(D0, 1, 0)>(vb), h1 = tr_read<v_rd_off(D0, 1, 1)>(vb);
  const s16x4 l2 = tr_read<v_rd_off(D0, 2, 0)>(vb), h2 = tr_read<v_rd_off(D0, 2, 1)>(vb), l3 = tr_read<v_rd_off(D0, 3, 0)>(vb), h3 = tr_read<v_rd_off(D0, 3, 1)>(vb);
  asm volatile("s_waitcnt lgkmcnt(0)" ::: "memory"); SBAR();
#define PK(L, H) (bf16x8){L[0], L[1], L[2], L[3], H[0], H[1], H[2], H[3]}
  od = __builtin_amdgcn_mfma_f32_32x32x16_bf16(pa0, PK(l0, h0), od, 0, 0, 0);
  od = __builtin_amdgcn_mfma_f32_32x32x16_bf16(pa1, PK(l1, h1), od, 0, 0, 0);
  od = __builtin_amdgcn_mfma_f32_32x32x16_bf16(pa2, PK(l2, h2), od, 0, 0, 0);
  od = __builtin_amdgcn_mfma_f32_32x32x16_bf16(pa3, PK(l3, h3), od, 0, 0, 0);
#undef PK
}
__device__ __forceinline__ void pv_d0(f32x16* o, int vb, bf16x8 pa0, bf16x8 pa1, bf16x8 pa2, bf16x8 pa3) {
  pv_one<0>(o[0], vb, pa0, pa1, pa2, pa3); pv_one<1>(o[1], vb, pa0, pa1, pa2, pa3); pv_one<2>(o[2], vb, pa0, pa1, pa2, pa3); pv_one<3>(o[3], vb, pa0, pa1, pa2, pa3);
}
struct Desc {
  const bf16_t* Q; int ldq;
  const bf16_t* K0; const bf16_t* V0; int ld0, n0;
  const bf16_t* K1; const bf16_t* V1; int ld1;
  int seq;
  bf16_t* O; int ldo;
  int ks, qrow0;
};
template <int MODE> __device__ __forceinline__ void na_mask(f32x16& p0, f32x16& p1, int t, const Desc& d, int wid, int r32, int hi, const float* btab) {
  if constexpr (MODE == 1) {
    if (t >= 4) {
      const int kr = d.ks + t - 4, qrow = d.qrow0 + (wid >> 1), qc = (wid & 1) * 32 + r32;
      const int r0q = min(max(qrow - 4, 0), 24);
      const bool rowok = (kr >= r0q) && (kr < r0q + 8);
      if (rowok) {
        const int qs = min(max(qc - 8, 0), 48);
        const float* brow = btab + (kr - qrow + 7) * 31 + (15 - qc + 4 * hi);
        const int kb = 4 * hi - qs;
#pragma unroll
        for (int rg = 0; rg < 4; ++rg) {
#pragma unroll
          for (int r = rg * 4; r < rg * 4 + 4; ++r) {
            const int kc = (r & 3) + 8 * (r >> 2);
            const bool ok0 = ((unsigned)(kc + kb) < 16u);
            const float b0 = brow[kc];
            p0[r] = ok0 ? p0[r] + b0 : -1e30f;
          }
          SBAR();
        }
#pragma unroll
        for (int rg = 0; rg < 4; ++rg) {
#pragma unroll
          for (int r = rg * 4; r < rg * 4 + 4; ++r) {
            const int kc = (r & 3) + 8 * (r >> 2);
            const bool ok1 = ((unsigned)(kc + 32 + kb) < 16u);
            const float b1 = brow[kc + 32];
            p1[r] = ok1 ? p1[r] + b1 : -1e30f;
          }
          SBAR();
        }
      } else {
#pragma unroll
        for (int r = 0; r < 16; ++r) { p0[r] = -1e30f; p1[r] = -1e30f; }
      }
    }
  }
}
template <int MODE>
__device__ __forceinline__ void attn_body(const Desc& d, char* lds) {
  const int tid = tid_opaque(), wid = tid >> 6, lane = tid & 63, r32 = lane & 31, hi = lane >> 5;
  char* V_lds = lds; char* K_lds = lds + 2 * SHM_V;
  float* ws = (float*)(lds + 2 * SHM_V + 2 * SHM_K) + wid * 64; float* li_l = ws; float* al_l = ws + 32;
  const float* btab = (const float*)(lds + SHM_ATTN) + 64;
  float m_reg = -1e30f, l_reg = 0; f32x16 o[4] = {}; bf16x8 qr[8];
  const bf16_t* Qw = d.Q + (long)(wid * QBLK + r32) * d.ldq + hi * 8;
#pragma unroll
  for (int d0 = 0; d0 < 8; ++d0) qr[d0] = *reinterpret_cast<const bf16x8*>(Qw + d0 * 16);
  const int sr = tid >> 4, sc = (tid & 15) * 8, vst0 = v_st(sr, sc), vst1 = v_st(32 + sr, sc);
  const int vb0 = (int)(uintptr_t)V_lds + v_rd_base(lane);
  constexpr int SDEPTH = (MODE == 1) ? 1 : 2;
  struct { bf16x8 vs0, vs1, ks0, ks1; } sr_[SDEPTH];
  const unsigned vo0a = (unsigned)(sr * d.ld0 + sc) * 2u, vo0b = (unsigned)((sr + 32) * d.ld0 + sc) * 2u, vo1a = (unsigned)(sr * d.ld1 + sc) * 2u, vo1b = (unsigned)((sr + 32) * d.ld1 + sc) * 2u;
#define SLOAD(i, k0) do { const bool s0_ = (k0) < d.n0; \
    const char* kb_ = s0_ ? (const char*)d.K0 + (size_t)(k0) * d.ld0 * 2 : (const char*)d.K1 + (size_t)((k0) - d.n0) * d.ld1 * 2; \
    const char* vb_ = s0_ ? (const char*)d.V0 + (size_t)(k0) * d.ld0 * 2 : (const char*)d.V1 + (size_t)((k0) - d.n0) * d.ld1 * 2; \
    const unsigned oa_ = s0_ ? vo0a : vo1a, ob_ = s0_ ? vo0b : vo1b; \
    sr_[i].vs0 = *reinterpret_cast<const bf16x8*>(vb_ + oa_); sr_[i].vs1 = *reinterpret_cast<const bf16x8*>(vb_ + ob_); \
    sr_[i].ks0 = *reinterpret_cast<const bf16x8*>(kb_ + oa_); sr_[i].ks1 = *reinterpret_cast<const bf16x8*>(kb_ + ob_); } while (0)
#define SWRITE(b, i) do { *(bf16x8*)(V_lds + (b) * SHM_V + vst0) = sr_[i].vs0;          \
    *(bf16x8*)(V_lds + (b) * SHM_V + vst1) = sr_[i].vs1; int kc = sc * 2;               \
    *(bf16x8*)(K_lds + (b) * SHM_K + KSWZ(sr, kc)) = sr_[i].ks0;                       \
    *(bf16x8*)(K_lds + (b) * SHM_K + KSWZ(32 + sr, kc)) = sr_[i].ks1; } while (0)
#define SWAIT() do { if constexpr (SDEPTH == 2) asm volatile("s_waitcnt vmcnt(4)" ::: "memory"); else asm volatile("s_waitcnt vmcnt(0)" ::: "memory"); } while (0)
#define RESC(a) do { if (__any((a) < 1.f)) { if (hi == 0) al_l[r32] = (a); asm volatile("s_waitcnt lgkmcnt(0)" ::: "memory"); \
    _Pragma("unroll") for (int dd = 0; dd < 4; ++dd) _Pragma("unroll") for (int r = 0; r < 16; ++r) o[dd][r] *= al_l[crow(r, hi)]; } } while (0)
  f32x16 pA0, pA1, pB0, pB1; float mnA, mnB, alA, alB; bf16x8 pa0, pa1, pa2, pa3; const int NT = d.seq / KVBLK;
  constexpr int SE = 0, SO = SDEPTH - 1;
  SLOAD(SE, 0); asm volatile("s_waitcnt vmcnt(0)" ::: "memory"); SWRITE(0, SE); __syncthreads();
  qkt(pA0, pA1, K_lds, qr, r32, hi); na_mask<MODE>(pA0, pA1, 0, d, wid, r32, hi, btab); partialSM(pA0, pA1, m_reg, mnA, alA);
  SLOAD(SO, KVBLK); if constexpr (SDEPTH == 2) { if (2 < NT) SLOAD(SE, 2 * KVBLK); }
  SWAIT(); SWRITE(1, SO); if constexpr (SDEPTH == 1) { if (2 < NT) SLOAD(SE, 2 * KVBLK); } __syncthreads();
  for (int j = 1; j + 1 < NT; j += 2) {
    SBAR(); qkt(pB0, pB1, K_lds + SHM_K, qr, r32, hi); na_mask<MODE>(pB0, pB1, j, d, wid, r32, hi, btab);
    finishSM(pA0, pA1, alA, l_reg, pa0, pa1, pa2, pa3); SBAR();
    if constexpr (SDEPTH == 2) SLOAD(SO, (j + SDEPTH) * KVBLK); SBAR();
    pv_d0(o, vb0, pa0, pa1, pa2, pa3); partialSM(pB0, pB1, m_reg, mnB, alB);
    __syncthreads(); SWAIT(); SWRITE(0, SE); if constexpr (SDEPTH == 1) SLOAD(SE, (j + 2) * KVBLK);
    RESC(alB); __syncthreads();
    SBAR(); qkt(pA0, pA1, K_lds, qr, r32, hi); na_mask<MODE>(pA0, pA1, j + 1, d, wid, r32, hi, btab);
    finishSM(pB0, pB1, alB, l_reg, pa0, pa1, pa2, pa3); SBAR();
    if constexpr (SDEPTH == 2) { if (j + 3 < NT) SLOAD(SE, (j + 3) * KVBLK); } SBAR();
    pv_d0(o, vb0 + (int)SHM_V, pa0, pa1, pa2, pa3); partialSM(pA0, pA1, m_reg, mnA, alA);
    __syncthreads(); SWAIT(); SWRITE(1, SO); if constexpr (SDEPTH == 1) { if (j + 3 < NT) SLOAD(SO, (j + 3) * KVBLK); }
    RESC(alA); __syncthreads();
  }
  SBAR(); qkt(pB0, pB1, K_lds + SHM_K, qr, r32, hi); na_mask<MODE>(pB0, pB1, NT - 1, d, wid, r32, hi, btab);
  finishSM(pA0, pA1, alA, l_reg, pa0, pa1, pa2, pa3); SBAR();
  pv_d0(o, vb0, pa0, pa1, pa2, pa3); partialSM(pB0, pB1, m_reg, mnB, alB);
  __syncthreads(); RESC(alB);
  finishSM(pB0, pB1, alB, l_reg, pa0, pa1, pa2, pa3); SBAR();
  pv_d0(o, vb0 + (int)SHM_V, pa0, pa1, pa2, pa3);
  if (hi == 0) li_l[r32] = l_reg; asm volatile("s_waitcnt lgkmcnt(0)" ::: "memory");
  float rli[16];
#pragma unroll
  for (int r = 0; r < 16; ++r) rli[r] = __builtin_amdgcn_rcpf(li_l[crow(r, hi)]);
  bf16_t* Ow = d.O + (long)(wid * QBLK) * DM;
#pragma unroll
  for (int r = 0; r < 16; ++r) { int orow = crow(r, hi);
#pragma unroll
    for (int d0 = 0; d0 < 4; ++d0) Ow[(long)orow * DM + d0 * 32 + r32] = (bf16_t)(cvtpk(o[d0][r] * rli[r], 0.f) & 0xffffu); }
#undef SLOAD
#undef SWRITE
#undef SWAIT
#undef RESC
}
}

__device__ __forceinline__ void ada_item(const Params& p, int item, unsigned char* shm) {
  const int tid = tid_opaque(), wid = tid >> 6, lane = tid & 63;
  const int layer = item / 96, r = item % 96, kh = r / 48, cb = r % 48;
  float* sc = (float*)shm;
  float* red = (float*)shm + 9 * 1024;
  __syncthreads();
  for (int i = tid; i < 9 * 1024; i += 512) { const int rr = i >> 10, kk = i & 1023;
    const float v = rr < 8 ? p.in[I_C][rr * 2048 + kh * 1024 + kk] : p.in[I_CCTX][kh * 1024 + kk]; sc[i] = silu_f(v); }
  __syncthreads();
  const float* W = p.in[I_ADAW] + ((size_t)layer * 2048 + kh * 1024 + wid * 128) * 12288 + cb * 256 + lane * 4;
  f32x4 acc[9];
#pragma unroll
  for (int i = 0; i < 9; ++i) acc[i] = (f32x4){0.f, 0.f, 0.f, 0.f};
  for (int k = 0; k < 128; k += 8) {
    f32x4 w[8];
#pragma unroll
    for (int u = 0; u < 8; ++u) w[u] = *(const f32x4*)(W + (size_t)(k + u) * 12288);
#pragma unroll
    for (int u = 0; u < 8; ++u)
#pragma unroll
      for (int i = 0; i < 9; ++i) acc[i] += sc[i * 1024 + wid * 128 + k + u] * w[u];
  }
#pragma unroll
  for (int i = 0; i < 9; ++i) *(f32x4*)(red + ((size_t)wid * 9 + i) * 256 + lane * 4) = acc[i];
  __syncthreads();
  float* part = (float*)(p.ws + W_PART);
  for (int i = tid; i < 9 * 256; i += 512) { const int rr = i >> 8, c = i & 255; float s = 0.f;
#pragma unroll
    for (int w = 0; w < 8; ++w) s += red[((size_t)w * 9 + rr) * 256 + c];
    const int col = cb * 256 + c;
    if (kh == 0) s += p.in[I_ADAB][layer * 12288 + col];
    part[((size_t)(layer * 2 + kh) * 9 + rr) * 12288 + col] = s; }
}
template <int MAP> __device__ __forceinline__ void transpose_tile(const float* W, int ldw, int K, int k0, int n0, bf16_t* Wt, unsigned char* shm) {
  const int tid = tid_opaque(); float* tile = (float*)shm;
  __syncthreads();
  f32x4 v[8];
#pragma unroll
  for (int i = 0; i < 8; ++i) { const int kk = (tid >> 6) + i * 8, c4 = (tid & 63) * 4; v[i] = *(const f32x4*)(W + (size_t)(k0 + kk) * ldw + n0 + c4); }
#pragma unroll
  for (int i = 0; i < 8; ++i) { const int kk = (tid >> 6) + i * 8, c4 = (tid & 63) * 4; *(f32x4*)(tile + kk * 260 + c4) = v[i]; }
  __syncthreads();
  const int n = tid & 255, kq = tid >> 8; int col = n0 + n, row;
  if (MAP == 0) row = col;
  else { const int isg = col >= FF ? 1 : 0, ch = col - isg * FF; row = (ch >> 7) * 256 + isg * 128 + (ch & 127); }
  bf16_t* dst = Wt + (size_t)row * K + k0 + kq * 32;
#pragma unroll
  for (int s = 0; s < 4; ++s) { float f[8];
#pragma unroll
    for (int i = 0; i < 8; ++i) f[i] = tile[(kq * 32 + s * 8 + i) * 260 + n];
    u32x4 w = {cvtpk(f[0], f[1]), cvtpk(f[2], f[3]), cvtpk(f[4], f[5]), cvtpk(f[6], f[7])}; *(u32x4*)(dst + s * 8) = w; }
}
template <int J> __device__ __forceinline__ void fold_item(const float* W, int ldw, int colbase, const float* M, const float* cs, bf16_t* Wt, int rowbase, int kc, unsigned char* shm) {
  const int tid = tid_opaque(); float* wl = (float*)shm;
  constexpr int KPT = 32 * J / 512;
  __syncthreads();
#pragma unroll
  for (int i = 0; i < 2; ++i) { const int idx = tid + i * 512, kk = idx >> 5, c4 = (idx & 31) * 4;
    *(f32x4*)(wl + kk * 132 + c4) = *(const f32x4*)(W + (size_t)(kc * 32 + kk) * ldw + colbase + c4); }
  __syncthreads();
  const int j = tid % J, kq = tid / J;
  float acc[KPT];
#pragma unroll
  for (int i = 0; i < KPT; ++i) acc[i] = 0.f;
  for (int c = 0; c < 128; c += 4) {
    const float m0 = M[(c + 0) * J + j], m1 = M[(c + 1) * J + j], m2 = M[(c + 2) * J + j], m3 = M[(c + 3) * J + j];
#pragma unroll
    for (int i = 0; i < KPT; ++i) { const f32x4 wv = *(const f32x4*)(wl + (kq * KPT + i) * 132 + c); acc[i] += wv[0] * m0 + wv[1] * m1 + wv[2] * m2 + wv[3] * m3; }
  }
  const float s = cs ? cs[j] : 1.f;
  bf16_t* dst = Wt + (size_t)(rowbase + j) * DM + kc * 32 + kq * KPT;
#pragma unroll
  for (int i = 0; i < KPT; i += 8) { u32x4 w = {cvtpk(acc[i] * s, acc[i + 1] * s), cvtpk(acc[i + 2] * s, acc[i + 3] * s), cvtpk(acc[i + 4] * s, acc[i + 5] * s), cvtpk(acc[i + 6] * s, acc[i + 7] * s)};
    *(u32x4*)(dst + i) = w; }
}
__device__ __forceinline__ void fold_item2(const float* W, int ldw, int colbase, const float* M, int ldm, int mcol0, const float* cs, bf16_t* Wt, int rowbase, int kc, unsigned char* shm) {
  const int tid = tid_opaque(); float* wl = (float*)shm;
  float* ml = (float*)(shm + 16896);
  __syncthreads();
  f32x4 wr_[2], mr_[8];
#pragma unroll
  for (int i = 0; i < 2; ++i) { const int idx = tid + i * 512, kk = idx >> 5, c4 = (idx & 31) * 4; wr_[i] = *(const f32x4*)(W + (size_t)(kc * 32 + kk) * ldw + colbase + c4); }
#pragma unroll
  for (int i = 0; i < 8; ++i) { const int idx = tid + i * 512, c = idx >> 5, c4 = (idx & 31) * 4; mr_[i] = *(const f32x4*)(M + (size_t)c * ldm + mcol0 + c4); }
#pragma unroll
  for (int i = 0; i < 2; ++i) { const int idx = tid + i * 512, kk = idx >> 5, c4 = (idx & 31) * 4; *(f32x4*)(wl + kk * 132 + c4) = wr_[i]; }
#pragma unroll
  for (int i = 0; i < 8; ++i) { const int idx = tid + i * 512, c = idx >> 5, c4 = (idx & 31) * 4; *(f32x4*)(ml + c * 128 + c4) = mr_[i]; }
  __syncthreads();
  const int j = tid & 127, kq = tid >> 7;
  float acc[8];
#pragma unroll
  for (int i = 0; i < 8; ++i) acc[i] = 0.f;
#pragma unroll 4
  for (int c = 0; c < 128; c += 4) {
    const float m0 = ml[(c + 0) * 128 + j], m1 = ml[(c + 1) * 128 + j], m2 = ml[(c + 2) * 128 + j], m3 = ml[(c + 3) * 128 + j];
#pragma unroll
    for (int i = 0; i < 8; ++i) { const f32x4 wv = *(const f32x4*)(wl + (kq * 8 + i) * 132 + c); acc[i] += wv[0] * m0 + wv[1] * m1 + wv[2] * m2 + wv[3] * m3; }
  }
  const float sc_ = cs ? cs[j] : 1.f;
  u32x4 w = {cvtpk(acc[0] * sc_, acc[1] * sc_), cvtpk(acc[2] * sc_, acc[3] * sc_), cvtpk(acc[4] * sc_, acc[5] * sc_), cvtpk(acc[6] * sc_, acc[7] * sc_)};
  *(u32x4*)(Wt + (size_t)(rowbase + j) * DM + kc * 32 + kq * 8) = w;
}
template <int MODE, int NR> __device__ __forceinline__ void norm_rows(const Params& p, int row0, const float* xp, const float* xs, const float* g, int layer, int kshift, float* yout) {
  const int lane = tid_opaque() & 63;
  f32x4 v[NR][8]; float ss[NR];
#pragma unroll
  for (int r = 0; r < NR; ++r) { const int row = row0 + r * 8;
    const float* x = row < NP ? xp + (size_t)row * DM : xs + (size_t)(row - NP) * DM;
#pragma unroll
    for (int i = 0; i < 8; ++i) v[r][i] = *(const f32x4*)(x + (i * 64 + lane) * 4); }
#pragma unroll
  for (int r = 0; r < NR; ++r) { float s = 0.f;
#pragma unroll
    for (int i = 0; i < 8; ++i) s += v[r][i][0] * v[r][i][0] + v[r][i][1] * v[r][i][1] + v[r][i][2] * v[r][i][2] + v[r][i][3] * v[r][i][3];
    ss[r] = rsqrtf(wave_sum(s) * (1.f / 2048.f) + 1e-6f); }
  if (MODE == 0) {
    const int bidx = row0 < NP ? 8 : ((row0 - NP) >> 11);
    const float* part = (const float*)(p.ws + W_PART);
#pragma unroll
    for (int i = 0; i < 8; ++i) { const int c = (i * 64 + lane) * 4;
      const f32x4 gv = *(const f32x4*)(g + c), sh = modv4(part, layer, bidx, kshift, c), scl = modv4(part, layer, bidx, kshift + 1, c);
      const f32x4 gs = gv * (scl + 1.f);
#pragma unroll
      for (int r = 0; r < NR; ++r) { const f32x4 y = v[r][i] * ss[r] * gs + sh;
        u32x2 w = {cvtpk(y[0], y[1]), cvtpk(y[2], y[3])}; *(u32x2*)((bf16_t*)(p.ws + W_ACT) + (size_t)(row0 + r * 8) * DM + c) = w; } }
  } else {
#pragma unroll
    for (int i = 0; i < 8; ++i) { const int c = (i * 64 + lane) * 4; const f32x4 gv = *(const f32x4*)(g + c);
#pragma unroll
      for (int r = 0; r < NR; ++r) *(f32x4*)(yout + (size_t)(row0 + r * 8) * DM + c) = v[r][i] * ss[r] * gv; }
  }
}
template <int MODE, int NR> __device__ __forceinline__ void norm_rows_b(const Params& p, int row0, const float* g, int layer, int kshift, float* yout) {
  const int lane = tid_opaque() & 63;
  const bf16_t* xb = (const bf16_t*)(p.ws + W_XB);
  u32x4 v[NR][4]; float ss[NR];
#pragma unroll
  for (int r = 0; r < NR; ++r)
#pragma unroll
    for (int i = 0; i < 4; ++i) v[r][i] = *(const u32x4*)(xb + (size_t)(row0 + r * 8) * DM + (i * 64 + lane) * 8);
#pragma unroll
  for (int r = 0; r < NR; ++r) { float s = 0.f;
#pragma unroll
    for (int i = 0; i < 4; ++i)
#pragma unroll
      for (int e = 0; e < 4; ++e) { const float a = bflo(v[r][i][e]), b = bfhi(v[r][i][e]); s += a * a + b * b; }
    ss[r] = rsqrtf(wave_sum(s) * (1.f / 2048.f) + 1e-6f); }
  const int bidx = row0 < NP ? 8 : ((row0 - NP) >> 11);
  const float* part = (const float*)(p.ws + W_PART);
#pragma unroll
  for (int i = 0; i < 4; ++i) { const int c = (i * 64 + lane) * 8;
    f32x4 gs0 = *(const f32x4*)(g + c), gs1 = *(const f32x4*)(g + c + 4), sh0 = {0.f, 0.f, 0.f, 0.f}, sh1 = {0.f, 0.f, 0.f, 0.f};
    if (MODE == 0) { gs0 = gs0 * (modv4(part, layer, bidx, kshift + 1, c) + 1.f); gs1 = gs1 * (modv4(part, layer, bidx, kshift + 1, c + 4) + 1.f);
      sh0 = modv4(part, layer, bidx, kshift, c); sh1 = modv4(part, layer, bidx, kshift, c + 4); }
#pragma unroll
    for (int r = 0; r < NR; ++r) { const u32x4 w = v[r][i];
      const f32x4 x0 = {bflo(w[0]), bfhi(w[0]), bflo(w[1]), bfhi(w[1])}, x1 = {bflo(w[2]), bfhi(w[2]), bflo(w[3]), bfhi(w[3])};
      const f32x4 y0 = x0 * ss[r] * gs0 + sh0, y1 = x1 * ss[r] * gs1 + sh1;
      if (MODE == 0) { u32x4 o = {cvtpk(y0[0], y0[1]), cvtpk(y0[2], y0[3]), cvtpk(y1[0], y1[1]), cvtpk(y1[2], y1[3])};
        *(u32x4*)((bf16_t*)(p.ws + W_ACT) + (size_t)(row0 + r * 8) * DM + c) = o; }
      else { float* y = yout + (size_t)(row0 + r * 8) * DM + c; *(f32x4*)y = y0; *(f32x4*)(y + 4) = y1; } } }
}
__device__ __forceinline__ void fix_phase(const Params& p, int layer) {
  const float* UB = (const float*)(p.ws + W_UB); bf16_t* G = (bf16_t*)(p.ws + W_BIG);
  const float* cw = p.in[I_FFCW] + (size_t)layer * 3 * FF2; const float* cb = p.in[I_FFCB] + (size_t)layer * FF2;
  const long total = 768L * (FF / 4);
  for (long i = (long)blockIdx.x * 512 + tid_opaque(); i < total; i += (long)gridDim.x * 512) {
    const int rr = (int)(i / (FF / 4)), ch = (int)(i % (FF / 4)) * 4;
    const int chunk = rr >> 1, last = rr & 1, row = chunk * 64 + (last ? 63 : 0);
    const int seqlen = row < NP ? 256 : 2048; const int rel = row < NP ? row : row - NP;
    const int ubc = (ch >> 7) * 256 + (ch & 127);
    const float* pu; const float* cu; const float* nu; bool hp, hn;
    if (!last) { hp = (rel % seqlen) != 0; pu = UB + ((size_t)(chunk - 1) * 4 + 3) * FF2; cu = UB + ((size_t)chunk * 4 + 0) * FF2; nu = UB + ((size_t)chunk * 4 + 1) * FF2; hn = true; }
    else { hn = ((rel + 1) % seqlen) != 0; pu = UB + ((size_t)chunk * 4 + 2) * FF2; cu = UB + ((size_t)chunk * 4 + 3) * FF2; nu = UB + ((size_t)(chunk + 1) * 4 + 0) * FF2; hp = true; }
    const f32x4 z = {0.f, 0.f, 0.f, 0.f};
    const f32x4 pv = hp ? *(const f32x4*)(pu + ubc) : z, pg = hp ? *(const f32x4*)(pu + ubc + 128) : z;
    const f32x4 cv = *(const f32x4*)(cu + ubc), cgt = *(const f32x4*)(cu + ubc + 128);
    const f32x4 nv = hn ? *(const f32x4*)(nu + ubc) : z, ng = hn ? *(const f32x4*)(nu + ubc + 128) : z;
    const f32x4 val = *(const f32x4*)(cw + ch) * pv + *(const f32x4*)(cw + FF2 + ch) * cv + *(const f32x4*)(cw + 2 * FF2 + ch) * nv + *(const f32x4*)(cb + ch);
    const f32x4 gat = *(const f32x4*)(cw + FF + ch) * pg + *(const f32x4*)(cw + FF2 + FF + ch) * cgt + *(const f32x4*)(cw + 2 * FF2 + FF + ch) * ng + *(const f32x4*)(cb + FF + ch);
    u32x2 w = {cvtpk(silu_fast(gat[0]) * val[0], silu_fast(gat[1]) * val[1]), cvtpk(silu_fast(gat[2]) * val[2], silu_fast(gat[3]) * val[3])};
    *(u32x2*)(G + (size_t)row * FF + ch) = w;
  }
}
__device__ __forceinline__ void oddprep_row(const Params& p, int row) {
  const int lane = tid_opaque() & 63;
  bf16_t* pr = (bf16_t*)(p.ws + W_BIG) + (size_t)row * ODN;
  const bool lat = row >= NP; const int t = lat ? (row - NP) & 2047 : row & 255;
  const int grow = t >> 6, gcol = t & 63;
  const float* rope = (const float*)(p.ws + W_ROPE);
  unsigned raw[16];
#pragma unroll
  for (int v = 0; v < 16; ++v) raw[v] = *(const unsigned*)(pr + 512 + v * 128 + lane * 2);
  const int seqlen = lat ? 2048 : 256;
  const bf16_t* zb = pr + lane * 8;
  u32x4 zw[16];
#pragma unroll
  for (int si = 0; si < 16; ++si) { const int tc = min(max(t + si - 8, 0), seqlen - 1); zw[si] = *(const u32x4*)(zb + (long)(tc - t) * ODN); }
  const int e0 = lane * 2;
  const float gq0 = p.in[I_ODQG][e0], gq1 = p.in[I_ODQG][e0 + 1], gk0 = p.in[I_ODKG][e0], gk1 = p.in[I_ODKG][e0 + 1];
  const int pos = lane < 32 ? grow : gcol; const int i0 = e0 & 31;
  const float c0 = rope[(pos * 32 + i0) * 2], s0 = rope[(pos * 32 + i0) * 2 + 1], c1 = rope[(pos * 32 + i0 + 1) * 2], s1 = rope[(pos * 32 + i0 + 1) * 2 + 1];
  const bool isx1 = (lane & 16) == 0;
#pragma unroll
  for (int v = 0; v < 16; ++v) {
    float a = bflo(raw[v]), b = bfhi(raw[v]);
    const float ss = wave_sum_dpp(a * a + b * b);
    const float rinv = rsqrtf(ss * (1.f / 128.f) + 1e-6f);
    a = a * rinv * (v < 12 ? gq0 : gk0); b = b * rinv * (v < 12 ? gq1 : gk1);
    if (lat) {
      const float pa = __shfl_xor(a, 16), pb = __shfl_xor(b, 16);
      const float na = isx1 ? a * c0 - pa * s0 : a * c0 + pa * s0;
      const float nb = isx1 ? b * c1 - pb * s1 : b * c1 + pb * s1;
      a = na; b = nb;
    } else if (v >= 12) { float* o = p.out + O_GK + (size_t)row * 512 + (v - 12) * 128 + e0; o[0] = a; o[1] = b; }
    *(unsigned*)(pr + 512 + v * 128 + lane * 2) = cvtpk(a, b);
  }
  const int grp = lane >> 4; const int hw = 1 << grp;
  const int lo = max(t - hw, 0), hi = min(t + hw, seqlen);
  float acc[8];
#pragma unroll
  for (int i = 0; i < 8; ++i) acc[i] = 0.f;
#pragma unroll
  for (int si = 0; si < 16; ++si) { const int ts = t + si - 8; const float wgt = (ts >= lo && ts < hi) ? 1.f : 0.f;
#pragma unroll
    for (int i = 0; i < 4; ++i) { acc[2 * i] += wgt * bflo(zw[si][i]); acc[2 * i + 1] += wgt * bfhi(zw[si][i]); } }
  const u32x4 self = zw[8]; const float inv = 1.f / (float)(hi - lo);
  unsigned ow[4];
#pragma unroll
  for (int i = 0; i < 4; ++i) ow[i] = cvtpk(acc[2 * i] * inv - bflo(self[i]), acc[2 * i + 1] * inv - bfhi(self[i]));
  u32x4 w = {ow[0], ow[1], ow[2], ow[3]};
  *(u32x4*)((bf16_t*)(p.ws + W_ACT) + (size_t)row * DM + lane * 8) = w;
}

__device__ __forceinline__ void do_tile(const Params& p, int i, unsigned char* shm) {
  constexpr int T0 = 576, T1 = 256, T2 = 320, T3 = 256, T4 = 2816;
  if (i < T0) { const int kt = i / 18, nt = i % 18; transpose_tile<0>(p.in[I_EVWIN], 5120, DM, kt * 64, nt * 256, (bf16_t*)(p.ws + W_EVIN), shm); return; } i -= T0;
  if (i < T1) { const int kt = i / 8, nt = i % 8; transpose_tile<0>(p.in[I_EVWOUT], DM, DM, kt * 64, nt * 256, (bf16_t*)(p.ws + W_EVOUT), shm); return; } i -= T1;
  if (i < T2) { const int kt = i / 10, nt = i % 10; transpose_tile<0>(p.in[I_ODWIN], ODN, DM, kt * 64, 512 + nt * 256, (bf16_t*)(p.ws + W_ODIN), shm); return; } i -= T2;
  if (i < T3) { const int kt = i / 8, nt = i % 8; transpose_tile<0>(p.in[I_ODWOUT], DM, DM, kt * 64, nt * 256, (bf16_t*)(p.ws + W_ODOUT), shm); return; } i -= T3;
  if (i < T4) { const int l = i / 1408, r = i % 1408, kt = r / 44, nt = r % 44;
    transpose_tile<1>(p.in[I_FFUP] + (size_t)l * DM * FF2, FF2, DM, kt * 64, nt * 256, (bf16_t*)(p.ws + W_UP) + (size_t)l * FF2 * DM, shm); return; } i -= T4;
  { const int l = i / 704, r = i % 704, kt = r / 8, nt = r % 8;
    transpose_tile<0>(p.in[I_FFDN] + (size_t)l * FF * DM, DM, FF, kt * 64, nt * 256, (bf16_t*)(p.ws + W_DN) + (size_t)l * DM * FF, shm); }
}
__device__ __forceinline__ int tile_now(int j) { return j < 832 ? j : (j < 2240 ? 1408 + (j - 832) : 4224 + (j - 2240)); }
__device__ __forceinline__ int tile_def(int d) { return d < 576 ? 832 + d : (d < 1984 ? 2816 + (d - 576) : 4928 + (d - 1984)); }
__device__ __forceinline__ void prep_phase(const Params& p, unsigned char* shm) {
  const int G = gridDim.x, bid = blockIdx.x, tid = tid_opaque();
  {
    const bool defer = (G == 256);
    const int n_ada = defer ? 96 : 192, n_tiles = defer ? 2944 : 5632;
    unsigned* qctr = (unsigned*)(p.ws + W_BAR);
    volatile LAS unsigned* qslot = (volatile LAS unsigned*)((LAS unsigned char*)shm + (LDS_BYTES - 32));
    for (;;) {
      __syncthreads();
      if (tid == 0) *qslot = atomicAdd(qctr, 1u);
      __syncthreads();
      const int it0 = (int)*qslot;
      if (it0 >= n_ada + n_tiles) break;
      if (it0 < n_ada) { ada_item(p, it0, shm); continue; }
      do_tile(p, defer ? tile_now(it0 - n_ada) : it0 - n_ada, shm);
    }
  }
  const long gt = (long)bid * 512 + tid, gs = (long)G * 512;
  {
    const long n0 = 8L * 256 * 1536 / 8, n1 = 8L * 256 * 512 / 8;
    for (long i = gt; i < 2 * n0 + 2 * n1; i += gs) {
      const float* src; bf16_t* dst; long j = i;
      if (j < n0) { src = p.in[I_CNAK]; dst = (bf16_t*)(p.ws + W_CNAK); }
      else if (j < 2 * n0) { j -= n0; src = p.in[I_CNAV]; dst = (bf16_t*)(p.ws + W_CNAV); }
      else if (j < 2 * n0 + n1) { j -= 2 * n0; src = p.in[I_CGK]; dst = (bf16_t*)(p.ws + W_CGK); }
      else { j -= 2 * n0 + n1; src = p.in[I_CGV]; dst = (bf16_t*)(p.ws + W_CGV); }
      const f32x4 a = *(const f32x4*)(src + j * 8), b = *(const f32x4*)(src + j * 8 + 4);
      u32x4 w = {cvtpk(a[0], a[1]), cvtpk(a[2], a[3]), cvtpk(b[0], b[1]), cvtpk(b[2], b[3])}; *(u32x4*)(dst + j * 8) = w;
    }
  }
  {
    float* ct = (float*)shm;
    __syncthreads();
    for (int i = tid; i < 2048; i += 512) ct[i] = cospif((float)i * (2.f / 2048.f));
    __syncthreads();
    const long nS = 2048L * 4096 / 8, nC = 256L * 512 / 8;
    for (long i = gt; i < nS + nC; i += gs) {
      int npos, sh, ts; long j; bf16_t* dst;
      if (i < nS) { npos = 2048; sh = 11; ts = 0; j = i; dst = (bf16_t*)(p.ws + W_DFTS); } else { npos = 256; sh = 8; ts = 3; j = i - nS; dst = (bf16_t*)(p.ws + W_DFTC); }
      const int prow = (int)((j * 8) >> (sh + 1)), k0 = (int)((j * 8) & (2 * npos - 1));
      float f[8];
#pragma unroll
      for (int e = 0; e < 8; ++e) { const int k = k0 + e; const int kk = k & (npos - 1); const int m = ((prow * kk) & (npos - 1)) << ts;
        f[e] = (k < npos) ? ct[m] : -ct[(m - 512) & 2047]; }
      u32x4 w = {cvtpk(f[0], f[1]), cvtpk(f[2], f[3]), cvtpk(f[4], f[5]), cvtpk(f[6], f[7])}; *(u32x4*)(dst + j * 8) = w;
    }
    float* M = (float*)(p.ws + W_FOLDM);
    for (long i = gt; i < 4L * 128 * 256; i += gs) { const int j = (int)(i & 255), c = (int)((i >> 8) & 127), g = (int)(i >> 15);
      const float* fw = p.in[I_EVFNET] + (size_t)g * 128 * 128 + (j & 127); float s = 0.f; const int off = (j < 128) ? 0 : 2048 - 512;
#pragma unroll 8
      for (int c2 = 0; c2 < 128; ++c2) { const float tr = ct[((((c * c2) & 127) << 4) + off) & 2047]; s += tr * fw[c2 * 128]; }
      M[i] = s; }
  }
  {
    float* rope = (float*)(p.ws + W_ROPE);
    for (long i = gt; i < 64 * 32; i += gs) { const int pos = (int)(i >> 5), k = (int)(i & 31);
      const float invf = exp2f(-(float)k * (1.f / 32.f) * 13.287712379549449f);
      const float ang = (float)pos * invf; const float x = ang * 0.3183098861837907f;
      rope[i * 2] = cospif(x); rope[i * 2 + 1] = sinpif(x); }
  }
}

#define XB_TMO      128
#define XB_XCNT(j)  (256  + 64 * (j))
#define XB_XSUB(j)  (1280 + 64 * (j))
#define XB_XGEN(j)  (2304 + 64 * (j))
#define XB_TOP      3328
#define XB_TOPGEN   3392
#define XCD_BAR_WORDS 3456
#define XB_SPIN_CAP (1u << 18)
__device__ __forceinline__ unsigned xb_ld(unsigned* p)              { return __hip_atomic_load(p, __ATOMIC_RELAXED, __HIP_MEMORY_SCOPE_AGENT); }
__device__ __forceinline__ unsigned xb_add(unsigned* p, unsigned v) { return __hip_atomic_fetch_add(p, v, __ATOMIC_RELAXED, __HIP_MEMORY_SCOPE_AGENT); }
__device__ __forceinline__ unsigned xb_xcc_id() { return (unsigned)__builtin_amdgcn_s_getreg((3 << 11) | 20) & 0xFu; }
#define XB_SPIN(cond, bar) do { unsigned _sp = 0; while (cond) { __builtin_amdgcn_s_sleep(1); \
    if ((++_sp & 255u) == 0u) { if (xb_ld(&(bar)[XB_TMO])) break; if (_sp > XB_SPIN_CAP) { atomicAdd(&(bar)[XB_TMO], 1u); break; } } } } while (0)
struct XcdBarrier { unsigned* bar; unsigned x; volatile LAS unsigned* st; };
__device__ __forceinline__ XcdBarrier xcd_barrier_post(unsigned* bar, volatile LAS unsigned* st) {
    XcdBarrier b; b.bar = bar; b.x = xb_xcc_id(); b.st = st;
    if (threadIdx.x == 0) (void)xb_add(&bar[XB_XCNT(b.x)], 1u);
    return b;
}
__device__ __forceinline__ void xcd_barrier_complete(unsigned* bar, unsigned x, unsigned& nloc, unsigned& nx) {
    const unsigned G = gridDim.x * gridDim.y * gridDim.z;
    unsigned sum, cnt, mine, sp = 0u;
    for (;;) {
        sum = 0u; cnt = 0u; mine = 0u;
#pragma unroll
        for (unsigned j = 0; j < 16; ++j) { const unsigned c = xb_ld(&bar[XB_XCNT(j)]); sum += c; cnt += (c > 0u) ? 1u : 0u; mine = (j == x) ? c : mine; }
        if (sum == G) break;
        __builtin_amdgcn_s_sleep(1);
        if ((++sp & 255u) == 0u) { if (xb_ld(&bar[XB_TMO])) break; if (sp > XB_SPIN_CAP) { atomicAdd(&bar[XB_TMO], 1u); break; } }
    }
    nloc = mine > 0u ? mine : 1u; nx = cnt > 0u ? cnt : 1u;
}
__device__ __forceinline__ void xcd_barrier(const XcdBarrier& b) {
    asm volatile("s_waitcnt vmcnt(0)" ::: "memory");
    __syncthreads();
    if (threadIdx.x == 0) {
        unsigned* bar = b.bar;
        __builtin_amdgcn_s_waitcnt(0);
        unsigned nloc = b.st[0], nx = b.st[1];
        if (nloc == 0u) { xcd_barrier_complete(bar, b.x, nloc, nx); b.st[0] = nloc; b.st[1] = nx; }
        const unsigned old = xb_add(&bar[XB_XSUB(b.x)], 1u);
        const unsigned gen = old / nloc;
        if (old + 1u == (gen + 1u) * nloc) {
            __builtin_amdgcn_fence(__ATOMIC_RELEASE, "agent");
            asm volatile("s_waitcnt vmcnt(0)" ::: "memory");
            const unsigned og = xb_add(&bar[XB_TOP], 1u);
            const unsigned tg = og / nx;
            if (og + 1u == (tg + 1u) * nx) xb_add(&bar[XB_TOPGEN], 1u);
            else XB_SPIN(xb_ld(&bar[XB_TOPGEN]) == tg, bar);
            __builtin_amdgcn_fence(__ATOMIC_ACQUIRE, "agent");
            xb_add(&bar[XB_XGEN(b.x)], 1u);
            asm volatile("s_waitcnt vmcnt(0)" ::: "memory");
        } else {
            XB_SPIN(xb_ld(&bar[XB_XGEN(b.x)]) == gen, bar);
            __builtin_amdgcn_fence(__ATOMIC_ACQUIRE, "agent");
            asm volatile("s_waitcnt vmcnt(0)" ::: "memory");
        }
    }
    __syncthreads();
}

__global__ void __launch_bounds__(512, 2) mega(Params p_unused) {
  extern __shared__ __attribute__((aligned(16))) unsigned char shm[];
  cg::grid_group grid = cg::this_grid();
  typedef const Params __attribute__((address_space(4)))* KP;
  KP kp0 = (KP)__builtin_amdgcn_kernarg_segment_ptr();
  const int G = gridDim.x, bid = blockIdx.x;
  const int ph_lo = kp0->ph_lo, ph_hi = kp0->ph_hi;
  volatile LAS unsigned* xst = (volatile LAS unsigned*)((LAS unsigned char*)shm + (LDS_BYTES - 16));
  if (threadIdx.x == 0) { xst[0] = 0u; xst[1] = 0u; }
  __syncthreads();
  XcdBarrier xb = xcd_barrier_post((unsigned*)(kp0->ws + W_BAR), xst);
  for (int phx = ph_lo * 2; phx < ph_hi * 2; ++phx) {
    const int ph = phx >> 1;
    if ((phx & 1) && !((REPMASK >> ph) & 1)) continue;
    if (phx > ph_lo * 2) { if (ph_hi > 1000) grid.sync(); else xcd_barrier(xb); }
    KP kp = kp0; asm volatile("" : "+s"(kp));
    Params p;
#pragma unroll
    for (int i = 0; i < 27; ++i) p.in[i] = kp->in[i];
    p.out = kp->out; p.ws = kp->ws; p.ph_lo = 0; p.ph_hi = 0;
    float* xr = p.out + O_Y;
    bf16_t* ACT = (bf16_t*)(p.ws + W_ACT); bf16_t* BIG = (bf16_t*)(p.ws + W_BIG);
    const float* part = (const float*)(p.ws + W_PART);
    int kind, layer = ph >= 9 ? 1 : 0;
    switch (ph) {
      case 0: kind = 0; break;
      case 1: case 5: case 9: case 14: kind = 1; break;
      case 2: case 10: kind = 2; break;
      case 3: case 12: kind = 3; break;
      case 4: case 8: case 13: case 17: kind = 4; break;
      case 6: case 15: kind = 5; break;
      case 7: case 16: kind = 6; break;
      case 11: kind = 7; break;
      default: kind = 8; break;
    }
    if (kind == 0 && (KMASK & 1)) {
      prep_phase(p, shm);
    } else if (kind == 1 && (KMASK & 2)) {
      const bool first = (ph == 1);
      const float* xp = first ? p.in[I_XP] : xr; const float* xs = first ? p.in[I_XS] : xr + (size_t)NP * DM;
      const bool n2 = (ph == 5 || ph == 14);
      const float* g = (n2 ? p.in[I_N2G] : p.in[I_N1G]) + layer * DM;
      if (first) {
        for (int it = bid; it < 768; it += G) {
          if (it < 512) { const int gi = it >> 7, kc = (it >> 1) & 63, jh = it & 1;
            fold_item2(p.in[I_EVWIN], 5120, 4608 + gi * 128, (const float*)(p.ws + W_FOLDM) + (size_t)gi * 128 * 256, 256, jh * 128, nullptr, (bf16_t*)(p.ws + W_EVIN), 4608 + gi * 256 + jh * 128, kc, shm); }
          else { const int v = it - 512, gi = v >> 6, kc = v & 63;
            fold_item2(p.in[I_ODWIN], ODN, gi * 128, p.in[I_ODPOOLW] + (size_t)gi * 128 * 128, 128, 0, p.in[I_ODPOOLS] + gi * 128, (bf16_t*)(p.ws + W_ODIN), gi * 128, kc, shm); }
        }
      }
      const int wid = tid_opaque() >> 6;
      if (first) { for (int it = bid; it < NTOK / 32; it += G) norm_rows<0, 4>(p, it * 32 + wid, xp, xs, g, layer, n2 ? 3 : 0, nullptr); }
      else { for (int it = bid; it < NTOK / 32; it += G) norm_rows_b<0, 4>(p, it * 32 + wid, g, layer, n2 ? 3 : 0, nullptr); }
    } else if (kind == 2 && (KMASK & 4)) {
      pg8::Gemm gm; gm.A = ACT; gm.M = NTOK; gm.K = DM;
      EpiIn E; E.O = BIG; E.out = p.out; E.yts = (bf16_t*)(p.ws + W_YTS); E.ytc = (bf16_t*)(p.ws + W_YTC);
      if (layer == 0) { gm.Bt = (const bf16_t*)(p.ws + W_EVIN); gm.N = EVN; E.ldc = EVN; E.even = 1; }
      else { gm.Bt = (const bf16_t*)(p.ws + W_ODIN); gm.N = ODN; E.ldc = ODN; E.even = 0; }
      pg8::StaticOrder S; S.init(gm.M, gm.N, G, bid);
      pg8::gemm_phase<EpiIn>((LAS unsigned char*)shm, gm, S, E);
      if (layer == 0 && G == 256 && bid >= 64) { for (int d = bid - 64; d < 2112; d += 192) do_tile(p, tile_def(d), shm); }
    } else if (kind == 3 && (KMASK & 8)) {
      const int nunits = 768 + 384;
      const bool bal = (layer == 0 && G == 256);
      const int nloc = bal ? (bid < 128 ? 6 : 3) : (nunits - bid + G - 1) / G;
      for (int iu = 0; iu < nloc; ++iu) {
        int u;
        if (bal) { if (bid < 128) u = iu < 4 ? bid * 4 + iu : 768 + bid * 2 + (iu - 4); else u = iu < 2 ? 512 + (bid - 128) * 2 + iu : 768 + 256 + (bid - 128); }
        else if (layer == 1 && G == 256 && iu < 3) u = (bid & 7) * 96 + iu * 32 + (bid >> 3);
        else u = bid + iu * G;
        at::Desc d; int masked = 0, head = 0;
        if (layer == 0) {
          if (u < 768) { const int b = u / 96, rem = u % 96, h = rem >> 3, rg = rem & 7; head = h; masked = 1;
            const size_t qrow = (size_t)NP + b * 2048 + rg * 256; const bool edge = (rg == 0 || rg == 7); const int ks = edge ? (rg ? 24 : 0) : min(max(4 * rg - 4, 0), 20);
            d.Q = BIG + qrow * EVN + h * 128; d.ldq = EVN;
            d.K0 = (const bf16_t*)(p.ws + W_CNAK) + (size_t)b * 256 * 1536 + h * 128; d.V0 = (const bf16_t*)(p.ws + W_CNAV) + (size_t)b * 256 * 1536 + h * 128; d.ld0 = 1536; d.n0 = 256;
            const size_t krow = (size_t)NP + b * 2048 + ks * 64;
            d.K1 = BIG + krow * EVN + 1536 + h * 128; d.V1 = BIG + krow * EVN + 3072 + h * 128; d.ld1 = EVN; d.seq = edge ? 768 : 1024;
            d.O = ACT + qrow * DM + h * 128; d.ldo = DM; d.ks = ks; d.qrow0 = 4 * rg;
          } else { const int v = u - 768, b = v / 12, h = v % 12; const size_t qrow = (size_t)b * 256;
            d.Q = BIG + qrow * EVN + h * 128; d.ldq = EVN;
            d.K0 = BIG + qrow * EVN + 1536 + h * 128; d.V0 = BIG + qrow * EVN + 3072 + h * 128; d.ld0 = EVN; d.n0 = 256;
            d.K1 = d.K0; d.V1 = d.V0; d.ld1 = EVN; d.seq = 256; d.O = ACT + qrow * DM + h * 128; d.ldo = DM; d.ks = 0; d.qrow0 = 0; }
        } else {
          if (u < 768) { const int b = u / 96, rem = u % 96, h = rem >> 3, qb = rem & 7, kvh = h / 3;
            const size_t qrow = (size_t)NP + b * 2048 + qb * 256;
            d.Q = BIG + qrow * ODN + 512 + h * 128; d.ldq = ODN;
            d.K0 = (const bf16_t*)(p.ws + W_CGK) + (size_t)b * 256 * 512 + kvh * 128; d.V0 = (const bf16_t*)(p.ws + W_CGV) + (size_t)b * 256 * 512 + kvh * 128; d.ld0 = 512; d.n0 = 256;
            const size_t krow = (size_t)NP + b * 2048;
            d.K1 = BIG + krow * ODN + 2048 + kvh * 128; d.V1 = BIG + krow * ODN + 2560 + kvh * 128; d.ld1 = ODN; d.seq = 2304;
            d.O = ACT + qrow * DM + 512 + h * 128; d.ldo = DM; d.ks = 0; d.qrow0 = 0;
          } else { const int v = u - 768, b = v / 12, h = v % 12, kvh = h / 3; const size_t qrow = (size_t)b * 256;
            d.Q = BIG + qrow * ODN + 512 + h * 128; d.ldq = ODN;
            d.K0 = BIG + qrow * ODN + 2048 + kvh * 128; d.V0 = BIG + qrow * ODN + 2560 + kvh * 128; d.ld0 = ODN; d.n0 = 256;
            d.K1 = d.K0; d.V1 = d.V0; d.ld1 = ODN; d.seq = 256; d.O = ACT + qrow * DM + 512 + h * 128; d.ldo = DM; d.ks = 0; d.qrow0 = 0; }
        }
        __syncthreads();
        if (masked && (AMASK & 1)) {
          float* btab = (float*)(shm + at::SHM_ATTN) + 64;
          const int tid = tid_opaque();
          if (tid < 465) btab[tid] = p.in[I_EVBIAS][head * 465 + tid] * (1.f / at::SCALE);
          at::attn_body<1>(d, (char*)shm);
        } else if (AMASK & 2) at::attn_body<0>(d, (char*)shm);
      }
      if (layer == 0 && (AMASK & 4)) {
        __syncthreads();
#pragma unroll 1
        for (int v = 0; v < 2; ++v) {
          pg8::Gemm gm; EpiFourier E; E.mix = ACT;
          if (v == 0) { gm.A = (const bf16_t*)(p.ws + W_DFTS); gm.Bt = (const bf16_t*)(p.ws + W_YTS); gm.M = 2048; gm.N = 4096; gm.K = 4096; E.rowbase = NP; E.npos = 2048; E.scale = 0.001953125f; }
          else { gm.A = (const bf16_t*)(p.ws + W_DFTC); gm.Bt = (const bf16_t*)(p.ws + W_YTC); gm.M = 256; gm.N = 16384; gm.K = 512; E.rowbase = 0; E.npos = 256; E.scale = 0.005524271728019903f; }
          pg8::StaticOrder S; S.init(gm.M, gm.N, G, (bid + 128) % G);
          pg8::gemm_phase<EpiFourier>((LAS unsigned char*)shm, gm, S, E);
          __syncthreads();
        }
      }
    } else if (kind == 4 && (KMASK & 16)) {
      pg8::Gemm gm; gm.M = NTOK; gm.N = DM; EpiRes E; E.xb = (bf16_t*)(p.ws + W_XB); E.xo = (phx & 1) ? ACT : E.xb; E.part = part; E.layer = layer; E.xp = p.in[I_XP]; E.xs = p.in[I_XS]; E.from_in = 0;
      if (ph == 4) { gm.A = ACT; gm.Bt = (const bf16_t*)(p.ws + W_EVOUT); gm.K = DM; E.gk = 2; E.from_in = 1; }
      else if (ph == 13) { gm.A = ACT; gm.Bt = (const bf16_t*)(p.ws + W_ODOUT); gm.K = DM; E.gk = 2; }
      else { gm.A = BIG; gm.Bt = layer ? (const bf16_t*)(p.ws + W_DN + (size_t)DM * FF * 2) : (const bf16_t*)(p.ws + W_DN); gm.K = FF; E.gk = 5; }
      pg8::StaticOrder S; S.init(gm.M, gm.N, G, bid);
      pg8::gemm_phase<EpiRes>((LAS unsigned char*)shm, gm, S, E);
    } else if (kind == 5 && (KMASK & 32)) {
      pg8::Gemm gm; gm.A = ACT; gm.Bt = (const bf16_t*)(p.ws + W_UP) + (size_t)layer * FF2 * DM; gm.M = NTOK; gm.N = FF2; gm.K = DM;
      EpiUp E; E.G = BIG; E.UB = (float*)(p.ws + W_UB); E.cw = p.in[I_FFCW] + (size_t)layer * 3 * FF2; E.cb = p.in[I_FFCB] + (size_t)layer * FF2;
      pg8::StaticOrder S; S.init(gm.M, gm.N, G, bid);
      pg8::gemm_phase<EpiUp>((LAS unsigned char*)shm, gm, S, E);
      if (layer == 0 && G == 256 && bid >= 128) { if (bid < 224) ada_item(p, 96 + (bid - 128), shm); for (int d = 2112 + (bid - 128); d < 2688; d += 128) do_tile(p, tile_def(d), shm); }
    } else if (kind == 6 && (KMASK & 64)) {
      fix_phase(p, layer);
    } else if (kind == 7 && (KMASK & 128)) {
      const int wid = tid_opaque() >> 6;
      for (int it = bid; it < NTOK / 8; it += G) oddprep_row(p, it * 8 + wid);
    } else if (KMASK & 256) {
      for (int e = 0; e < EXTRA_SYNCS; ++e) xcd_barrier(xb);
      const int wid = tid_opaque() >> 6;
      for (int it = bid; it < NTOK / 32; it += G) norm_rows_b<1, 4>(p, it * 32 + wid, p.in[I_FING], 0, 0, xr);
    }
  }
}

extern "C" void kernel_launch(void* const* d_in, const int* in_sizes, int n_in, void* d_out, int out_size, void* d_ws, size_t ws_size, hipStream_t stream) {
  static int grid = 0;
  if (grid == 0) {
    if (n_in != 27 || out_size != 83886080 || ws_size < W_END) { fprintf(stderr, "kernel_launch: unexpected shapes: n_in %d out %d ws %zu (need %zu)\n", n_in, out_size, ws_size, (size_t)W_END); grid = -1; return; }
    int dev = 0, cus = 0, per_cu = 0;
    if (hipGetDevice(&dev) != hipSuccess || hipDeviceGetAttribute(&cus, hipDeviceAttributeMultiprocessorCount, dev) != hipSuccess) { grid = -1; return; }
    if (hipFuncSetAttribute((const void*)mega, hipFuncAttributeMaxDynamicSharedMemorySize, LDS_BYTES) != hipSuccess) { fprintf(stderr, "kernel_launch: hipFuncSetAttribute failed\n"); grid = -1; return; }
    if (hipOccupancyMaxActiveBlocksPerMultiprocessor(&per_cu, (const void*)mega, 512, LDS_BYTES) != hipSuccess || per_cu < 1) { fprintf(stderr, "kernel_launch: occupancy query says %d\n", per_cu); per_cu = 1; }
    (void)hipGetLastError();
    grid = cus * per_cu;
  }
  if (grid < 0) return;
  Params p{};
  for (int i = 0; i < 27; ++i) p.in[i] = (const float*)d_in[i];
  p.out = (float*)d_out; p.ws = (unsigned char*)d_ws;
#if N_LAUNCH_SPLIT
  for (int ph = 0; ph < PH_LIMIT; ++ph) { if (ph == SKIP_PH) continue; p.ph_lo = ph; p.ph_hi = ph + 1; hipLaunchKernelGGL(mega, dim3(grid), dim3(512), LDS_BYTES, stream, p); }
#else
  p.ph_lo = 0; p.ph_hi = NPH;
  (void)hipMemsetAsync((unsigned char*)d_ws + W_BAR, 0, 16384, stream);
  void* args[] = {&p};
  hipError_t e = hipLaunchCooperativeKernel((const void*)mega, dim3(grid), dim3(512), args, LDS_BYTES, stream);
  if (e != hipSuccess) fprintf(stderr, "kernel_launch: cooperative launch failed: %s (grid %d)\n", hipGetErrorString(e), grid);
#endif
}
```

```cpp
#include <hip/hip_runtime.h>
#include <hip/hip_cooperative_groups.h>
#include <cstdio>
#include <cstdint>
namespace cg = cooperative_groups;

#ifndef PH_LIMIT
#define PH_LIMIT 19
#endif
#ifndef SKIP_PH
#define SKIP_PH 99
#endif
#ifndef DBG_L0
#define DBG_L0 0
#endif
#ifndef DBG_SRC0
#define DBG_SRC0 0
#endif
#ifndef REPMASK
#define REPMASK 0
#endif
#ifndef EXTRA_SYNCS
#define EXTRA_SYNCS 0
#endif
#ifndef AMASK
#define AMASK 7
#endif
#ifndef KMASK
#define KMASK 511
#endif
#ifndef N_LAUNCH_SPLIT
#define N_LAUNCH_SPLIT 0
#endif

typedef unsigned short bf16_t;
typedef short bf16x8 __attribute__((ext_vector_type(8)));
typedef short s16x4 __attribute__((ext_vector_type(4)));
typedef float f32x4 __attribute__((ext_vector_type(4)));
typedef float f32x16 __attribute__((ext_vector_type(16)));
typedef unsigned u32x4 __attribute__((ext_vector_type(4)));
typedef unsigned u32x2 __attribute__((ext_vector_type(2)));
#define LAS __attribute__((address_space(3)))

constexpr int DM = 2048, NP = 8192, NS = 16384, NTOK = 24576;
constexpr int EVN = 5632, ODN = 3072, FF = 5632, FF2 = 11264;
constexpr int NPH = 19;
constexpr int LDS_BYTES = 135168;

enum { I_XP = 0, I_XS, I_C, I_CNAK, I_CNAV, I_CGK, I_CGV, I_CCTX, I_N1G, I_N2G, I_ADAW, I_ADAB, I_EVWIN, I_EVBIAS, I_EVFNET, I_EVWOUT,
       I_ODWIN, I_ODPOOLW, I_ODPOOLS, I_ODQG, I_ODKG, I_ODWOUT, I_FFUP, I_FFCW, I_FFCB, I_FFDN, I_FING };
constexpr size_t O_Y = 0, O_NAK = 50331648, O_NAV = 62914560, O_GK = 75497472, O_GV = 79691776;
constexpr size_t al256(size_t x) { return (x + 255) / 256 * 256; }
constexpr size_t W_PART = 0;
constexpr size_t W_FOLDM = W_PART + al256((size_t)2 * 2 * 9 * 12288 * 4);
constexpr size_t W_ROPE = W_FOLDM + al256((size_t)4 * 128 * 256 * 4);
constexpr size_t W_EVOUT = W_ROPE + al256((size_t)64 * 32 * 2 * 4);
constexpr size_t W_ODIN = W_EVOUT + (size_t)DM * DM * 2;
constexpr size_t W_ODOUT = W_ODIN + (size_t)ODN * DM * 2;
constexpr size_t W_UP = W_ODOUT + (size_t)DM * DM * 2;
constexpr size_t W_CGK = W_UP + (size_t)2 * FF2 * DM * 2;
constexpr size_t W_CGV = W_CGK + (size_t)8 * 256 * 512 * 2;
constexpr size_t W_EVIN = W_CGV + (size_t)8 * 256 * 512 * 2;
constexpr size_t W_XB = W_EVIN;
constexpr size_t W_DFTS = W_EVIN + (size_t)EVN * DM * 2;
constexpr size_t W_DFTC = W_DFTS + (size_t)2048 * 4096 * 2;
constexpr size_t W_CNAK = W_DFTC + (size_t)256 * 512 * 2;
constexpr size_t W_CNAV = W_CNAK + (size_t)8 * 256 * 1536 * 2;
constexpr size_t W_YTS = W_CNAV + (size_t)8 * 256 * 1536 * 2;
constexpr size_t W_YTC = W_YTS + (size_t)4096 * 4096 * 2;
static_assert(W_YTC + (size_t)16384 * 512 * 2 - W_XB >= (size_t)NTOK * DM * 2, "XB alias region too small");
constexpr size_t W_ACT = W_YTC + (size_t)16384 * 512 * 2;
constexpr size_t W_BIG = W_ACT + (size_t)NTOK * DM * 2;
constexpr size_t W_UB = W_BIG + (size_t)NTOK * EVN * 2;
constexpr size_t W_DN = W_UB + (size_t)384 * 4 * FF2 * 4;
constexpr size_t W_BAR = W_DN + (size_t)2 * DM * FF * 2;
constexpr size_t W_END = W_BAR + 16384;

struct Params { const float* in[27]; float* out; unsigned char* ws; int ph_lo, ph_hi; };

__device__ __forceinline__ unsigned cvtpk(float lo, float hi) { unsigned r; asm volatile("v_cvt_pk_bf16_f32 %0, %1, %2" : "=v"(r) : "v"(lo), "v"(hi)); return r; }
__device__ __forceinline__ float bf2f(bf16_t b) { return __uint_as_float(((unsigned)b) << 16); }
__device__ __forceinline__ float bflo(unsigned w) { return __uint_as_float(w << 16); }
__device__ __forceinline__ float bfhi(unsigned w) { return __uint_as_float(w & 0xffff0000u); }
__device__ __forceinline__ float wave_sum(float v) {
#pragma unroll
  for (int o = 32; o > 0; o >>= 1) v += __shfl_xor(v, o);
  return v;
}
__device__ __forceinline__ float wave_sum_dpp(float v) {
#define WS_DPP(x, ctrl, rm, bc) __builtin_bit_cast(float, __builtin_amdgcn_update_dpp(0, __builtin_bit_cast(int, x), ctrl, rm, 0xf, bc))
  v += WS_DPP(v, 0x111, 0xf, true); v += WS_DPP(v, 0x112, 0xf, true); v += WS_DPP(v, 0x114, 0xf, true); v += WS_DPP(v, 0x118, 0xf, true);
  v += WS_DPP(v, 0x142, 0xa, false);
  v += WS_DPP(v, 0x143, 0xc, false);
#undef WS_DPP
  return __builtin_bit_cast(float, __builtin_amdgcn_readlane(__builtin_bit_cast(int, v), 63));
}
__device__ __forceinline__ int tid_opaque() { int t = threadIdx.x; asm volatile("" : "+v"(t)); return t; }
__device__ __forceinline__ float silu_f(float x) { return x / (1.f + __expf(-x)); }
__device__ __forceinline__ float silu_fast(float x) { return x * __builtin_amdgcn_rcpf(1.f + __builtin_amdgcn_exp2f(x * -1.4426950408889634f)); }
__device__ __forceinline__ f32x4 modv4(const float* part, int l, int bidx, int k, int col) {
  const float* p0 = part + ((size_t)(l * 2 + 0) * 9 + bidx) * 12288 + k * 2048 + col;
  const float* p1 = part + ((size_t)(l * 2 + 1) * 9 + bidx) * 12288 + k * 2048 + col;
  return *(const f32x4*)p0 + *(const f32x4*)p1;
}

namespace pg8 {
constexpr int BM = 256, BK = 64, HALF = 128, HTB = HALF * BK * 2, STAGE_BYTES = 8 * HTB, NXCD = 8, WGM = 8;
__host__ __device__ __forceinline__ int lds_byte(int r, int c) { const int st = (r >> 4) * 2 + (c >> 5), rr = r & 15, cc = c & 31, ob = rr * 64 + cc * 2; return st * 1024 + (ob ^ (((ob >> 9) & 1) << 5)); }
__host__ __device__ __forceinline__ void stage_rc(int b, int& R, int& C) { const int st = b / 1024, sb = b % 1024, swz = sb ^ (((sb >> 9) & 1) << 5); R = (st >> 1) * 16 + swz / 64; C = (st & 1) * 32 + (swz % 64) / 2; }
__host__ __device__ __forceinline__ int perm32(int rho) { const int n = rho >> 4, i = rho & 15; return 8 * (i >> 2) + 4 * n + (i & 3); }
struct Unit { int pm, pn; };
struct Gemm { const bf16_t* A; const bf16_t* Bt; int M, N, K; };
struct StaticOrder {
  int nM, nN, nwg, G, c;
  __device__ void init(int M, int N, int G_, int c_) { nM = M / BM; nN = N / BM; nwg = nM * nN; G = G_; c = c_; }
  __device__ bool next(int i, Unit& u) const {
    const long L = (long)i * G + c; if (L >= nwg) return false;
    int wgid = (int)L; { const int q = nwg / NXCD, r = nwg % NXCD, xcd = wgid % NXCD, off = wgid / NXCD; wgid = (xcd < r ? xcd * (q + 1) : r * (q + 1) + (xcd - r) * q) + off; }
    const int nig = WGM * nN, gid = wgid / nig, fm = gid * WGM, gsz = (nM - fm) < WGM ? (nM - fm) : WGM;
    u.pm = fm + ((wgid % nig) % gsz); u.pn = (wgid % nig) / gsz; return true;
  }
};

template <class Epi>
__device__ __forceinline__ void gemm_phase(LAS unsigned char* lds, const Gemm g, const StaticOrder& S, const Epi& E) {
  const int tid = tid_opaque(), wid = __builtin_amdgcn_readfirstlane(tid >> 6), lane = tid & 63, wr = wid >> 2, wc = wid & 3, fr = lane & 15, fq = lane >> 4;
  const int K = g.K, nt = K / BK;
  unsigned voffA[2], voffB[2];
#pragma unroll
  for (int i = 0; i < 2; ++i) { int R, C; stage_rc(tid * 16 + i * 8192, R, C); const int Rb = Epi::PERM ? ((R & ~31) + perm32(R & 31)) : R;
    const int Ra = Epi::APERM ? ((R & ~63) + 4 * (R & 15) + ((R >> 4) & 3)) : R;
    voffA[i] = (unsigned)(Ra * K + C) * 2u; voffB[i] = (unsigned)(Rb * K + C) * 2u; }
  const size_t kstep = (size_t)(BK * 2);
  const size_t hstep = (size_t)HALF * K * 2;
  const size_t tstep = 2 * hstep;
  const unsigned ldsw = (unsigned)wid * 1024u;
  const int aoff = lds_byte(wr * 64 + fr, fq * 8), boff = lds_byte(wc * 32 + fr, fq * 8);
#define PG8_SA(b, h) (((b) * 2 + (h)) * HTB)
#define PG8_SB(b, h) ((4 + (b) * 2 + (h)) * HTB)
#define PG8_STAGE(bufoff, gbase, voff) do { _Pragma("unroll") for (int _i = 0; _i < 2; ++_i) \
    __builtin_amdgcn_global_load_lds((const unsigned*)((const char*)(gbase) + (voff)[_i]), (LAS unsigned*)(lds + (bufoff) + ldsw + _i * 8192), 16, 0, 0); } while (0)
#define PG8_LDA(dst, b, h) do { _Pragma("unroll") for (int m = 0; m < 4; ++m) _Pragma("unroll") for (int k = 0; k < 2; ++k) dst[m][k] = *(const LAS bf16x8*)(lds + PG8_SA(b, h) + aoff + m * 2048 + k * 1024); } while (0)
#define PG8_LDB(dst, b, h) do { _Pragma("unroll") for (int n = 0; n < 2; ++n) _Pragma("unroll") for (int k = 0; k < 2; ++k) dst[n][k] = *(const LAS bf16x8*)(lds + PG8_SB(b, h) + boff + n * 2048 + k * 1024); } while (0)
#define PG8_MMA(ai, bj, At, Bt) do { __builtin_amdgcn_s_setprio(1); _Pragma("unroll") for (int m = 0; m < 4; ++m) _Pragma("unroll") for (int n = 0; n < 2; ++n) _Pragma("unroll") for (int k = 0; k < 2; ++k) \
    acc[ai][bj][m][n] = __builtin_amdgcn_mfma_f32_16x16x32_bf16(Bt[n][k], At[m][k], acc[ai][bj][m][n], 0, 0, 0); __builtin_amdgcn_s_setprio(0); } while (0)
#define PG8_WAIT_V(n) asm volatile("s_waitcnt vmcnt(" #n ")" ::: "memory")
#define PG8_WAIT_L(n) asm volatile("s_waitcnt lgkmcnt(" #n ")" ::: "memory")
#define PG8_BAR __builtin_amdgcn_s_barrier()
#define PG8_SCHED __builtin_amdgcn_sched_barrier(0)
  Unit cur, nxt; int ui = 0;
  if (!S.next(0, cur)) return;
  f32x4 acc[2][2][4][2];
#pragma unroll
  for (int a = 0; a < 2; ++a)
#pragma unroll
    for (int b = 0; b < 2; ++b)
#pragma unroll
      for (int m = 0; m < 4; ++m)
#pragma unroll
        for (int n = 0; n < 2; ++n) acc[a][b][m][n] = (f32x4){0.f, 0.f, 0.f, 0.f};
  bf16x8 At[4][2], B0[2][2], B1[2][2];
  const char* cA = (const char*)g.A + (size_t)cur.pm * tstep; const char* cB = (const char*)g.Bt + (size_t)cur.pn * tstep;
  PG8_STAGE(PG8_SB(0, 0), cB, voffB); PG8_STAGE(PG8_SA(0, 0), cA, voffA); PG8_STAGE(PG8_SB(0, 1), cB + hstep, voffB); PG8_STAGE(PG8_SA(0, 1), cA + hstep, voffA);
  if (wr == 1) PG8_BAR;
  PG8_WAIT_V(4); PG8_BAR;
  PG8_STAGE(PG8_SB(1, 0), cB + kstep, voffB); PG8_STAGE(PG8_SA(1, 0), cA + kstep, voffA); PG8_STAGE(PG8_SB(1, 1), cB + hstep + kstep, voffB);
  PG8_WAIT_V(6); PG8_BAR;
  for (;;) {
    const bool has_next = S.next(ui + 1, nxt);
    const char* nA = has_next ? (const char*)g.A + (size_t)nxt.pm * tstep : cA; const char* nB = has_next ? (const char*)g.Bt + (size_t)nxt.pn * tstep : cB;
    for (int t = 0; t < nt; t += 2) {
      const bool last = (t == nt - 2);
      const char* a1 = cA + (size_t)(t + 1) * kstep;
      const char* a2 = last ? nA : cA + (size_t)(t + 2) * kstep; const char* b2 = last ? nB : cB + (size_t)(t + 2) * kstep;
      const char* a3 = a2 + kstep; const char* b3 = b2 + kstep;
      PG8_LDB(B0, 0, 0); PG8_SCHED; PG8_LDA(At, 0, 0); PG8_STAGE(PG8_SA(1, 1), a1 + hstep, voffA);
      PG8_WAIT_L(8); PG8_BAR; PG8_WAIT_L(0); PG8_MMA(0, 0, At, B0); PG8_BAR; PG8_SCHED;
      PG8_LDB(B1, 0, 1); PG8_STAGE(PG8_SB(0, 0), b2, voffB);
      PG8_BAR; PG8_WAIT_L(0); PG8_MMA(0, 1, At, B1); PG8_BAR;
      PG8_LDA(At, 0, 1); PG8_STAGE(PG8_SA(0, 0), a2, voffA);
      PG8_BAR; PG8_WAIT_L(0); PG8_MMA(1, 0, At, B0); PG8_BAR; PG8_SCHED;
      PG8_STAGE(PG8_SB(0, 1), b2 + hstep, voffB);
      PG8_WAIT_V(6); PG8_BAR; PG8_MMA(1, 1, At, B1); PG8_BAR;
      PG8_LDB(B0, 1, 0); PG8_SCHED; PG8_LDA(At, 1, 0); PG8_STAGE(PG8_SA(0, 1), a2 + hstep, voffA);
      PG8_WAIT_L(8); PG8_BAR; PG8_WAIT_L(0); PG8_MMA(0, 0, At, B0); PG8_BAR; PG8_SCHED;
      PG8_LDB(B1, 1, 1); PG8_STAGE(PG8_SB(1, 0), b3, voffB);
      PG8_BAR; PG8_WAIT_L(0); PG8_MMA(0, 1, At, B1); PG8_BAR;
      PG8_LDA(At, 1, 1); PG8_STAGE(PG8_SA(1, 0), a3, voffA);
      PG8_BAR; PG8_WAIT_L(0); PG8_MMA(1, 0, At, B0); PG8_BAR; PG8_SCHED;
      PG8_STAGE(PG8_SB(1, 1), b3 + hstep, voffB);
      PG8_WAIT_V(6); PG8_BAR; PG8_MMA(1, 1, At, B1); PG8_BAR;
    }
    E(acc, cur, wr, wc, fr, fq);
    if (!has_next) break;
#pragma unroll
    for (int a = 0; a < 2; ++a)
#pragma unroll
      for (int b = 0; b < 2; ++b)
#pragma unroll
        for (int m = 0; m < 4; ++m)
#pragma unroll
          for (int n = 0; n < 2; ++n) acc[a][b][m][n] = (f32x4){0.f, 0.f, 0.f, 0.f};
    cur = nxt; cA = nA; cB = nB; ++ui;
  }
  PG8_WAIT_V(0);
  if (wr == 0) PG8_BAR;
  PG8_BAR;
#undef PG8_SA
#undef PG8_SB
#undef PG8_STAGE
#undef PG8_LDA
#undef PG8_LDB
#undef PG8_MMA
#undef PG8_WAIT_V
#undef PG8_WAIT_L
#undef PG8_BAR
#undef PG8_SCHED
}
}
using pg8::Unit;
typedef f32x4 AccT[2][2][4][2];

struct EpiIn {
  static constexpr bool PERM = true; static constexpr bool APERM = false;
  bf16_t* O; int ldc; int even; float* out; bf16_t* yts; bf16_t* ytc;
  __device__ __forceinline__ void operator()(const AccT& acc, const Unit& u, int wr, int wc, int fr, int fq) const {
    const int row0 = u.pm * 256 + wr * 64 + fr;
    if (even && u.pn >= 18) {
      const int g = u.pn - 18;
      bf16_t* base; size_t rs; int half, pos0;
      if (u.pm < 32) { base = ytc + (size_t)((u.pm * 4 + g) * 128) * 512; rs = 512; half = 256; pos0 = wr * 64 + fr; }
      else { const int b = (u.pm - 32) >> 3; base = yts + (size_t)((b * 4 + g) * 128) * 4096; rs = 4096; half = 2048; pos0 = ((u.pm - 32) & 7) * 256 + wr * 64 + fr; }
#pragma unroll
      for (int ai = 0; ai < 2; ++ai)
#pragma unroll
        for (int m = 0; m < 4; ++m) { const int pos = pos0 + ai * 128 + m * 16;
#pragma unroll
          for (int bj = 0; bj < 2; ++bj)
#pragma unroll
            for (int n = 0; n < 2; ++n)
#pragma unroll
              for (int j = 0; j < 4; ++j) { const int d = wc * 32 + 8 * fq + 4 * n + j;
                base[(size_t)d * rs + bj * half + pos] = (bf16_t)(cvtpk(acc[ai][bj][m][n][j], 0.f) & 0xffffu); } }
      return;
    }
    const int col0 = u.pn * 256 + wc * 32 + 8 * fq;
    float* side = nullptr; int sld = 0;
    if (u.pm < 32) {
      if (even) { if (u.pn >= 6 && u.pn < 12) { side = out + O_NAK + (col0 - 1536); sld = 1536; } else if (u.pn >= 12) { side = out + O_NAV + (col0 - 3072); sld = 1536; } }
      else if (u.pn >= 10) { side = out + O_GV + (col0 - 2560); sld = 512; }
    }
#pragma unroll
    for (int ai = 0; ai < 2; ++ai)
#pragma unroll
      for (int m = 0; m < 4; ++m) { const int row = row0 + ai * 128 + m * 16; bf16_t* rowp = O + (size_t)row * ldc + col0;
#pragma unroll
        for (int bj = 0; bj < 2; ++bj) { const f32x4 v0 = acc[ai][bj][m][0], v1 = acc[ai][bj][m][1];
          u32x4 w = {cvtpk(v0[0], v0[1]), cvtpk(v0[2], v0[3]), cvtpk(v1[0], v1[1]), cvtpk(v1[2], v1[3])};
          *(u32x4*)(rowp + bj * 128) = w;
          if (side) { float* sp = side + (size_t)row * sld + bj * 128; *(f32x4*)sp = v0; *(f32x4*)(sp + 4) = v1; } } }
  }
};
struct EpiRes {
  static constexpr bool PERM = true; static constexpr bool APERM = false;
  const float* xp; const float* xs; bf16_t* xb; bf16_t* xo; const float* part; int layer, gk; int from_in;
  __device__ __forceinline__ void operator()(const AccT& acc, const Unit& u, int wr, int wc, int fr, int fq) const {
    const int bidx = u.pm < 32 ? 8 : ((u.pm - 32) >> 3);
    const int row0 = u.pm * 256 + wr * 64 + fr, col0 = u.pn * 256 + wc * 32 + 8 * fq;
    const float* xin = u.pm < 32 ? xp : (xs - (size_t)NP * DM);
    f32x4 gv[2][2];
#pragma unroll
    for (int bj = 0; bj < 2; ++bj)
#pragma unroll
      for (int n = 0; n < 2; ++n) gv[bj][n] = modv4(part, layer, bidx, gk, col0 + bj * 128 + n * 4);
#pragma unroll
    for (int ai = 0; ai < 2; ++ai)
#pragma unroll
      for (int m = 0; m < 4; ++m) { const size_t ro = (size_t)(row0 + ai * 128 + m * 16) * DM + col0;
#pragma unroll
        for (int bj = 0; bj < 2; ++bj) { f32x4 x0, x1;
          if (from_in) { x0 = *(const f32x4*)(xin + ro + bj * 128); x1 = *(const f32x4*)(xin + ro + bj * 128 + 4); }
          else { const u32x4 w = *(const u32x4*)(xb + ro + bj * 128); x0 = (f32x4){bflo(w[0]), bfhi(w[0]), bflo(w[1]), bfhi(w[1])}; x1 = (f32x4){bflo(w[2]), bfhi(w[2]), bflo(w[3]), bfhi(w[3])}; }
          x0 = x0 + gv[bj][0] * acc[ai][bj][m][0]; x1 = x1 + gv[bj][1] * acc[ai][bj][m][1];
          u32x4 o = {cvtpk(x0[0], x0[1]), cvtpk(x0[2], x0[3]), cvtpk(x1[0], x1[1]), cvtpk(x1[2], x1[3])};
          *(u32x4*)(xo + ro + bj * 128) = o; } }
  }
};
__device__ __forceinline__ float dpp_ror1(float v) { return __builtin_bit_cast(float, __builtin_amdgcn_update_dpp(0, __builtin_bit_cast(int, v), 0x121, 0xf, 0xf, false)); }
__device__ __forceinline__ float dpp_rol1(float v) { return __builtin_bit_cast(float, __builtin_amdgcn_update_dpp(0, __builtin_bit_cast(int, v), 0x12F, 0xf, 0xf, false)); }
struct EpiUp {
  static constexpr bool PERM = true; static constexpr bool APERM = true;
  bf16_t* G; float* UB; const float* cw; const float* cb;
  __device__ __forceinline__ void operator()(const AccT& acc, const Unit& u, int wr, int wc, int fr, int fq) const {
    const int cc0 = wc * 32 + 8 * fq;
    const int chv = u.pn * 128 + cc0;
    unsigned gp[2][4][4];
#pragma unroll
    for (int n = 0; n < 2; ++n) {
      const int ch = chv + 4 * n;
      f32x4 cwv[1][8];
      cwv[0][0] = *(const f32x4*)(cw + ch); cwv[0][1] = *(const f32x4*)(cw + FF2 + ch); cwv[0][2] = *(const f32x4*)(cw + 2 * FF2 + ch); cwv[0][3] = *(const f32x4*)(cb + ch);
      cwv[0][4] = *(const f32x4*)(cw + FF + ch); cwv[0][5] = *(const f32x4*)(cw + FF2 + FF + ch); cwv[0][6] = *(const f32x4*)(cw + 2 * FF2 + FF + ch); cwv[0][7] = *(const f32x4*)(cb + FF + ch);
      const f32x4 v0 = cwv[0][0] * -0.6931471805599453f, v1 = cwv[0][1] * -0.6931471805599453f, v2 = cwv[0][2] * -0.6931471805599453f, vb = cwv[0][3] * -0.6931471805599453f;
      const f32x4 g0 = cwv[0][4] * -1.4426950408889634f, g1 = cwv[0][5] * -1.4426950408889634f, g2 = cwv[0][6] * -1.4426950408889634f, gb = cwv[0][7] * -1.4426950408889634f;
#pragma unroll
      for (int ai = 0; ai < 2; ++ai) {
        const int chunk = u.pm * 4 + ai * 2 + wr;
        f32x4 o[4];
        {
          const f32x4 a0 = acc[ai][0][0][n], a1 = acc[ai][0][1][n], a2 = acc[ai][0][2][n], a3 = acc[ai][0][3][n];
          const f32x4 b0 = acc[ai][1][0][n], b1 = acc[ai][1][1][n], b2 = acc[ai][1][2][n], b3 = acc[ai][1][3][n];
          f32x4 au, ad, bu, bd;
#pragma unroll
          for (int j = 0; j < 4; ++j) { au[j] = dpp_ror1(a3[j]); ad[j] = dpp_rol1(a0[j]); bu[j] = dpp_ror1(b3[j]); bd[j] = dpp_rol1(b0[j]); }
          f32x4 vv[4], gg[4];
          vv[0] = v0 * au + v1 * a0 + v2 * a1 + vb; vv[1] = v0 * a0 + v1 * a1 + v2 * a2 + vb; vv[2] = v0 * a1 + v1 * a2 + v2 * a3 + vb; vv[3] = v0 * a2 + v1 * a3 + v2 * ad + vb;
          gg[0] = g0 * bu + g1 * b0 + g2 * b1 + gb; gg[1] = g0 * b0 + g1 * b1 + g2 * b2 + gb; gg[2] = g0 * b1 + g1 * b2 + g2 * b3 + gb; gg[3] = g0 * b2 + g1 * b3 + g2 * bd + gb;
#pragma unroll
          for (int m = 0; m < 4; ++m) { f32x4 e, r;
#pragma unroll
            for (int j = 0; j < 4; ++j) e[j] = __builtin_amdgcn_exp2f(gg[m][j]);
            e = e + 1.f;
#pragma unroll
            for (int j = 0; j < 4; ++j) r[j] = __builtin_amdgcn_rcpf(e[j]);
            o[m] = (vv[m] * gg[m]) * r; }
        }
#pragma unroll
        for (int m = 0; m < 4; ++m) { gp[ai][m][n * 2 + 0] = cvtpk(o[m][0], o[m][1]); gp[ai][m][n * 2 + 1] = cvtpk(o[m][2], o[m][3]); }
        if (fr == 0 || fr == 15) {
          float* ub = UB + ((size_t)chunk * 4 + (fr ? 2 : 0)) * FF2 + u.pn * 256 + cc0 + 4 * n;
          if (fr == 0) { *(f32x4*)ub = acc[ai][0][0][n]; *(f32x4*)(ub + 128) = acc[ai][1][0][n]; *(f32x4*)(ub + FF2) = acc[ai][0][1][n]; *(f32x4*)(ub + FF2 + 128) = acc[ai][1][1][n]; }
          else { *(f32x4*)ub = acc[ai][0][2][n]; *(f32x4*)(ub + 128) = acc[ai][1][2][n]; *(f32x4*)(ub + FF2) = acc[ai][0][3][n]; *(f32x4*)(ub + FF2 + 128) = acc[ai][1][3][n]; }
        }
      }
    }
#pragma unroll
    for (int ai = 0; ai < 2; ++ai) {
      const int rowc = (u.pm * 4 + ai * 2 + wr) * 64;
#pragma unroll
      for (int m = 0; m < 4; ++m) {
        const bool skip = (m == 0 && fr == 0) || (m == 3 && fr == 15);
        if (!skip) { u32x4 w = {gp[ai][m][0], gp[ai][m][1], gp[ai][m][2], gp[ai][m][3]}; *(u32x4*)(G + (size_t)(rowc + 4 * fr + m) * FF + chv) = w; }
      }
    }
  }
};
struct EpiFourier {
  static constexpr bool PERM = true; static constexpr bool APERM = false;
  bf16_t* mix; int rowbase, npos; float scale;
  __device__ __forceinline__ void operator()(const AccT& acc, const Unit& u, int wr, int wc, int fr, int fq) const {
    const int pos0 = u.pm * 256 + wr * 64 + fr;
#pragma unroll
    for (int bj = 0; bj < 2; ++bj) {
      const int col = u.pn * 256 + bj * 128 + wc * 32 + 8 * fq; const int b = col >> 9, gd = col & 511;
      bf16_t* basep = mix + (size_t)(rowbase + b * npos) * DM + 1536 + gd;
#pragma unroll
      for (int ai = 0; ai < 2; ++ai)
#pragma unroll
        for (int m = 0; m < 4; ++m) { const f32x4 v0 = acc[ai][bj][m][0] * scale, v1 = acc[ai][bj][m][1] * scale;
          u32x4 w = {cvtpk(v0[0], v0[1]), cvtpk(v0[2], v0[3]), cvtpk(v1[0], v1[1]), cvtpk(v1[2], v1[3])};
          *(u32x4*)(basep + (size_t)(pos0 + ai * 128 + m * 16) * DM) = w; }
    }
  }
};

namespace at {
constexpr int D = 128, NW = 8, QBLK = 32, KVBLK = 64;
constexpr float SCALE = 0.088388347648318440f;
constexpr float THR = 8.f;
constexpr size_t SHM_V = KVBLK * D * 2, SHM_K = KVBLK * D * 2, SHM_ATTN = 2 * SHM_V + 2 * SHM_K + NW * 64 * 4;
#define KSWZ(row, colB) ((row) * 256 + ((colB) ^ (((row) & 7) << 4)))
#define SBAR() __builtin_amdgcn_sched_barrier(0)
__device__ __forceinline__ int crow(int r, int hi) { return (r & 3) + 8 * (r >> 2) + 4 * hi; }
__device__ __forceinline__ void partialSM(f32x16& p0, f32x16& p1, float& m_reg, float& mn, float& alpha) {
  constexpr float C = SCALE * 1.4426950408889634f;
  float pmax = p0[0];
#pragma unroll
  for (int r = 1; r < 16; ++r) pmax = fmaxf(pmax, p0[r]);
#pragma unroll
  for (int r = 0; r < 16; ++r) pmax = fmaxf(pmax, p1[r]);
  { auto rr = __builtin_amdgcn_permlane32_swap(__float_as_uint(pmax), __float_as_uint(pmax), false, false);
    pmax = fmaxf(__uint_as_float(rr[0]), __uint_as_float(rr[1])); }
  if (__builtin_expect(__all(pmax - m_reg <= THR / SCALE), 1)) { mn = m_reg; alpha = 1.f; }
  else { mn = fmaxf(m_reg, pmax); alpha = __builtin_amdgcn_exp2f((m_reg - mn) * C); m_reg = mn; }
  float mnC = -mn * C;
  p0 = p0 * C + mnC; p1 = p1 * C + mnC;
#pragma unroll
  for (int r = 0; r < 16; ++r) p0[r] = __builtin_amdgcn_exp2f(p0[r]);
}
__device__ __forceinline__ void finishSM(f32x16& p0, f32x16& p1, float alpha, float& l_reg, bf16x8& pa0, bf16x8& pa1, bf16x8& pa2, bf16x8& pa3) {
#pragma unroll
  for (int r = 0; r < 16; ++r) p1[r] = __builtin_amdgcn_exp2f(p1[r]);
  float ps;
  { typedef float f32x8 __attribute__((ext_vector_type(8))); typedef float f32x2v __attribute__((ext_vector_type(2)));
    const f32x16 s16 = p0 + p1; const f32x8 s8 = s16.lo + s16.hi; const f32x4 s4 = s8.lo + s8.hi; const f32x2v s2 = s4.lo + s4.hi; ps = s2.x + s2.y; }
  { auto rr = __builtin_amdgcn_permlane32_swap(__float_as_uint(ps), __float_as_uint(ps), false, false);
    ps = __uint_as_float(rr[0]) + __uint_as_float(rr[1]); }
  l_reg = l_reg * alpha + ps;
#define PK4(P, BASE, OUT) do { unsigned a0 = cvtpk(P[BASE + 0], P[BASE + 1]), a1 = cvtpk(P[BASE + 2], P[BASE + 3]);   \
    unsigned b0 = cvtpk(P[BASE + 4], P[BASE + 5]), b1 = cvtpk(P[BASE + 6], P[BASE + 7]);                              \
    auto r0 = __builtin_amdgcn_permlane32_swap(a0, b0, false, false); auto r1 = __builtin_amdgcn_permlane32_swap(a1, b1, false, false); \
    u32x4 w = {r0[0], r1[0], r0[1], r1[1]}; OUT = *reinterpret_cast<bf16x8*>(&w); } while (0)
  PK4(p0, 0, pa0); PK4(p0, 8, pa1); PK4(p1, 0, pa2); PK4(p1, 8, pa3);
#undef PK4
}
__device__ __forceinline__ void qkt(f32x16& p0, f32x16& p1, const char* Ks, const bf16x8* qr, int r32, int hi) {
  p0 = f32x16{}; p1 = f32x16{};
#pragma unroll
  for (int d0 = 0; d0 < 8; ++d0) { int cb = (d0 * 16 + hi * 8) * 2;
    bf16x8 b0 = *reinterpret_cast<const bf16x8*>(Ks + KSWZ(r32, cb));
    bf16x8 b1 = *reinterpret_cast<const bf16x8*>(Ks + KSWZ(32 + r32, cb));
    p0 = __builtin_amdgcn_mfma_f32_32x32x16_bf16(b0, qr[d0], p0, 0, 0, 0);
    p1 = __builtin_amdgcn_mfma_f32_32x32x16_bf16(b1, qr[d0], p1, 0, 0, 0); }
}
__device__ __forceinline__ int v_st(int k, int c) { const int kk = (k & ~0xC) | ((k & 4) << 1) | ((k & 8) >> 1); return ((kk >> 3) * 4 + (c >> 5)) * 512 + ((kk & 7) * 32 + (c & 31)) * 2; }
__device__ __forceinline__ int v_rd_base(int lane) { return ((lane & 3) << 3) | (((lane >> 2) & 3) << 6) | (((lane >> 4) & 1) << 5) | (((lane >> 5) & 1) << 8); }
constexpr int v_rd_off(int d0, int ks, int half) { return d0 * 512 + ks * 4096 + half * 2048; }
template <int OFF> __device__ __forceinline__ s16x4 tr_read(int vb) {
  s16x4 r; asm volatile("ds_read_b64_tr_b16 %0, %1 offset:%2" : "=&v"(r) : "v"(vb), "i"(OFF) : "memory"); return r;
}
template <int D0> __device__ __forceinline__ void pv_one(f32x16& od, int vb, bf16x8 pa0, bf16x8 pa1, bf16x8 pa2, bf16x8 pa3) {
  const s16x4 l0 = tr_read<v_rd_off(D0, 0, 0)>(vb), h0 = tr_read<v_rd_off(D0, 0, 1)>(vb), l1 = tr_read<v_rd_off(D0, 1, 0)>(vb), h1 = tr_read<v_rd_off(D0, 1, 1)>(vb);
  const s16x4 l2 = tr_read<v_rd_off(D0, 2, 0)>(vb), h2 = tr_read<v_rd_off(D0, 2, 1)>(vb), l3 = tr_read<v_rd_off(D0, 3, 0)>(vb), h3 = tr_read<v_rd_off(D0, 3, 1)>(vb);
  asm volatile("s_waitcnt lgkmcnt(0)" ::: "memory"); SBAR();
#define PK(L, H) (bf16x8){L[0], L[1], L[2], L[3], H[0], H[1], H[2], H[3]}
  od = __builtin_amdgcn_mfma_f32_32x32x16_bf16(pa0, PK(l0, h0), od, 0, 0, 0);
  od = __builtin_amdgcn_mfma_f32_32x32x16_bf16(pa1, PK(l1, h1), od, 0, 0, 0);
  od = __builtin_amdgcn_mfma_f32_32x32x16_bf16(pa2, PK(l2, h2), od, 0, 0, 0);
  od = __builtin_amdgcn_mfma_f32_32x32x16_bf16(pa3, PK(l3, h3), od, 0, 0, 0);
#undef PK
}
__device__ __forceinline__ void pv_d0(f32x16* o, int vb, bf16x8 pa0, bf16x8 pa1, bf16x8 pa2, bf16x8 pa3) {
  pv_one<0>(o[0], vb, pa0, pa1, pa2, pa3); pv_one<1>(o[1], vb, pa0, pa1, pa2, pa3); pv_one<2>(o[2], vb, pa0, pa1, pa2, pa3); pv_one<3>(o[3], vb, pa0, pa1, pa2, pa3);
}
struct Desc {
  const bf16_t* Q; int ldq;
  const bf16_t* K0; const bf16_t* V0; int ld0, n0;
  const bf16_t* K1; const bf16_t* V1; int ld1;
  int seq;
  bf16_t* O; int ldo;
  int ks, qrow0;
};
template <int MODE> __device__ __forceinline__ void na_mask(f32x16& p0, f32x16& p1, int t, const Desc& d, int wid, int r32, int hi, const float* btab) {
  if constexpr (MODE == 1) {
    if (t >= 4) {
      const int kr = d.ks + t - 4, qrow = d.qrow0 + (wid >> 1), qc = (wid & 1) * 32 + r32;
      const int r0q = min(max(qrow - 4, 0), 24);
      const bool rowok = (kr >= r0q) && (kr < r0q + 8);
      if (rowok) {
        const int qs = min(max(qc - 8, 0), 48);
        const float* brow = btab + (kr - qrow + 7) * 31 + (15 - qc + 4 * hi);
        const int kb = 4 * hi - qs;
#pragma unroll
        for (int rg = 0; rg < 4; ++rg) {
#pragma unroll
          for (int r = rg * 4; r < rg * 4 + 4; ++r) {
            const int kc = (r & 3) + 8 * (r >> 2);
            const bool ok0 = ((unsigned)(kc + kb) < 16u);
            const float b0 = brow[kc];
            p0[r] = ok0 ? p0[r] + b0 : -1e30f;
          }
          SBAR();
        }
#pragma unroll
        for (int rg = 0; rg < 4; ++rg) {
#pragma unroll
          for (int r = rg * 4; r < rg * 4 + 4; ++r) {
            const int kc = (r & 3) + 8 * (r >> 2);
            const bool ok1 = ((unsigned)(kc + 32 + kb) < 16u);
            const float b1 = brow[kc + 32];
            p1[r] = ok1 ? p1[r] + b1 : -1e30f;
          }
          SBAR();
        }
      } else {
#pragma unroll
        for (int r = 0; r < 16; ++r) { p0[r] = -1e30f; p1[r] = -1e30f; }
      }
    }
  }
}
template <int MODE>
__device__ __forceinline__ void attn_body(const Desc& d, char* lds) {
  const int tid = tid_opaque(), wid = tid >> 6, lane = tid & 63, r32 = lane & 31, hi = lane >> 5;
  char* V_lds = lds; char* K_lds = lds + 2 * SHM_V;
  float* ws = (float*)(lds + 2 * SHM_V + 2 * SHM_K) + wid * 64; float* li_l = ws; float* al_l = ws + 32;
  const float* btab = (const float*)(lds + SHM_ATTN) + 64;
  float m_reg = -1e30f, l_reg = 0; f32x16 o[4] = {}; bf16x8 qr[8];
  const bf16_t* Qw = d.Q + (long)(wid * QBLK + r32) * d.ldq + hi * 8;
#pragma unroll
  for (int d0 = 0; d0 < 8; ++d0) qr[d0] = *reinterpret_cast<const bf16x8*>(Qw + d0 * 16);
  const int sr = tid >> 4, sc = (tid & 15) * 8, vst0 = v_st(sr, sc), vst1 = v_st(32 + sr, sc);
  const int vb0 = (int)(uintptr_t)V_lds + v_rd_base(lane);
  constexpr int SDEPTH = (MODE == 1) ? 1 : 2;
  struct { bf16x8 vs0, vs1, ks0, ks1; } sr_[SDEPTH];
  const unsigned vo0a = (unsigned)(sr * d.ld0 + sc) * 2u, vo0b = (unsigned)((sr + 32) * d.ld0 + sc) * 2u, vo1a = (unsigned)(sr * d.ld1 + sc) * 2u, vo1b = (unsigned)((sr + 32) * d.ld1 + sc) * 2u;
#define SLOAD(i, k0) do { const bool s0_ = (k0) < d.n0; \
    const char* kb_ = s0_ ? (const char*)d.K0 + (size_t)(k0) * d.ld0 * 2 : (const char*)d.K1 + (size_t)((k0) - d.n0) * d.ld1 * 2; \
    const char* vb_ = s0_ ? (const char*)d.V0 + (size_t)(k0) * d.ld0 * 2 : (const char*)d.V1 + (size_t)((k0) - d.n0) * d.ld1 * 2; \
    const unsigned oa_ = s0_ ? vo0a : vo1a, ob_ = s0_ ? vo0b : vo1b; \
    sr_[i].vs0 = *reinterpret_cast<const bf16x8*>(vb_ + oa_); sr_[i].vs1 = *reinterpret_cast<const bf16x8*>(vb_ + ob_); \
    sr_[i].ks0 = *reinterpret_cast<const bf16x8*>(kb_ + oa_); sr_[i].ks1 = *reinterpret_cast<const bf16x8*>(kb_ + ob_); } while (0)
#define SWRITE(b, i) do { *(bf16x8*)(V_lds + (b) * SHM_V + vst0) = sr_[i].vs0;          \
    *(bf16x8*)(V_lds + (b) * SHM_V + vst1) = sr_[i].vs1; int kc = sc * 2;               \
    *(bf16x8*)(K_lds + (b) * SHM_K + KSWZ(sr, kc)) = sr_[i].ks0;                       \
    *(bf16x8*)(K_lds + (b) * SHM_K + KSWZ(32 + sr, kc)) = sr_[i].ks1; } while (0)
#define SWAIT() do { if constexpr (SDEPTH == 2) asm volatile("s_waitcnt vmcnt(4)" ::: "memory"); else asm volatile("s_waitcnt vmcnt(0)" ::: "memory"); } while (0)
#define RESC(a) do { if (__any((a) < 1.f)) { if (hi == 0) al_l[r32] = (a); asm volatile("s_waitcnt lgkmcnt(0)" ::: "memory"); \
    _Pragma("unroll") for (int dd = 0; dd < 4; ++dd) _Pragma("unroll") for (int r = 0; r < 16; ++r) o[dd][r] *= al_l[crow(r, hi)]; } } while (0)
  f32x16 pA0, pA1, pB0, pB1; float mnA, mnB, alA, alB; bf16x8 pa0, pa1, pa2, pa3; const int NT = d.seq / KVBLK;
  constexpr int SE = 0, SO = SDEPTH - 1;
  SLOAD(SE, 0); asm volatile("s_waitcnt vmcnt(0)" ::: "memory"); SWRITE(0, SE); __syncthreads();
  qkt(pA0, pA1, K_lds, qr, r32, hi); na_mask<MODE>(pA0, pA1, 0, d, wid, r32, hi, btab); partialSM(pA0, pA1, m_reg, mnA, alA);
  SLOAD(SO, KVBLK); if constexpr (SDEPTH == 2) { if (2 < NT) SLOAD(SE, 2 * KVBLK); }
  SWAIT(); SWRITE(1, SO); if constexpr (SDEPTH == 1) { if (2 < NT) SLOAD(SE, 2 * KVBLK); } __syncthreads();
  for (int j = 1; j + 1 < NT; j += 2) {
    SBAR(); qkt(pB0, pB1, K_lds + SHM_K, qr, r32, hi); na_mask<MODE>(pB0, pB1, j, d, wid, r32, hi, btab);
    finishSM(pA0, pA1, alA, l_reg, pa0, pa1, pa2, pa3); SBAR();
    if constexpr (SDEPTH == 2) SLOAD(SO, (j + SDEPTH) * KVBLK); SBAR();
    pv_d0(o, vb0, pa0, pa1, pa2, pa3); partialSM(pB0, pB1, m_reg, mnB, alB);
    __syncthreads(); SWAIT(); SWRITE(0, SE); if constexpr (SDEPTH == 1) SLOAD(SE, (j + 2) * KVBLK);
    RESC(alB); __syncthreads();
    SBAR(); qkt(pA0, pA1, K_lds, qr, r32, hi); na_mask<MODE>(pA0, pA1, j + 1, d, wid, r32, hi, btab);
    finishSM(pB0, pB1, alB, l_reg, pa0, pa1, pa2, pa3); SBAR();
    if constexpr (SDEPTH == 2) { if (j + 3 < NT) SLOAD(SE, (j + 3) * KVBLK); } SBAR();
    pv_d0(o, vb0 + (int)SHM_V, pa0, pa1, pa2, pa3); partialSM(pA0, pA1, m_reg, mnA, alA);
    __syncthreads(); SWAIT(); SWRITE(1, SO); if constexpr (SDEPTH == 1) { if (j + 3 < NT) SLOAD(SO, (j + 3) * KVBLK); }
    RESC(alA); __syncthreads();
  }
  SBAR(); qkt(pB0, pB1, K_lds + SHM_K, qr, r32, hi); na_mask<MODE>(pB0, pB1, NT - 1, d, wid, r32, hi, btab);
  finishSM(pA0, pA1, alA, l_reg, pa0, pa1, pa2, pa3); SBAR();
  pv_d0(o, vb0, pa0, pa1, pa2, pa3); partialSM(pB0, pB1, m_reg, mnB, alB);
  __syncthreads(); RESC(alB);
  finishSM(pB0, pB1, alB, l_reg, pa0, pa1, pa2, pa3); SBAR();
  pv_d0(o, vb0 + (int)SHM_V, pa0, pa1, pa2, pa3);
  if (hi == 0) li_l[r32] = l_reg; asm volatile("s_waitcnt lgkmcnt(0)" ::: "memory");
  float rli[16];
#pragma unroll
  for (int r = 0; r < 16; ++r) rli[r] = __builtin_amdgcn_rcpf(li_l[crow(r, hi)]);
  bf16_t* Ow = d.O + (long)(wid * QBLK) * DM;
#pragma unroll
  for (int r = 0; r < 16; ++r) { int orow = crow(r, hi);
#pragma unroll
    for (int d0 = 0; d0 < 4; ++d0) Ow[(long)orow * DM + d0 * 32 + r32] = (bf16_t)(cvtpk(o[d0][r] * rli[r], 0.f) & 0xffffu); }
#undef SLOAD
#undef SWRITE
#undef SWAIT
#undef RESC
}
}

__device__ __forceinline__ void ada_item(const Params& p, int item, unsigned char* shm) {
  const int tid = tid_opaque(), wid = tid >> 6, lane = tid & 63;
  const int layer = item / 96, r = item % 96, kh = r / 48, cb = r % 48;
  float* sc = (float*)shm;
  float* red = (float*)shm + 9 * 1024;
  __syncthreads();
  for (int i = tid; i < 9 * 1024; i += 512) { const int rr = i >> 10, kk = i & 1023;
    const float v = rr < 8 ? p.in[I_C][rr * 2048 + kh * 1024 + kk] : p.in[I_CCTX][kh * 1024 + kk]; sc[i] = silu_f(v); }
  __syncthreads();
  const float* W = p.in[I_ADAW] + ((size_t)layer * 2048 + kh * 1024 + wid * 128) * 12288 + cb * 256 + lane * 4;
  f32x4 acc[9];
#pragma unroll
  for (int i = 0; i < 9; ++i) acc[i] = (f32x4){0.f, 0.f, 0.f, 0.f};
  for (int k = 0; k < 128; k += 8) {
    f32x4 w[8];
#pragma unroll
    for (int u = 0; u < 8; ++u) w[u] = *(const f32x4*)(W + (size_t)(k + u) * 12288);
#pragma unroll
    for (int u = 0; u < 8; ++u)
#pragma unroll
      for (int i = 0; i < 9; ++i) acc[i] += sc[i * 1024 + wid * 128 + k + u] * w[u];
  }
#pragma unroll
  for (int i = 0; i < 9; ++i) *(f32x4*)(red + ((size_t)wid * 9 + i) * 256 + lane * 4) = acc[i];
  __syncthreads();
  float* part = (float*)(p.ws + W_PART);
  for (int i = tid; i < 9 * 256; i += 512) { const int rr = i >> 8, c = i & 255; float s = 0.f;
#pragma unroll
    for (int w = 0; w < 8; ++w) s += red[((size_t)w * 9 + rr) * 256 + c];
    const int col = cb * 256 + c;
    if (kh == 0) s += p.in[I_ADAB][layer * 12288 + col];
    part[((size_t)(layer * 2 + kh) * 9 + rr) * 12288 + col] = s; }
}
template <int MAP> __device__ __forceinline__ void transpose_tile(const float* W, int ldw, int K, int k0, int n0, bf16_t* Wt, unsigned char* shm) {
  const int tid = tid_opaque(); float* tile = (float*)shm;
  __syncthreads();
  f32x4 v[8];
#pragma unroll
  for (int i = 0; i < 8; ++i) { const int kk = (tid >> 6) + i * 8, c4 = (tid & 63) * 4; v[i] = *(const f32x4*)(W + (size_t)(k0 + kk) * ldw + n0 + c4); }
#pragma unroll
  for (int i = 0; i < 8; ++i) { const int kk = (tid >> 6) + i * 8, c4 = (tid & 63) * 4; *(f32x4*)(tile + kk * 260 + c4) = v[i]; }
  __syncthreads();
  const int n = tid & 255, kq = tid >> 8; int col = n0 + n, row;
  if (MAP == 0) row = col;
  else { const int isg = col >= FF ? 1 : 0, ch = col - isg * FF; row = (ch >> 7) * 256 + isg * 128 + (ch & 127); }
  bf16_t* dst = Wt + (size_t)row * K + k0 + kq * 32;
#pragma unroll
  for (int s = 0; s < 4; ++s) { float f[8];
#pragma unroll
    for (int i = 0; i < 8; ++i) f[i] = tile[(kq * 32 + s * 8 + i) * 260 + n];
    u32x4 w = {cvtpk(f[0], f[1]), cvtpk(f[2], f[3]), cvtpk(f[4], f[5]), cvtpk(f[6], f[7])}; *(u32x4*)(dst + s * 8) = w; }
}
template <int J> __device__ __forceinline__ void fold_item(const float* W, int ldw, int colbase, const float* M, const float* cs, bf16_t* Wt, int rowbase, int kc, unsigned char* shm) {
  const int tid = tid_opaque(); float* wl = (float*)shm;
  constexpr int KPT = 32 * J / 512;
  __syncthreads();
#pragma unroll
  for (int i = 0; i < 2; ++i) { const int idx = tid + i * 512, kk = idx >> 5, c4 = (idx & 31) * 4;
    *(f32x4*)(wl + kk * 132 + c4) = *(const f32x4*)(W + (size_t)(kc * 32 + kk) * ldw + colbase + c4); }
  __syncthreads();
  const int j = tid % J, kq = tid / J;
  float acc[KPT];
#pragma unroll
  for (int i = 0; i < KPT; ++i) acc[i] = 0.f;
  for (int c = 0; c < 128; c += 4) {
    const float m0 = M[(c + 0) * J + j], m1 = M[(c + 1) * J + j], m2 = M[(c + 2) * J + j], m3 = M[(c + 3) * J + j];
#pragma unroll
    for (int i = 0; i < KPT; ++i) { const f32x4 wv = *(const f32x4*)(wl + (kq * KPT + i) * 132 + c); acc[i] += wv[0] * m0 + wv[1] * m1 + wv[2] * m2 + wv[3] * m3; }
  }
  const float s = cs ? cs[j] : 1.f;
  bf16_t* dst = Wt + (size_t)(rowbase + j) * DM + kc * 32 + kq * KPT;
#pragma unroll
  for (int i = 0; i < KPT; i += 8) { u32x4 w = {cvtpk(acc[i] * s, acc[i + 1] * s), cvtpk(acc[i + 2] * s, acc[i + 3] * s), cvtpk(acc[i + 4] * s, acc[i + 5] * s), cvtpk(acc[i + 6] * s, acc[i + 7] * s)};
    *(u32x4*)(dst + i) = w; }
}
__device__ __forceinline__ void fold_item2(const float* W, int ldw, int colbase, const float* M, int ldm, int mcol0, const float* cs, bf16_t* Wt, int rowbase, int kc, unsigned char* shm) {
  const int tid = tid_opaque(); float* wl = (float*)shm;
  float* ml = (float*)(shm + 16896);
  __syncthreads();
  f32x4 wr_[2], mr_[8];
#pragma unroll
  for (int i = 0; i < 2; ++i) { const int idx = tid + i * 512, kk = idx >> 5, c4 = (idx & 31) * 4; wr_[i] = *(const f32x4*)(W + (size_t)(kc * 32 + kk) * ldw + colbase + c4); }
#pragma unroll
  for (int i = 0; i < 8; ++i) { const int idx = tid + i * 512, c = idx >> 5, c4 = (idx & 31) * 4; mr_[i] = *(const f32x4*)(M + (size_t)c * ldm + mcol0 + c4); }
#pragma unroll
  for (int i = 0; i < 2; ++i) { const int idx = tid + i * 512, kk = idx >> 5, c4 = (idx & 31) * 4; *(f32x4*)(wl + kk * 132 + c4) = wr_[i]; }
#pragma unroll
  for (int i = 0; i < 8; ++i) { const int idx = tid + i * 512, c = idx >> 5, c4 = (idx & 31) * 4; *(f32x4*)(ml + c * 128 + c4) = mr_[i]; }
  __syncthreads();
  const int j = tid & 127, kq = tid >> 7;
  float acc[8];
#pragma unroll
  for (int i = 0; i < 8; ++i) acc[i] = 0.f;
#pragma unroll 4
  for (int c = 0; c < 128; c += 4) {
    const float m0 = ml[(c + 0) * 128 + j], m1 = ml[(c + 1) * 128 + j], m2 = ml[(c + 2) * 128 + j], m3 = ml[(c + 3) * 128 + j];
#pragma unroll
    for (int i = 0; i < 8; ++i) { const f32x4 wv = *(const f32x4*)(wl + (kq * 8 + i) * 132 + c); acc[i] += wv[0] * m0 + wv[1] * m1 + wv[2] * m2 + wv[3] * m3; }
  }
  const float sc_ = cs ? cs[j] : 1.f;
  u32x4 w = {cvtpk(acc[0] * sc_, acc[1] * sc_), cvtpk(acc[2] * sc_, acc[3] * sc_), cvtpk(acc[4] * sc_, acc[5] * sc_), cvtpk(acc[6] * sc_, acc[7] * sc_)};
  *(u32x4*)(Wt + (size_t)(rowbase + j) * DM + kc * 32 + kq * 8) = w;
}
template <int MODE, int NR> __device__ __forceinline__ void norm_rows(const Params& p, int row0, const float* xp, const float* xs, const float* g, int layer, int kshift, float* yout) {
  const int lane = tid_opaque() & 63;
  f32x4 v[NR][8]; float ss[NR];
#pragma unroll
  for (int r = 0; r < NR; ++r) { const int row = row0 + r * 8;
    const float* x = row < NP ? xp + (size_t)row * DM : xs + (size_t)(row - NP) * DM;
#pragma unroll
    for (int i = 0; i < 8; ++i) v[r][i] = *(const f32x4*)(x + (i * 64 + lane) * 4); }
#pragma unroll
  for (int r = 0; r < NR; ++r) { float s = 0.f;
#pragma unroll
    for (int i = 0; i < 8; ++i) s += v[r][i][0] * v[r][i][0] + v[r][i][1] * v[r][i][1] + v[r][i][2] * v[r][i][2] + v[r][i][3] * v[r][i][3];
    ss[r] = rsqrtf(wave_sum(s) * (1.f / 2048.f) + 1e-6f); }
  if (MODE == 0) {
    const int bidx = row0 < NP ? 8 : ((row0 - NP) >> 11);
    const float* part = (const float*)(p.ws + W_PART);
#pragma unroll
    for (int i = 0; i < 8; ++i) { const int c = (i * 64 + lane) * 4;
      const f32x4 gv = *(const f32x4*)(g + c), sh = modv4(part, layer, bidx, kshift, c), scl = modv4(part, layer, bidx, kshift + 1, c);
      const f32x4 gs = gv * (scl + 1.f);
#pragma unroll
      for (int r = 0; r < NR; ++r) { const f32x4 y = v[r][i] * ss[r] * gs + sh;
        u32x2 w = {cvtpk(y[0], y[1]), cvtpk(y[2], y[3])}; *(u32x2*)((bf16_t*)(p.ws + W_ACT) + (size_t)(row0 + r * 8) * DM + c) = w; } }
  } else {
#pragma unroll
    for (int i = 0; i < 8; ++i) { const int c = (i * 64 + lane) * 4; const f32x4 gv = *(const f32x4*)(g + c);
#pragma unroll
      for (int r = 0; r < NR; ++r) *(f32x4*)(yout + (size_t)(row0 + r * 8) * DM + c) = v[r][i] * ss[r] * gv; }
  }
}
template <int MODE, int NR> __device__ __forceinline__ void norm_rows_b(const Params& p, int row0, const float* g, int layer, int kshift, float* yout) {
  const int lane = tid_opaque() & 63;
  const bf16_t* xb = (const bf16_t*)(p.ws + W_XB);
  u32x4 v[NR][4]; float ss[NR];
#pragma unroll
  for (int r = 0; r < NR; ++r)
#pragma unroll
    for (int i = 0; i < 4; ++i) v[r][i] = *(const u32x4*)(xb + (size_t)(row0 + r * 8) * DM + (i * 64 + lane) * 8);
#pragma unroll
  for (int r = 0; r < NR; ++r) { float s = 0.f;
#pragma unroll
    for (int i = 0; i < 4; ++i)
#pragma unroll
      for (int e = 0; e < 4; ++e) { const float a = bflo(v[r][i][e]), b = bfhi(v[r][i][e]); s += a * a + b * b; }
    ss[r] = rsqrtf(wave_sum(s) * (1.f / 2048.f) + 1e-6f); }
  const int bidx = row0 < NP ? 8 : ((row0 - NP) >> 11);
  const float* part = (const float*)(p.ws + W_PART);
#pragma unroll
  for (int i = 0; i < 4; ++i) { const int c = (i * 64 + lane) * 8;
    f32x4 gs0 = *(const f32x4*)(g + c), gs1 = *(const f32x4*)(g + c + 4), sh0 = {0.f, 0.f, 0.f, 0.f}, sh1 = {0.f, 0.f, 0.f, 0.f};
    if (MODE == 0) { gs0 = gs0 * (modv4(part, layer, bidx, kshift + 1, c) + 1.f); gs1 = gs1 * (modv4(part, layer, bidx, kshift + 1, c + 4) + 1.f);
      sh0 = modv4(part, layer, bidx, kshift, c); sh1 = modv4(part, layer, bidx, kshift, c + 4); }
#pragma unroll
    for (int r = 0; r < NR; ++r) { const u32x4 w = v[r][i];
      const f32x4 x0 = {bflo(w[0]), bfhi(w[0]), bflo(w[1]), bfhi(w[1])}, x1 = {bflo(w[2]), bfhi(w[2]), bflo(w[3]), bfhi(w[3])};
      const f32x4 y0 = x0 * ss[r] * gs0 + sh0, y1 = x1 * ss[r] * gs1 + sh1;
      if (MODE == 0) { u32x4 o = {cvtpk(y0[0], y0[1]), cvtpk(y0[2], y0[3]), cvtpk(y1[0], y1[1]), cvtpk(y1[2], y1[3])};
        *(u32x4*)((bf16_t*)(p.ws + W_ACT) + (size_t)(row0 + r * 8) * DM + c) = o; }
      else { float* y = yout + (size_t)(row0 + r * 8) * DM + c; *(f32x4*)y = y0; *(f32x4*)(y + 4) = y1; } } }
}
__device__ __forceinline__ void fix_phase(const Params& p, int layer) {
  const float* UB = (const float*)(p.ws + W_UB); bf16_t* G = (bf16_t*)(p.ws + W_BIG);
  const float* cw = p.in[I_FFCW] + (size_t)layer * 3 * FF2; const float* cb = p.in[I_FFCB] + (size_t)layer * FF2;
  const long total = 768L * (FF / 4), stride = (long)gridDim.x * 512;
  for (long i0 = (long)blockIdx.x * 512 + tid_opaque(); i0 < total; i0 += 2 * stride) {
    f32x4 pv[2], pg[2], cv[2], cg[2], nv[2], ng[2], w[2][8]; float wp[2], wn[2]; int rowq[2], chq[2]; bool ok[2];
#pragma unroll
    for (int q = 0; q < 2; ++q) {
      const long iq = i0 + q * stride; ok[q] = iq < total; const long i = ok[q] ? iq : i0;
      const int rr = (int)(i / (FF / 4)), ch = (int)(i % (FF / 4)) * 4;
      const int chunk = rr >> 1, last = rr & 1, row = chunk * 64 + (last ? 63 : 0);
      const int seqlen = row < NP ? 256 : 2048; const int rel = row < NP ? row : row - NP;
      const int ubc = (ch >> 7) * 256 + (ch & 127);
      const bool hp = last ? true : (rel % seqlen) != 0, hn = last ? ((rel + 1) % seqlen) != 0 : true;
      const int pc = last ? chunk : max(chunk - 1, 0), nc = last ? min(chunk + 1, 383) : chunk;
      const float* pu = UB + ((size_t)pc * 4 + (last ? 2 : 3)) * FF2 + ubc;
      const float* cu = UB + ((size_t)chunk * 4 + (last ? 3 : 0)) * FF2 + ubc;
      const float* nu = UB + ((size_t)nc * 4 + (last ? 0 : 1)) * FF2 + ubc;
      pv[q] = *(const f32x4*)pu; pg[q] = *(const f32x4*)(pu + 128); cv[q] = *(const f32x4*)cu; cg[q] = *(const f32x4*)(cu + 128); nv[q] = *(const f32x4*)nu; ng[q] = *(const f32x4*)(nu + 128);
      w[q][0] = *(const f32x4*)(cw + ch); w[q][1] = *(const f32x4*)(cw + FF2 + ch); w[q][2] = *(const f32x4*)(cw + 2 * FF2 + ch); w[q][3] = *(const f32x4*)(cb + ch);
      w[q][4] = *(const f32x4*)(cw + FF + ch); w[q][5] = *(const f32x4*)(cw + FF2 + FF + ch); w[q][6] = *(const f32x4*)(cw + 2 * FF2 + FF + ch); w[q][7] = *(const f32x4*)(cb + FF + ch);
      wp[q] = hp ? 1.f : 0.f; wn[q] = hn ? 1.f : 0.f; rowq[q] = row; chq[q] = ch;
    }
#pragma unroll
    for (int q = 0; q < 2; ++q) {
      const f32x4 val = w[q][0] * (pv[q] * wp[q]) + w[q][1] * cv[q] + w[q][2] * (nv[q] * wn[q]) + w[q][3];
      const f32x4 gat = w[q][4] * (pg[q] * wp[q]) + w[q][5] * cg[q] + w[q][6] * (ng[q] * wn[q]) + w[q][7];
      u32x2 o = {cvtpk(silu_fast(gat[0]) * val[0], silu_fast(gat[1]) * val[1]), cvtpk(silu_fast(gat[2]) * val[2], silu_fast(gat[3]) * val[3])};
      if (ok[q]) *(u32x2*)(G + (size_t)rowq[q] * FF + chq[q]) = o;
    }
  }
}
__device__ __forceinline__ void oddprep_row(const Params& p, int row) {
  const int lane = tid_opaque() & 63;
  bf16_t* pr = (bf16_t*)(p.ws + W_BIG) + (size_t)row * ODN;
  const bool lat = row >= NP; const int t = lat ? (row - NP) & 2047 : row & 255;
  const int grow = t >> 6, gcol = t & 63;
  const float* rope = (const float*)(p.ws + W_ROPE);
  unsigned raw[16];
#pragma unroll
  for (int v = 0; v < 16; ++v) raw[v] = *(const unsigned*)(pr + 512 + v * 128 + lane * 2);
  const int seqlen = lat ? 2048 : 256;
  const bf16_t* zb = pr + lane * 8;
  u32x4 zw[16];
#pragma unroll
  for (int si = 0; si < 16; ++si) { const int tc = min(max(t + si - 8, 0), seqlen - 1); zw[si] = *(const u32x4*)(zb + (long)(tc - t) * ODN); }
  const int e0 = lane * 2;
  const float gq0 = p.in[I_ODQG][e0], gq1 = p.in[I_ODQG][e0 + 1], gk0 = p.in[I_ODKG][e0], gk1 = p.in[I_ODKG][e0 + 1];
  const int pos = lane < 32 ? grow : gcol; const int i0 = e0 & 31;
  const float c0 = rope[(pos * 32 + i0) * 2], s0 = rope[(pos * 32 + i0) * 2 + 1], c1 = rope[(pos * 32 + i0 + 1) * 2], s1 = rope[(pos * 32 + i0 + 1) * 2 + 1];
  const bool isx1 = (lane & 16) == 0;
#pragma unroll
  for (int v = 0; v < 16; ++v) {
    float a = bflo(raw[v]), b = bfhi(raw[v]);
    const float ss = wave_sum_dpp(a * a + b * b);
    const float rinv = rsqrtf(ss * (1.f / 128.f) + 1e-6f);
    a = a * rinv * (v < 12 ? gq0 : gk0); b = b * rinv * (v < 12 ? gq1 : gk1);
    if (lat) {
      const float pa = __shfl_xor(a, 16), pb = __shfl_xor(b, 16);
      const float na = isx1 ? a * c0 - pa * s0 : a * c0 + pa * s0;
      const float nb = isx1 ? b * c1 - pb * s1 : b * c1 + pb * s1;
      a = na; b = nb;
    } else if (v >= 12) { float* o = p.out + O_GK + (size_t)row * 512 + (v - 12) * 128 + e0; o[0] = a; o[1] = b; }
    *(unsigned*)(pr + 512 + v * 128 + lane * 2) = cvtpk(a, b);
  }
  const int grp = lane >> 4; const int hw = 1 << grp;
  const int lo = max(t - hw, 0), hi = min(t + hw, seqlen);
  float acc[8];
#pragma unroll
  for (int i = 0; i < 8; ++i) acc[i] = 0.f;
#pragma unroll
  for (int si = 0; si < 16; ++si) { const int ts = t + si - 8; const float wgt = (ts >= lo && ts < hi) ? 1.f : 0.f;
#pragma unroll
    for (int i = 0; i < 4; ++i) { acc[2 * i] += wgt * bflo(zw[si][i]); acc[2 * i + 1] += wgt * bfhi(zw[si][i]); } }
  const u32x4 self = zw[8]; const float inv = 1.f / (float)(hi - lo);
  unsigned ow[4];
#pragma unroll
  for (int i = 0; i < 4; ++i) ow[i] = cvtpk(acc[2 * i] * inv - bflo(self[i]), acc[2 * i + 1] * inv - bfhi(self[i]));
  u32x4 w = {ow[0], ow[1], ow[2], ow[3]};
  *(u32x4*)((bf16_t*)(p.ws + W_ACT) + (size_t)row * DM + lane * 8) = w;
}

__device__ __forceinline__ void do_tile(const Params& p, int i, unsigned char* shm) {
  constexpr int T0 = 576, T1 = 256, T2 = 320, T3 = 256, T4 = 2816;
  if (i < T0) { const int kt = i / 18, nt = i % 18; transpose_tile<0>(p.in[I_EVWIN], 5120, DM, kt * 64, nt * 256, (bf16_t*)(p.ws + W_EVIN), shm); return; } i -= T0;
  if (i < T1) { const int kt = i / 8, nt = i % 8; transpose_tile<0>(p.in[I_EVWOUT], DM, DM, kt * 64, nt * 256, (bf16_t*)(p.ws + W_EVOUT), shm); return; } i -= T1;
  if (i < T2) { const int kt = i / 10, nt = i % 10; transpose_tile<0>(p.in[I_ODWIN], ODN, DM, kt * 64, 512 + nt * 256, (bf16_t*)(p.ws + W_ODIN), shm); return; } i -= T2;
  if (i < T3) { const int kt = i / 8, nt = i % 8; transpose_tile<0>(p.in[I_ODWOUT], DM, DM, kt * 64, nt * 256, (bf16_t*)(p.ws + W_ODOUT), shm); return; } i -= T3;
  if (i < T4) { const int l = i / 1408, r = i % 1408, kt = r / 44, nt = r % 44;
    transpose_tile<1>(p.in[I_FFUP] + (size_t)l * DM * FF2, FF2, DM, kt * 64, nt * 256, (bf16_t*)(p.ws + W_UP) + (size_t)l * FF2 * DM, shm); return; } i -= T4;
  { const int l = i / 704, r = i % 704, kt = r / 8, nt = r % 8;
    transpose_tile<0>(p.in[I_FFDN] + (size_t)l * FF * DM, DM, FF, kt * 64, nt * 256, (bf16_t*)(p.ws + W_DN) + (size_t)l * DM * FF, shm); }
}
__device__ __forceinline__ int tile_now(int j) { return j < 832 ? j : (j < 2240 ? 1408 + (j - 832) : 4224 + (j - 2240)); }
__device__ __forceinline__ int tile_def(int d) { return d < 576 ? 832 + d : (d < 1984 ? 2816 + (d - 576) : 4928 + (d - 1984)); }
__device__ __forceinline__ void prep_phase(const Params& p, unsigned char* shm) {
  const int G = gridDim.x, bid = blockIdx.x, tid = tid_opaque();
  {
    const bool defer = (G == 256);
    const int n_ada = defer ? 96 : 192, n_tiles = defer ? 2944 : 5632;
    unsigned* qctr = (unsigned*)(p.ws + W_BAR);
    volatile LAS unsigned* qslot = (volatile LAS unsigned*)((LAS unsigned char*)shm + (LDS_BYTES - 32));
    for (;;) {
      __syncthreads();
      if (tid == 0) *qslot = atomicAdd(qctr, 1u);
      __syncthreads();
      const int it0 = (int)*qslot;
      if (it0 >= n_ada + n_tiles) break;
      if (it0 < n_ada) { ada_item(p, it0, shm); continue; }
      do_tile(p, defer ? tile_now(it0 - n_ada) : it0 - n_ada, shm);
    }
  }
  const long gt = (long)bid * 512 + tid, gs = (long)G * 512;
  {
    const long n0 = 8L * 256 * 1536 / 8, n1 = 8L * 256 * 512 / 8;
    const long ntot = 2 * n0 + 2 * n1;
    for (long ib = gt; ib < ntot; ib += 4 * gs) {
      f32x4 va[4], vb[4]; bf16_t* dq[4]; bool okq[4];
#pragma unroll
      for (int q = 0; q < 4; ++q) { const long iq = ib + q * gs; okq[q] = iq < ntot; long j = okq[q] ? iq : ib;
        const float* src; bf16_t* dst;
        if (j < n0) { src = p.in[I_CNAK]; dst = (bf16_t*)(p.ws + W_CNAK); }
        else if (j < 2 * n0) { j -= n0; src = p.in[I_CNAV]; dst = (bf16_t*)(p.ws + W_CNAV); }
        else if (j < 2 * n0 + n1) { j -= 2 * n0; src = p.in[I_CGK]; dst = (bf16_t*)(p.ws + W_CGK); }
        else { j -= 2 * n0 + n1; src = p.in[I_CGV]; dst = (bf16_t*)(p.ws + W_CGV); }
        va[q] = *(const f32x4*)(src + j * 8); vb[q] = *(const f32x4*)(src + j * 8 + 4); dq[q] = dst + j * 8; }
#pragma unroll
      for (int q = 0; q < 4; ++q) { u32x4 w = {cvtpk(va[q][0], va[q][1]), cvtpk(va[q][2], va[q][3]), cvtpk(vb[q][0], vb[q][1]), cvtpk(vb[q][2], vb[q][3])}; if (okq[q]) *(u32x4*)dq[q] = w; }
    }
  }
  {
    float* ct = (float*)shm;
    __syncthreads();
    for (int i = tid; i < 2048; i += 512) ct[i] = cospif((float)i * (2.f / 2048.f));
    __syncthreads();
    const long nS = 2048L * 4096 / 8, nC = 256L * 512 / 8;
    for (long i = gt; i < nS + nC; i += gs) {
      int npos, sh, ts; long j; bf16_t* dst;
      if (i < nS) { npos = 2048; sh = 11; ts = 0; j = i; dst = (bf16_t*)(p.ws + W_DFTS); } else { npos = 256; sh = 8; ts = 3; j = i - nS; dst = (bf16_t*)(p.ws + W_DFTC); }
      const int prow = (int)((j * 8) >> (sh + 1)), k0 = (int)((j * 8) & (2 * npos - 1));
      float f[8];
#pragma unroll
      for (int e = 0; e < 8; ++e) { const int k = k0 + e; const int kk = k & (npos - 1); const int m = ((prow * kk) & (npos - 1)) << ts;
        f[e] = (k < npos) ? ct[m] : -ct[(m - 512) & 2047]; }
      u32x4 w = {cvtpk(f[0], f[1]), cvtpk(f[2], f[3]), cvtpk(f[4], f[5]), cvtpk(f[6], f[7])}; *(u32x4*)(dst + j * 8) = w;
    }
    float* M = (float*)(p.ws + W_FOLDM);
    for (long i = gt; i < 4L * 128 * 256; i += gs) { const int j = (int)(i & 255), c = (int)((i >> 8) & 127), g = (int)(i >> 15);
      const float* fw = p.in[I_EVFNET] + (size_t)g * 128 * 128 + (j & 127); float s = 0.f; const int off = (j < 128) ? 0 : 2048 - 512;
#pragma unroll 8
      for (int c2 = 0; c2 < 128; ++c2) { const float tr = ct[((((c * c2) & 127) << 4) + off) & 2047]; s += tr * fw[c2 * 128]; }
      M[i] = s; }
  }
  {
    float* rope = (float*)(p.ws + W_ROPE);
    for (long i = gt; i < 64 * 32; i += gs) { const int pos = (int)(i >> 5), k = (int)(i & 31);
      const float invf = exp2f(-(float)k * (1.f / 32.f) * 13.287712379549449f);
      const float ang = (float)pos * invf; const float x = ang * 0.3183098861837907f;
      rope[i * 2] = cospif(x); rope[i * 2 + 1] = sinpif(x); }
  }
}

#define XB_TMO      128
#define XB_XCNT(j)  (256  + 64 * (j))
#define XB_XSUB(j)  (1280 + 64 * (j))
#define XB_XGEN(j)  (2304 + 64 * (j))
#define XB_TOP      3328
#define XB_TOPGEN   3392
#define XCD_BAR_WORDS 3456
#define XB_SPIN_CAP (1u << 18)
__device__ __forceinline__ unsigned xb_ld(unsigned* p)              { return __hip_atomic_load(p, __ATOMIC_RELAXED, __HIP_MEMORY_SCOPE_AGENT); }
__device__ __forceinline__ unsigned xb_add(unsigned* p, unsigned v) { return __hip_atomic_fetch_add(p, v, __ATOMIC_RELAXED, __HIP_MEMORY_SCOPE_AGENT); }
__device__ __forceinline__ unsigned xb_xcc_id() { return (unsigned)__builtin_amdgcn_s_getreg((3 << 11) | 20) & 0xFu; }
#define XB_SPIN(cond, bar) do { unsigned _sp = 0; while (cond) { __builtin_amdgcn_s_sleep(1); \
    if ((++_sp & 255u) == 0u) { if (xb_ld(&(bar)[XB_TMO])) break; if (_sp > XB_SPIN_CAP) { atomicAdd(&(bar)[XB_TMO], 1u); break; } } } } while (0)
struct XcdBarrier { unsigned* bar; unsigned x; volatile LAS unsigned* st; };
__device__ __forceinline__ XcdBarrier xcd_barrier_post(unsigned* bar, volatile LAS unsigned* st) {
    XcdBarrier b; b.bar = bar; b.x = xb_xcc_id(); b.st = st;
    if (threadIdx.x == 0) (void)xb_add(&bar[XB_XCNT(b.x)], 1u);
    return b;
}
__device__ __forceinline__ void xcd_barrier_complete(unsigned* bar, unsigned x, unsigned& nloc, unsigned& nx) {
    const unsigned G = gridDim.x * gridDim.y * gridDim.z;
    unsigned sum, cnt, mine, sp = 0u;
    for (;;) {
        sum = 0u; cnt = 0u; mine = 0u;
#pragma unroll
        for (unsigned j = 0; j < 16; ++j) { const unsigned c = xb_ld(&bar[XB_XCNT(j)]); sum += c; cnt += (c > 0u) ? 1u : 0u; mine = (j == x) ? c : mine; }
        if (sum == G) break;
        __builtin_amdgcn_s_sleep(1);
        if ((++sp & 255u) == 0u) { if (xb_ld(&bar[XB_TMO])) break; if (sp > XB_SPIN_CAP) { atomicAdd(&bar[XB_TMO], 1u); break; } }
    }
    nloc = mine > 0u ? mine : 1u; nx = cnt > 0u ? cnt : 1u;
}
__device__ __forceinline__ void xcd_barrier(const XcdBarrier& b) {
    asm volatile("s_waitcnt vmcnt(0)" ::: "memory");
    __syncthreads();
    if (threadIdx.x == 0) {
        unsigned* bar = b.bar;
        __builtin_amdgcn_s_waitcnt(0);
        unsigned nloc = b.st[0], nx = b.st[1];
        if (nloc == 0u) { xcd_barrier_complete(bar, b.x, nloc, nx); b.st[0] = nloc; b.st[1] = nx; }
        const unsigned old = xb_add(&bar[XB_XSUB(b.x)], 1u);
        const unsigned gen = old / nloc;
        if (old + 1u == (gen + 1u) * nloc) {
            __builtin_amdgcn_fence(__ATOMIC_RELEASE, "agent");
            asm volatile("s_waitcnt vmcnt(0)" ::: "memory");
            const unsigned og = xb_add(&bar[XB_TOP], 1u);
            const unsigned tg = og / nx;
            if (og + 1u == (tg + 1u) * nx) xb_add(&bar[XB_TOPGEN], 1u);
            else XB_SPIN(xb_ld(&bar[XB_TOPGEN]) == tg, bar);
            __builtin_amdgcn_fence(__ATOMIC_ACQUIRE, "agent");
            xb_add(&bar[XB_XGEN(b.x)], 1u);
            asm volatile("s_waitcnt vmcnt(0)" ::: "memory");
        } else {
            XB_SPIN(xb_ld(&bar[XB_XGEN(b.x)]) == gen, bar);
            __builtin_amdgcn_fence(__ATOMIC_ACQUIRE, "agent");
            asm volatile("s_waitcnt vmcnt(0)" ::: "memory");
        }
    }
    __syncthreads();
}

__global__ void __launch_bounds__(512, 2) mega(Params p_unused) {
  extern __shared__ __attribute__((aligned(16))) unsigned char shm[];
  cg::grid_group grid = cg::this_grid();
  typedef const Params __attribute__((address_space(4)))* KP;
  KP kp0 = (KP)__builtin_amdgcn_kernarg_segment_ptr();
  const int G = gridDim.x, bid = blockIdx.x;
  const int ph_lo = kp0->ph_lo, ph_hi = kp0->ph_hi;
  volatile LAS unsigned* xst = (volatile LAS unsigned*)((LAS unsigned char*)shm + (LDS_BYTES - 16));
  if (threadIdx.x == 0) { xst[0] = 0u; xst[1] = 0u; }
  __syncthreads();
  XcdBarrier xb = xcd_barrier_post((unsigned*)(kp0->ws + W_BAR), xst);
  for (int phx = ph_lo * 2; phx < ph_hi * 2; ++phx) {
    const int ph = phx >> 1;
    if ((phx & 1) && !((REPMASK >> ph) & 1)) continue;
    if (phx > ph_lo * 2) { if (ph_hi > 1000) grid.sync(); else xcd_barrier(xb); }
    KP kp = kp0; asm volatile("" : "+s"(kp));
    Params p;
#pragma unroll
    for (int i = 0; i < 27; ++i) p.in[i] = kp->in[i];
    p.out = kp->out; p.ws = kp->ws; p.ph_lo = 0; p.ph_hi = 0;
    float* xr = p.out + O_Y;
    bf16_t* ACT = (bf16_t*)(p.ws + W_ACT); bf16_t* BIG = (bf16_t*)(p.ws + W_BIG);
    const float* part = (const float*)(p.ws + W_PART);
    int kind, layer = ph >= 9 ? 1 : 0;
    switch (ph) {
      case 0: kind = 0; break;
      case 1: case 5: case 9: case 14: kind = 1; break;
      case 2: case 10: kind = 2; break;
      case 3: case 12: kind = 3; break;
      case 4: case 8: case 13: case 17: kind = 4; break;
      case 6: case 15: kind = 5; break;
      case 7: case 16: kind = 6; break;
      case 11: kind = 7; break;
      default: kind = 8; break;
    }
    if (kind == 0 && (KMASK & 1)) {
      prep_phase(p, shm);
    } else if (kind == 1 && (KMASK & 2)) {
      const bool first = (ph == 1);
      const float* xp = first ? p.in[I_XP] : xr; const float* xs = first ? p.in[I_XS] : xr + (size_t)NP * DM;
      const bool n2 = (ph == 5 || ph == 14);
      const float* g = (n2 ? p.in[I_N2G] : p.in[I_N1G]) + layer * DM;
      if (first) {
        for (int it = bid; it < 768; it += G) {
          if (it < 512) { const int gi = it >> 7, kc = (it >> 1) & 63, jh = it & 1;
            fold_item2(p.in[I_EVWIN], 5120, 4608 + gi * 128, (const float*)(p.ws + W_FOLDM) + (size_t)gi * 128 * 256, 256, jh * 128, nullptr, (bf16_t*)(p.ws + W_EVIN), 4608 + gi * 256 + jh * 128, kc, shm); }
          else { const int v = it - 512, gi = v >> 6, kc = v & 63;
            fold_item2(p.in[I_ODWIN], ODN, gi * 128, p.in[I_ODPOOLW] + (size_t)gi * 128 * 128, 128, 0, p.in[I_ODPOOLS] + gi * 128, (bf16_t*)(p.ws + W_ODIN), gi * 128, kc, shm); }
        }
      }
      const int wid = tid_opaque() >> 6;
      if (first) { for (int it = bid; it < NTOK / 32; it += G) norm_rows<0, 4>(p, it * 32 + wid, xp, xs, g, layer, n2 ? 3 : 0, nullptr); }
      else { for (int it = bid; it < NTOK / 32; it += G) norm_rows_b<0, 4>(p, it * 32 + wid, g, layer, n2 ? 3 : 0, nullptr); }
    } else if (kind == 2 && (KMASK & 4)) {
      pg8::Gemm gm; gm.A = ACT; gm.M = NTOK; gm.K = DM;
      EpiIn E; E.O = BIG; E.out = p.out; E.yts = (bf16_t*)(p.ws + W_YTS); E.ytc = (bf16_t*)(p.ws + W_YTC);
      if (layer == 0) { gm.Bt = (const bf16_t*)(p.ws + W_EVIN); gm.N = EVN; E.ldc = EVN; E.even = 1; }
      else { gm.Bt = (const bf16_t*)(p.ws + W_ODIN); gm.N = ODN; E.ldc = ODN; E.even = 0; }
      pg8::StaticOrder S; S.init(gm.M, gm.N, G, bid);
      pg8::gemm_phase<EpiIn>((LAS unsigned char*)shm, gm, S, E);
      if (layer == 0 && G == 256 && bid >= 64) { for (int d = bid - 64; d < 2112; d += 192) do_tile(p, tile_def(d), shm); }
    } else if (kind == 3 && (KMASK & 8)) {
      const int nunits = 768 + 384;
      const bool bal = (layer == 0 && G == 256);
      const int nloc = bal ? (bid < 128 ? 6 : 3) : (nunits - bid + G - 1) / G;
      for (int iu = 0; iu < nloc; ++iu) {
        int u;
        if (bal) { if (bid < 128) u = iu < 4 ? bid * 4 + iu : 768 + bid * 2 + (iu - 4); else u = iu < 2 ? 512 + (bid - 128) * 2 + iu : 768 + 256 + (bid - 128); }
        else if (layer == 1 && G == 256 && iu < 3) u = (bid & 7) * 96 + iu * 32 + (bid >> 3);
        else u = bid + iu * G;
        at::Desc d; int masked = 0, head = 0;
        if (layer == 0) {
          if (u < 768) { const int b = u / 96, rem = u % 96, h = rem >> 3, rg = rem & 7; head = h; masked = 1;
            const size_t qrow = (size_t)NP + b * 2048 + rg * 256; const bool edge = (rg == 0 || rg == 7); const int ks = edge ? (rg ? 24 : 0) : min(max(4 * rg - 4, 0), 20);
            d.Q = BIG + qrow * EVN + h * 128; d.ldq = EVN;
            d.K0 = (const bf16_t*)(p.ws + W_CNAK) + (size_t)b * 256 * 1536 + h * 128; d.V0 = (const bf16_t*)(p.ws + W_CNAV) + (size_t)b * 256 * 1536 + h * 128; d.ld0 = 1536; d.n0 = 256;
            const size_t krow = (size_t)NP + b * 2048 + ks * 64;
            d.K1 = BIG + krow * EVN + 1536 + h * 128; d.V1 = BIG + krow * EVN + 3072 + h * 128; d.ld1 = EVN; d.seq = edge ? 768 : 1024;
            d.O = ACT + qrow * DM + h * 128; d.ldo = DM; d.ks = ks; d.qrow0 = 4 * rg;
          } else { const int v = u - 768, b = v / 12, h = v % 12; const size_t qrow = (size_t)b * 256;
            d.Q = BIG + qrow * EVN + h * 128; d.ldq = EVN;
            d.K0 = BIG + qrow * EVN + 1536 + h * 128; d.V0 = BIG + qrow * EVN + 3072 + h * 128; d.ld0 = EVN; d.n0 = 256;
            d.K1 = d.K0; d.V1 = d.V0; d.ld1 = EVN; d.seq = 256; d.O = ACT + qrow * DM + h * 128; d.ldo = DM; d.ks = 0; d.qrow0 = 0; }
        } else {
          if (u < 768) { const int b = u / 96, rem = u % 96, h = rem >> 3, qb = rem & 7, kvh = h / 3;
            const size_t qrow = (size_t)NP + b * 2048 + qb * 256;
            d.Q = BIG + qrow * ODN + 512 + h * 128; d.ldq = ODN;
            d.K0 = (const bf16_t*)(p.ws + W_CGK) + (size_t)b * 256 * 512 + kvh * 128; d.V0 = (const bf16_t*)(p.ws + W_CGV) + (size_t)b * 256 * 512 + kvh * 128; d.ld0 = 512; d.n0 = 256;
            const size_t krow = (size_t)NP + b * 2048;
            d.K1 = BIG + krow * ODN + 2048 + kvh * 128; d.V1 = BIG + krow * ODN + 2560 + kvh * 128; d.ld1 = ODN; d.seq = 2304;
            d.O = ACT + qrow * DM + 512 + h * 128; d.ldo = DM; d.ks = 0; d.qrow0 = 0;
          } else { const int v = u - 768, b = v / 12, h = v % 12, kvh = h / 3; const size_t qrow = (size_t)b * 256;
            d.Q = BIG + qrow * ODN + 512 + h * 128; d.ldq = ODN;
            d.K0 = BIG + qrow * ODN + 2048 + kvh * 128; d.V0 = BIG + qrow * ODN + 2560 + kvh * 128; d.ld0 = ODN; d.n0 = 256;
            d.K1 = d.K0; d.V1 = d.V0; d.ld1 = ODN; d.seq = 256; d.O = ACT + qrow * DM + 512 + h * 128; d.ldo = DM; d.ks = 0; d.qrow0 = 0; }
        }
        __syncthreads();
        if (masked && (AMASK & 1)) {
          float* btab = (float*)(shm + at::SHM_ATTN) + 64;
          const int tid = tid_opaque();
          if (tid < 465) btab[tid] = p.in[I_EVBIAS][head * 465 + tid] * (1.f / at::SCALE);
          at::attn_body<1>(d, (char*)shm);
        } else if (AMASK & 2) at::attn_body<0>(d, (char*)shm);
      }
      if (layer == 0 && (AMASK & 4)) {
        __syncthreads();
#pragma unroll 1
        for (int v = 0; v < 2; ++v) {
          pg8::Gemm gm; EpiFourier E; E.mix = ACT;
          if (v == 0) { gm.A = (const bf16_t*)(p.ws + W_DFTS); gm.Bt = (const bf16_t*)(p.ws + W_YTS); gm.M = 2048; gm.N = 4096; gm.K = 4096; E.rowbase = NP; E.npos = 2048; E.scale = 0.001953125f; }
          else { gm.A = (const bf16_t*)(p.ws + W_DFTC); gm.Bt = (const bf16_t*)(p.ws + W_YTC); gm.M = 256; gm.N = 16384; gm.K = 512; E.rowbase = 0; E.npos = 256; E.scale = 0.005524271728019903f; }
          pg8::StaticOrder S; S.init(gm.M, gm.N, G, (bid + 128) % G);
          pg8::gemm_phase<EpiFourier>((LAS unsigned char*)shm, gm, S, E);
          __syncthreads();
        }
      }
    } else if (kind == 4 && (KMASK & 16)) {
      pg8::Gemm gm; gm.M = NTOK; gm.N = DM; EpiRes E; E.xb = (bf16_t*)(p.ws + W_XB); E.xo = (phx & 1) ? ACT : E.xb; E.part = part; E.layer = layer; E.xp = p.in[I_XP]; E.xs = p.in[I_XS]; E.from_in = 0;
      if (ph == 4) { gm.A = ACT; gm.Bt = (const bf16_t*)(p.ws + W_EVOUT); gm.K = DM; E.gk = 2; E.from_in = 1; }
      else if (ph == 13) { gm.A = ACT; gm.Bt = (const bf16_t*)(p.ws + W_ODOUT); gm.K = DM; E.gk = 2; }
      else { gm.A = BIG; gm.Bt = layer ? (const bf16_t*)(p.ws + W_DN + (size_t)DM * FF * 2) : (const bf16_t*)(p.ws + W_DN); gm.K = FF; E.gk = 5; }
      pg8::StaticOrder S; S.init(gm.M, gm.N, G, bid);
      pg8::gemm_phase<EpiRes>((LAS unsigned char*)shm, gm, S, E);
    } else if (kind == 5 && (KMASK & 32)) {
      pg8::Gemm gm; gm.A = ACT; gm.Bt = (const bf16_t*)(p.ws + W_UP) + (size_t)layer * FF2 * DM; gm.M = NTOK; gm.N = FF2; gm.K = DM;
      EpiUp E; E.G = BIG; E.UB = (float*)(p.ws + W_UB); E.cw = p.in[I_FFCW] + (size_t)layer * 3 * FF2; E.cb = p.in[I_FFCB] + (size_t)layer * FF2;
      pg8::StaticOrder S; S.init(gm.M, gm.N, G, bid);
      pg8::gemm_phase<EpiUp>((LAS unsigned char*)shm, gm, S, E);
      if (layer == 0 && G == 256 && bid >= 128) { if (bid < 224) ada_item(p, 96 + (bid - 128), shm); for (int d = 2112 + (bid - 128); d < 2688; d += 128) do_tile(p, tile_def(d), shm); }
    } else if (kind == 6 && (KMASK & 64)) {
      fix_phase(p, layer);
    } else if (kind == 7 && (KMASK & 128)) {
      const int wid = tid_opaque() >> 6;
      for (int it = bid; it < NTOK / 8; it += G) oddprep_row(p, it * 8 + wid);
    } else if (KMASK & 256) {
      for (int e = 0; e < EXTRA_SYNCS; ++e) xcd_barrier(xb);
      const int wid = tid_opaque() >> 6;
      for (int it = bid; it < NTOK / 32; it += G) norm_rows_b<1, 4>(p, it * 32 + wid, p.in[I_FING], 0, 0, xr);
    }
  }
}

extern "C" void kernel_launch(void* const* d_in, const int* in_sizes, int n_in, void* d_out, int out_size, void* d_ws, size_t ws_size, hipStream_t stream) {
  static int grid = 0;
  if (grid == 0) {
    if (n_in != 27 || out_size != 83886080 || ws_size < W_END) { fprintf(stderr, "kernel_launch: unexpected shapes: n_in %d out %d ws %zu (need %zu)\n", n_in, out_size, ws_size, (size_t)W_END); grid = -1; return; }
    int dev = 0, cus = 0, per_cu = 0;
    if (hipGetDevice(&dev) != hipSuccess || hipDeviceGetAttribute(&cus, hipDeviceAttributeMultiprocessorCount, dev) != hipSuccess) { grid = -1; return; }
    if (hipFuncSetAttribute((const void*)mega, hipFuncAttributeMaxDynamicSharedMemorySize, LDS_BYTES) != hipSuccess) { fprintf(stderr, "kernel_launch: hipFuncSetAttribute failed\n"); grid = -1; return; }
    if (hipOccupancyMaxActiveBlocksPerMultiprocessor(&per_cu, (const void*)mega, 512, LDS_BYTES) != hipSuccess || per_cu < 1) { fprintf(stderr, "kernel_launch: occupancy query says %d\n", per_cu); per_cu = 1; }
    (void)hipGetLastError();
    grid = cus * per_cu;
  }
  if (grid < 0) return;
  Params p{};
  for (int i = 0; i < 27; ++i) p.in[i] = (const float*)d_in[i];
  p.out = (float*)d_out; p.ws = (unsigned char*)d_ws;
#if N_LAUNCH_SPLIT
  for (int ph = 0; ph < PH_LIMIT; ++ph) { if (ph == SKIP_PH) continue; p.ph_lo = ph; p.ph_hi = ph + 1; hipLaunchKernelGGL(mega, dim3(grid), dim3(512), LDS_BYTES, stream, p); }
#else
  p.ph_lo = 0; p.ph_hi = NPH;
  (void)hipMemsetAsync((unsigned char*)d_ws + W_BAR, 0, 16384, stream);
  void* args[] = {&p};
  hipError_t e = hipLaunchCooperativeKernel((const void*)mega, dim3(grid), dim3(512), args, LDS_BYTES, stream);
  if (e != hipSuccess) fprintf(stderr, "kernel_launch: cooperative launch failed: %s (grid %d)\n", hipGetErrorString(e), grid);
#endif
}
```

```cpp
#include <hip/hip_runtime.h>
#include <hip/hip_cooperative_groups.h>
#include <cstdio>
#include <cstdint>
namespace cg = cooperative_groups;

#ifndef PH_LIMIT
#define PH_LIMIT 19
#endif
#ifndef SKIP_PH
#define SKIP_PH 99
#endif
#ifndef DBG_L0
#define DBG_L0 0
#endif
#ifndef DBG_SRC0
#define DBG_SRC0 0
#endif
#ifndef REPMASK
#define REPMASK 0
#endif
#ifndef EXTRA_SYNCS
#define EXTRA_SYNCS 0
#endif
#ifndef AMASK
#define AMASK 7
#endif
#ifndef KMASK
#define KMASK 511
#endif
#ifndef N_LAUNCH_SPLIT
#define N_LAUNCH_SPLIT 0
#endif

typedef unsigned short bf16_t;
typedef short bf16x8 __attribute__((ext_vector_type(8)));
typedef short s16x4 __attribute__((ext_vector_type(4)));
typedef float f32x4 __attribute__((ext_vector_type(4)));
typedef float f32x16 __attribute__((ext_vector_type(16)));
typedef unsigned u32x4 __attribute__((ext_vector_type(4)));
typedef unsigned u32x2 __attribute__((ext_vector_type(2)));
#define LAS __attribute__((address_space(3)))

constexpr int DM = 2048, NP = 8192, NS = 16384, NTOK = 24576;
constexpr int EVN = 5632, ODN = 3072, FF = 5632, FF2 = 11264;
constexpr int NPH = 19;
constexpr int LDS_BYTES = 135168;

enum { I_XP = 0, I_XS, I_C, I_CNAK, I_CNAV, I_CGK, I_CGV, I_CCTX, I_N1G, I_N2G, I_ADAW, I_ADAB, I_EVWIN, I_EVBIAS, I_EVFNET, I_EVWOUT,
       I_ODWIN, I_ODPOOLW, I_ODPOOLS, I_ODQG, I_ODKG, I_ODWOUT, I_FFUP, I_FFCW, I_FFCB, I_FFDN, I_FING };
constexpr size_t O_Y = 0, O_NAK = 50331648, O_NAV = 62914560, O_GK = 75497472, O_GV = 79691776;
constexpr size_t al256(size_t x) { return (x + 255) / 256 * 256; }
constexpr size_t W_PART = 0;
constexpr size_t W_FOLDM = W_PART + al256((size_t)2 * 2 * 9 * 12288 * 4);
constexpr size_t W_ROPE = W_FOLDM + al256((size_t)4 * 128 * 256 * 4);
constexpr size_t W_EVOUT = W_ROPE + al256((size_t)64 * 32 * 2 * 4);
constexpr size_t W_ODIN = W_EVOUT + (size_t)DM * DM * 2;
constexpr size_t W_ODOUT = W_ODIN + (size_t)ODN * DM * 2;
constexpr size_t W_UP = W_ODOUT + (size_t)DM * DM * 2;
constexpr size_t W_CGK = W_UP + (size_t)2 * FF2 * DM * 2;
constexpr size_t W_CGV = W_CGK + (size_t)8 * 256 * 512 * 2;
constexpr size_t W_EVIN = W_CGV + (size_t)8 * 256 * 512 * 2;
constexpr size_t W_XB = W_EVIN;
constexpr size_t W_DFTS = W_EVIN + (size_t)EVN * DM * 2;
constexpr size_t W_DFTC = W_DFTS + (size_t)2048 * 4096 * 2;
constexpr size_t W_CNAK = W_DFTC + (size_t)256 * 512 * 2;
constexpr size_t W_CNAV = W_CNAK + (size_t)8 * 256 * 1536 * 2;
constexpr size_t W_YTS = W_CNAV + (size_t)8 * 256 * 1536 * 2;
constexpr size_t W_YTC = W_YTS + (size_t)4096 * 4096 * 2;
static_assert(W_YTC + (size_t)16384 * 512 * 2 - W_XB >= (size_t)NTOK * DM * 2, "XB alias region too small");
constexpr size_t W_ACT = W_YTC + (size_t)16384 * 512 * 2;
constexpr size_t W_BIG = W_ACT + (size_t)NTOK * DM * 2;
constexpr size_t W_UB = W_BIG + (size_t)NTOK * EVN * 2;
constexpr size_t W_DN = W_UB + (size_t)384 * 4 * FF2 * 4;
constexpr size_t W_BAR = W_DN + (size_t)2 * DM * FF * 2;
constexpr size_t W_END = W_BAR + 16384;

struct Params { const float* in[27]; float* out; unsigned char* ws; int ph_lo, ph_hi; };

__device__ __forceinline__ unsigned cvtpk(float lo, float hi) { unsigned r; asm volatile("v_cvt_pk_bf16_f32 %0, %1, %2" : "=v"(r) : "v"(lo), "v"(hi)); return r; }
__device__ __forceinline__ float bf2f(bf16_t b) { return __uint_as_float(((unsigned)b) << 16); }
__device__ __forceinline__ float bflo(unsigned w) { return __uint_as_float(w << 16); }
__device__ __forceinline__ float bfhi(unsigned w) { return __uint_as_float(w & 0xffff0000u); }
__device__ __forceinline__ float wave_sum(float v) {
#pragma unroll
  for (int o = 32; o > 0; o >>= 1) v += __shfl_xor(v, o);
  return v;
}
__device__ __forceinline__ float wave_sum_dpp(float v) {
#define WS_DPP(x, ctrl, rm, bc) __builtin_bit_cast(float, __builtin_amdgcn_update_dpp(0, __builtin_bit_cast(int, x), ctrl, rm, 0xf, bc))
  v += WS_DPP(v, 0x111, 0xf, true); v += WS_DPP(v, 0x112, 0xf, true); v += WS_DPP(v, 0x114, 0xf, true); v += WS_DPP(v, 0x118, 0xf, true);
  v += WS_DPP(v, 0x142, 0xa, false);
  v += WS_DPP(v, 0x143, 0xc, false);
#undef WS_DPP
  return __builtin_bit_cast(float, __builtin_amdgcn_readlane(__builtin_bit_cast(int, v), 63));
}
__device__ __forceinline__ int tid_opaque() { int t = threadIdx.x; asm volatile("" : "+v"(t)); return t; }
__device__ __forceinline__ float silu_f(float x) { return x / (1.f + __expf(-x)); }
__device__ __forceinline__ float silu_fast(float x) { return x * __builtin_amdgcn_rcpf(1.f + __builtin_amdgcn_exp2f(x * -1.4426950408889634f)); }
__device__ __forceinline__ f32x4 modv4(const float* part, int l, int bidx, int k, int col) {
  const float* p0 = part + ((size_t)(l * 2 + 0) * 9 + bidx) * 12288 + k * 2048 + col;
  const float* p1 = part + ((size_t)(l * 2 + 1) * 9 + bidx) * 12288 + k * 2048 + col;
  return *(const f32x4*)p0 + *(const f32x4*)p1;
}

namespace pg8 {
constexpr int BM = 256, BK = 64, HALF = 128, HTB = HALF * BK * 2, STAGE_BYTES = 8 * HTB, NXCD = 8, WGM = 8;
__host__ __device__ __forceinline__ int lds_byte(int r, int c) { const int st = (r >> 4) * 2 + (c >> 5), rr = r & 15, cc = c & 31, ob = rr * 64 + cc * 2; return st * 1024 + (ob ^ (((ob >> 9) & 1) << 5)); }
__host__ __device__ __forceinline__ void stage_rc(int b, int& R, int& C) { const int st = b / 1024, sb = b % 1024, swz = sb ^ (((sb >> 9) & 1) << 5); R = (st >> 1) * 16 + swz / 64; C = (st & 1) * 32 + (swz % 64) / 2; }
__host__ __device__ __forceinline__ int perm32(int rho) { const int n = rho >> 4, i = rho & 15; return 8 * (i >> 2) + 4 * n + (i & 3); }
struct Unit { int pm, pn; };
struct Gemm { const bf16_t* A; const bf16_t* Bt; int M, N, K; };
struct StaticOrder {
  int nM, nN, nwg, G, c;
  __device__ void init(int M, int N, int G_, int c_) { nM = M / BM; nN = N / BM; nwg = nM * nN; G = G_; c = c_; }
  __device__ bool next(int i, Unit& u) const {
    const long L = (long)i * G + c; if (L >= nwg) return false;
    int wgid = (int)L; { const int q = nwg / NXCD, r = nwg % NXCD, xcd = wgid % NXCD, off = wgid / NXCD; wgid = (xcd < r ? xcd * (q + 1) : r * (q + 1) + (xcd - r) * q) + off; }
    const int nig = WGM * nN, gid = wgid / nig, fm = gid * WGM, gsz = (nM - fm) < WGM ? (nM - fm) : WGM;
    u.pm = fm + ((wgid % nig) % gsz); u.pn = (wgid % nig) / gsz; return true;
  }
};

template <class Epi>
__device__ __forceinline__ void gemm_phase(LAS unsigned char* lds, const Gemm g, const StaticOrder& S, const Epi& E) {
  const int tid = tid_opaque(), wid = __builtin_amdgcn_readfirstlane(tid >> 6), lane = tid & 63, wr = wid >> 2, wc = wid & 3, fr = lane & 15, fq = lane >> 4;
  const int K = g.K, nt = K / BK;
  unsigned voffA[2], voffB[2];
#pragma unroll
  for (int i = 0; i < 2; ++i) { int R, C; stage_rc(tid * 16 + i * 8192, R, C); const int Rb = Epi::PERM ? ((R & ~31) + perm32(R & 31)) : R;
    const int Ra = Epi::APERM ? ((R & ~63) + 4 * (R & 15) + ((R >> 4) & 3)) : R;
    voffA[i] = (unsigned)(Ra * K + C) * 2u; voffB[i] = (unsigned)(Rb * K + C) * 2u; }
  const size_t kstep = (size_t)(BK * 2);
  const size_t hstep = (size_t)HALF * K * 2;
  const size_t tstep = 2 * hstep;
  const unsigned ldsw = (unsigned)wid * 1024u;
  const int aoff = lds_byte(wr * 64 + fr, fq * 8), boff = lds_byte(wc * 32 + fr, fq * 8);
#define PG8_SA(b, h) (((b) * 2 + (h)) * HTB)
#define PG8_SB(b, h) ((4 + (b) * 2 + (h)) * HTB)
#define PG8_STAGE(bufoff, gbase, voff) do { _Pragma("unroll") for (int _i = 0; _i < 2; ++_i) \
    __builtin_amdgcn_global_load_lds((const unsigned*)((const char*)(gbase) + (voff)[_i]), (LAS unsigned*)(lds + (bufoff) + ldsw + _i * 8192), 16, 0, 0); } while (0)
#define PG8_LDA(dst, b, h) do { _Pragma("unroll") for (int m = 0; m < 4; ++m) _Pragma("unroll") for (int k = 0; k < 2; ++k) dst[m][k] = *(const LAS bf16x8*)(lds + PG8_SA(b, h) + aoff + m * 2048 + k * 1024); } while (0)
#define PG8_LDB(dst, b, h) do { _Pragma("unroll") for (int n = 0; n < 2; ++n) _Pragma("unroll") for (int k = 0; k < 2; ++k) dst[n][k] = *(const LAS bf16x8*)(lds + PG8_SB(b, h) + boff + n * 2048 + k * 1024); } while (0)
#define PG8_MMA(ai, bj, At, Bt) do { __builtin_amdgcn_s_setprio(1); _Pragma("unroll") for (int m = 0; m < 4; ++m) _Pragma("unroll") for (int n = 0; n < 2; ++n) _Pragma("unroll") for (int k = 0; k < 2; ++k) \
    acc[ai][bj][m][n] = __builtin_amdgcn_mfma_f32_16x16x32_bf16(Bt[n][k], At[m][k], acc[ai][bj][m][n], 0, 0, 0); __builtin_amdgcn_s_setprio(0); } while (0)
#define PG8_WAIT_V(n) asm volatile("s_waitcnt vmcnt(" #n ")" ::: "memory")
#define PG8_WAIT_L(n) asm volatile("s_waitcnt lgkmcnt(" #n ")" ::: "memory")
#define PG8_BAR __builtin_amdgcn_s_barrier()
#define PG8_SCHED __builtin_amdgcn_sched_barrier(0)
  Unit cur, nxt; int ui = 0;
  if (!S.next(0, cur)) return;
  f32x4 acc[2][2][4][2];
#pragma unroll
  for (int a = 0; a < 2; ++a)
#pragma unroll
    for (int b = 0; b < 2; ++b)
#pragma unroll
      for (int m = 0; m < 4; ++m)
#pragma unroll
        for (int n = 0; n < 2; ++n) acc[a][b][m][n] = (f32x4){0.f, 0.f, 0.f, 0.f};
  bf16x8 At[4][2], B0[2][2], B1[2][2];
  const char* cA = (const char*)g.A + (size_t)cur.pm * tstep; const char* cB = (const char*)g.Bt + (size_t)cur.pn * tstep;
  PG8_STAGE(PG8_SB(0, 0), cB, voffB); PG8_STAGE(PG8_SA(0, 0), cA, voffA); PG8_STAGE(PG8_SB(0, 1), cB + hstep, voffB); PG8_STAGE(PG8_SA(0, 1), cA + hstep, voffA);
  if (wr == 1) PG8_BAR;
  PG8_WAIT_V(4); PG8_BAR;
  PG8_STAGE(PG8_SB(1, 0), cB + kstep, voffB); PG8_STAGE(PG8_SA(1, 0), cA + kstep, voffA); PG8_STAGE(PG8_SB(1, 1), cB + hstep + kstep, voffB);
  PG8_WAIT_V(6); PG8_BAR;
  for (;;) {
    const bool has_next = S.next(ui + 1, nxt);
    const char* nA = has_next ? (const char*)g.A + (size_t)nxt.pm * tstep : cA; const char* nB = has_next ? (const char*)g.Bt + (size_t)nxt.pn * tstep : cB;
    for (int t = 0; t < nt; t += 2) {
      const bool last = (t == nt - 2);
      const char* a1 = cA + (size_t)(t + 1) * kstep;
      const char* a2 = last ? nA : cA + (size_t)(t + 2) * kstep; const char* b2 = last ? nB : cB + (size_t)(t + 2) * kstep;
      const char* a3 = a2 + kstep; const char* b3 = b2 + kstep;
      PG8_LDB(B0, 0, 0); PG8_SCHED; PG8_LDA(At, 0, 0); PG8_STAGE(PG8_SA(1, 1), a1 + hstep, voffA);
      PG8_WAIT_L(8); PG8_BAR; PG8_WAIT_L(0); PG8_MMA(0, 0, At, B0); PG8_BAR; PG8_SCHED;
      PG8_LDB(B1, 0, 1); PG8_STAGE(PG8_SB(0, 0), b2, voffB);
      PG8_BAR; PG8_WAIT_L(0); PG8_MMA(0, 1, At, B1); PG8_BAR;
      PG8_LDA(At, 0, 1); PG8_STAGE(PG8_SA(0, 0), a2, voffA);
      PG8_BAR; PG8_WAIT_L(0); PG8_MMA(1, 0, At, B0); PG8_BAR; PG8_SCHED;
      PG8_STAGE(PG8_SB(0, 1), b2 + hstep, voffB);
      PG8_WAIT_V(6); PG8_BAR; PG8_MMA(1, 1, At, B1); PG8_BAR;
      PG8_LDB(B0, 1, 0); PG8_SCHED; PG8_LDA(At, 1, 0); PG8_STAGE(PG8_SA(0, 1), a2 + hstep, voffA);
      PG8_WAIT_L(8); PG8_BAR; PG8_WAIT_L(0); PG8_MMA(0, 0, At, B0); PG8_BAR; PG8_SCHED;
      PG8_LDB(B1, 1, 1); PG8_STAGE(PG8_SB(1, 0), b3, voffB);
      PG8_BAR; PG8_WAIT_L(0); PG8_MMA(0, 1, At, B1); PG8_BAR;
      PG8_LDA(At, 1, 1); PG8_STAGE(PG8_SA(1, 0), a3, voffA);
      PG8_BAR; PG8_WAIT_L(0); PG8_MMA(1, 0, At, B0); PG8_BAR; PG8_SCHED;
      PG8_STAGE(PG8_SB(1, 1), b3 + hstep, voffB);
      PG8_WAIT_V(6); PG8_BAR; PG8_MMA(1, 1, At, B1); PG8_BAR;
    }
    E(acc, cur, wr, wc, fr, fq);
    if (!has_next) break;
#pragma unroll
    for (int a = 0; a < 2; ++a)
#pragma unroll
      for (int b = 0; b < 2; ++b)
#pragma unroll
        for (int m = 0; m < 4; ++m)
#pragma unroll
          for (int n = 0; n < 2; ++n) acc[a][b][m][n] = (f32x4){0.f, 0.f, 0.f, 0.f};
    cur = nxt; cA = nA; cB = nB; ++ui;
  }
  PG8_WAIT_V(0);
  if (wr == 0) PG8_BAR;
  PG8_BAR;
#undef PG8_SA
#undef PG8_SB
#undef PG8_STAGE
#undef PG8_LDA
#undef PG8_LDB
#undef PG8_MMA
#undef PG8_WAIT_V
#undef PG8_WAIT_L
#undef PG8_BAR
#undef PG8_SCHED
}
}
using pg8::Unit;
typedef f32x4 AccT[2][2][4][2];

struct EpiIn {
  static constexpr bool PERM = true; static constexpr bool APERM = false;
  bf16_t* O; int ldc; int even; float* out; bf16_t* yts; bf16_t* ytc;
  __device__ __forceinline__ void operator()(const AccT& acc, const Unit& u, int wr, int wc, int fr, int fq) const {
    const int row0 = u.pm * 256 + wr * 64 + fr;
    if (even && u.pn >= 18) {
      const int g = u.pn - 18;
      bf16_t* base; size_t rs; int half, pos0;
      if (u.pm < 32) { base = ytc + (size_t)((u.pm * 4 + g) * 128) * 512; rs = 512; half = 256; pos0 = wr * 64 + fr; }
      else { const int b = (u.pm - 32) >> 3; base = yts + (size_t)((b * 4 + g) * 128) * 4096; rs = 4096; half = 2048; pos0 = ((u.pm - 32) & 7) * 256 + wr * 64 + fr; }
#pragma unroll
      for (int ai = 0; ai < 2; ++ai)
#pragma unroll
        for (int m = 0; m < 4; ++m) { const int pos = pos0 + ai * 128 + m * 16;
#pragma unroll
          for (int bj = 0; bj < 2; ++bj)
#pragma unroll
            for (int n = 0; n < 2; ++n)
#pragma unroll
              for (int j = 0; j < 4; ++j) { const int d = wc * 32 + 8 * fq + 4 * n + j;
                base[(size_t)d * rs + bj * half + pos] = (bf16_t)(cvtpk(acc[ai][bj][m][n][j], 0.f) & 0xffffu); } }
      return;
    }
    const int col0 = u.pn * 256 + wc * 32 + 8 * fq;
    float* side = nullptr; int sld = 0;
    if (u.pm < 32) {
      if (even) { if (u.pn >= 6 && u.pn < 12) { side = out + O_NAK + (col0 - 1536); sld = 1536; } else if (u.pn >= 12) { side = out + O_NAV + (col0 - 3072); sld = 1536; } }
      else if (u.pn >= 10) { side = out + O_GV + (col0 - 2560); sld = 512; }
    }
#pragma unroll
    for (int ai = 0; ai < 2; ++ai)
#pragma unroll
      for (int m = 0; m < 4; ++m) { const int row = row0 + ai * 128 + m * 16; bf16_t* rowp = O + (size_t)row * ldc + col0;
#pragma unroll
        for (int bj = 0; bj < 2; ++bj) { const f32x4 v0 = acc[ai][bj][m][0], v1 = acc[ai][bj][m][1];
          u32x4 w = {cvtpk(v0[0], v0[1]), cvtpk(v0[2], v0[3]), cvtpk(v1[0], v1[1]), cvtpk(v1[2], v1[3])};
          *(u32x4*)(rowp + bj * 128) = w;
          if (side) { float* sp = side + (size_t)row * sld + bj * 128; *(f32x4*)sp = v0; *(f32x4*)(sp + 4) = v1; } } }
  }
};
struct EpiRes {
  static constexpr bool PERM = true; static constexpr bool APERM = false;
  const float* xp; const float* xs; bf16_t* xb; bf16_t* xo; const float* part; int layer, gk; int from_in;
  __device__ __forceinline__ void operator()(const AccT& acc, const Unit& u, int wr, int wc, int fr, int fq) const {
    const int bidx = u.pm < 32 ? 8 : ((u.pm - 32) >> 3);
    const int row0 = u.pm * 256 + wr * 64 + fr, col0 = u.pn * 256 + wc * 32 + 8 * fq;
    const float* xin = u.pm < 32 ? xp : (xs - (size_t)NP * DM);
    f32x4 gv[2][2];
#pragma unroll
    for (int bj = 0; bj < 2; ++bj)
#pragma unroll
      for (int n = 0; n < 2; ++n) gv[bj][n] = modv4(part, layer, bidx, gk, col0 + bj * 128 + n * 4);
#pragma unroll
    for (int ai = 0; ai < 2; ++ai)
#pragma unroll
      for (int m = 0; m < 4; ++m) { const size_t ro = (size_t)(row0 + ai * 128 + m * 16) * DM + col0;
#pragma unroll
        for (int bj = 0; bj < 2; ++bj) { f32x4 x0, x1;
          if (from_in) { x0 = *(const f32x4*)(xin + ro + bj * 128); x1 = *(const f32x4*)(xin + ro + bj * 128 + 4); }
          else { const u32x4 w = *(const u32x4*)(xb + ro + bj * 128); x0 = (f32x4){bflo(w[0]), bfhi(w[0]), bflo(w[1]), bfhi(w[1])}; x1 = (f32x4){bflo(w[2]), bfhi(w[2]), bflo(w[3]), bfhi(w[3])}; }
          x0 = x0 + gv[bj][0] * acc[ai][bj][m][0]; x1 = x1 + gv[bj][1] * acc[ai][bj][m][1];
          u32x4 o = {cvtpk(x0[0], x0[1]), cvtpk(x0[2], x0[3]), cvtpk(x1[0], x1[1]), cvtpk(x1[2], x1[3])};
          *(u32x4*)(xo + ro + bj * 128) = o; } }
  }
};
__device__ __forceinline__ float dpp_ror1(float v) { return __builtin_bit_cast(float, __builtin_amdgcn_update_dpp(0, __builtin_bit_cast(int, v), 0x121, 0xf, 0xf, false)); }
__device__ __forceinline__ float dpp_rol1(float v) { return __builtin_bit_cast(float, __builtin_amdgcn_update_dpp(0, __builtin_bit_cast(int, v), 0x12F, 0xf, 0xf, false)); }
struct EpiUp {
  static constexpr bool PERM = true; static constexpr bool APERM = true;
  bf16_t* G; float* UB; const float* cw; const float* cb;
  __device__ __forceinline__ void operator()(const AccT& acc, const Unit& u, int wr, int wc, int fr, int fq) const {
    const int cc0 = wc * 32 + 8 * fq;
    const int chv = u.pn * 128 + cc0;
    unsigned gp[2][4][4];
#pragma unroll
    for (int n = 0; n < 2; ++n) {
      const int ch = chv + 4 * n;
      f32x4 cwv[1][8];
      cwv[0][0] = *(const f32x4*)(cw + ch); cwv[0][1] = *(const f32x4*)(cw + FF2 + ch); cwv[0][2] = *(const f32x4*)(cw + 2 * FF2 + ch); cwv[0][3] = *(const f32x4*)(cb + ch);
      cwv[0][4] = *(const f32x4*)(cw + FF + ch); cwv[0][5] = *(const f32x4*)(cw + FF2 + FF + ch); cwv[0][6] = *(const f32x4*)(cw + 2 * FF2 + FF + ch); cwv[0][7] = *(const f32x4*)(cb + FF + ch);
      const f32x4 v0 = cwv[0][0] * -0.6931471805599453f, v1 = cwv[0][1] * -0.6931471805599453f, v2 = cwv[0][2] * -0.6931471805599453f, vb = cwv[0][3] * -0.6931471805599453f;
      const f32x4 g0 = cwv[0][4] * -1.4426950408889634f, g1 = cwv[0][5] * -1.4426950408889634f, g2 = cwv[0][6] * -1.4426950408889634f, gb = cwv[0][7] * -1.4426950408889634f;
#pragma unroll
      for (int ai = 0; ai < 2; ++ai) {
        const int chunk = u.pm * 4 + ai * 2 + wr;
        f32x4 o[4];
        {
          const f32x4 a0 = acc[ai][0][0][n], a1 = acc[ai][0][1][n], a2 = acc[ai][0][2][n], a3 = acc[ai][0][3][n];
          const f32x4 b0 = acc[ai][1][0][n], b1 = acc[ai][1][1][n], b2 = acc[ai][1][2][n], b3 = acc[ai][1][3][n];
          f32x4 au, ad, bu, bd;
#pragma unroll
          for (int j = 0; j < 4; ++j) { au[j] = dpp_ror1(a3[j]); ad[j] = dpp_rol1(a0[j]); bu[j] = dpp_ror1(b3[j]); bd[j] = dpp_rol1(b0[j]); }
          f32x4 vv[4], gg[4];
          vv[0] = v0 * au + v1 * a0 + v2 * a1 + vb; vv[1] = v0 * a0 + v1 * a1 + v2 * a2 + vb; vv[2] = v0 * a1 + v1 * a2 + v2 * a3 + vb; vv[3] = v0 * a2 + v1 * a3 + v2 * ad + vb;
          gg[0] = g0 * bu + g1 * b0 + g2 * b1 + gb; gg[1] = g0 * b0 + g1 * b1 + g2 * b2 + gb; gg[2] = g0 * b1 + g1 * b2 + g2 * b3 + gb; gg[3] = g0 * b2 + g1 * b3 + g2 * bd + gb;
#pragma unroll
          for (int m = 0; m < 4; ++m) { f32x4 e, r;
#pragma unroll
            for (int j = 0; j < 4; ++j) e[j] = __builtin_amdgcn_exp2f(gg[m][j]);
            e = e + 1.f;
#pragma unroll
            for (int j = 0; j < 4; ++j) r[j] = __builtin_amdgcn_rcpf(e[j]);
            o[m] = (vv[m] * gg[m]) * r; }
        }
#pragma unroll
        for (int m = 0; m < 4; ++m) { gp[ai][m][n * 2 + 0] = cvtpk(o[m][0], o[m][1]); gp[ai][m][n * 2 + 1] = cvtpk(o[m][2], o[m][3]); }
        if (fr == 0 || fr == 15) {
          float* ub = UB + ((size_t)chunk * 4 + (fr ? 2 : 0)) * FF2 + u.pn * 256 + cc0 + 4 * n;
          if (fr == 0) { *(f32x4*)ub = acc[ai][0][0][n]; *(f32x4*)(ub + 128) = acc[ai][1][0][n]; *(f32x4*)(ub + FF2) = acc[ai][0][1][n]; *(f32x4*)(ub + FF2 + 128) = acc[ai][1][1][n]; }
          else { *(f32x4*)ub = acc[ai][0][2][n]; *(f32x4*)(ub + 128) = acc[ai][1][2][n]; *(f32x4*)(ub + FF2) = acc[ai][0][3][n]; *(f32x4*)(ub + FF2 + 128) = acc[ai][1][3][n]; }
        }
      }
    }
#pragma unroll
    for (int ai = 0; ai < 2; ++ai) {
      const int rowc = (u.pm * 4 + ai * 2 + wr) * 64;
#pragma unroll
      for (int m = 0; m < 4; ++m) {
        const bool skip = (m == 0 && fr == 0) || (m == 3 && fr == 15);
        if (!skip) { u32x4 w = {gp[ai][m][0], gp[ai][m][1], gp[ai][m][2], gp[ai][m][3]}; *(u32x4*)(G + (size_t)(rowc + 4 * fr + m) * FF + chv) = w; }
      }
    }
  }
};
struct EpiFourier {
  static constexpr bool PERM = true; static constexpr bool APERM = false;
  bf16_t* mix; int rowbase, npos; float scale;
  __device__ __forceinline__ void operator()(const AccT& acc, const Unit& u, int wr, int wc, int fr, int fq) const {
    const int pos0 = u.pm * 256 + wr * 64 + fr;
#pragma unroll
    for (int bj = 0; bj < 2; ++bj) {
      const int col = u.pn * 256 + bj * 128 + wc * 32 + 8 * fq; const int b = col >> 9, gd = col & 511;
      bf16_t* basep = mix + (size_t)(rowbase + b * npos) * DM + 1536 + gd;
#pragma unroll
      for (int ai = 0; ai < 2; ++ai)
#pragma unroll
        for (int m = 0; m < 4; ++m) { const f32x4 v0 = acc[ai][bj][m][0] * scale, v1 = acc[ai][bj][m][1] * scale;
          u32x4 w = {cvtpk(v0[0], v0[1]), cvtpk(v0[2], v0[3]), cvtpk(v1[0], v1[1]), cvtpk(v1[2], v1[3])};
          *(u32x4*)(basep + (size_t)(pos0 + ai * 128 + m * 16) * DM) = w; }
    }
  }
};

namespace at {
constexpr int D = 128, NW = 8, QBLK = 32, KVBLK = 64;
constexpr float SCALE = 0.088388347648318440f;
constexpr float THR = 8.f;
constexpr size_t SHM_V = KVBLK * D * 2, SHM_K = KVBLK * D * 2, SHM_ATTN = 2 * SHM_V + 2 * SHM_K + NW * 64 * 4;
#define KSWZ(row, colB) ((row) * 256 + ((colB) ^ (((row) & 7) << 4)))
#define SBAR() __builtin_amdgcn_sched_barrier(0)
__device__ __forceinline__ int crow(int r, int hi) { return (r & 3) + 8 * (r >> 2) + 4 * hi; }
__device__ __forceinline__ void partialSM(f32x16& p0, f32x16& p1, float& m_reg, float& mn, float& alpha) {
  constexpr float C = SCALE * 1.4426950408889634f;
  float pmax = p0[0];
#pragma unroll
  for (int r = 1; r < 16; ++r) pmax = fmaxf(pmax, p0[r]);
#pragma unroll
  for (int r = 0; r < 16; ++r) pmax = fmaxf(pmax, p1[r]);
  { auto rr = __builtin_amdgcn_permlane32_swap(__float_as_uint(pmax), __float_as_uint(pmax), false, false);
    pmax = fmaxf(__uint_as_float(rr[0]), __uint_as_float(rr[1])); }
  if (__builtin_expect(__all(pmax - m_reg <= THR / SCALE), 1)) { mn = m_reg; alpha = 1.f; }
  else { mn = fmaxf(m_reg, pmax); alpha = __builtin_amdgcn_exp2f((m_reg - mn) * C); m_reg = mn; }
  float mnC = -mn * C;
  p0 = p0 * C + mnC; p1 = p1 * C + mnC;
#pragma unroll
  for (int r = 0; r < 16; ++r) p0[r] = __builtin_amdgcn_exp2f(p0[r]);
}
__device__ __forceinline__ void finishSM(f32x16& p0, f32x16& p1, float alpha, float& l_reg, bf16x8& pa0, bf16x8& pa1, bf16x8& pa2, bf16x8& pa3) {
#pragma unroll
  for (int r = 0; r < 16; ++r) p1[r] = __builtin_amdgcn_exp2f(p1[r]);
  float ps;
  { typedef float f32x8 __attribute__((ext_vector_type(8))); typedef float f32x2v __attribute__((ext_vector_type(2)));
    const f32x16 s16 = p0 + p1; const f32x8 s8 = s16.lo + s16.hi; const f32x4 s4 = s8.lo + s8.hi; const f32x2v s2 = s4.lo + s4.hi; ps = s2.x + s2.y; }
  { auto rr = __builtin_amdgcn_permlane32_swap(__float_as_uint(ps), __float_as_uint(ps), false, false);
    ps = __uint_as_float(rr[0]) + __uint_as_float(rr[1]); }
  l_reg = l_reg * alpha + ps;
#define PK4(P, BASE, OUT) do { unsigned a0 = cvtpk(P[BASE + 0], P[BASE + 1]), a1 = cvtpk(P[BASE + 2], P[BASE + 3]);   \
    unsigned b0 = cvtpk(P[BASE + 4], P[BASE + 5]), b1 = cvtpk(P[BASE + 6], P[BASE + 7]);                              \
    auto r0 = __builtin_amdgcn_permlane32_swap(a0, b0, false, false); auto r1 = __builtin_amdgcn_permlane32_swap(a1, b1, false, false); \
    u32x4 w = {r0[0], r1[0], r0[1], r1[1]}; OUT = *reinterpret_cast<bf16x8*>(&w); } while (0)
  PK4(p0, 0, pa0); PK4(p0, 8, pa1); PK4(p1, 0, pa2); PK4(p1, 8, pa3);
#undef PK4
}
__device__ __forceinline__ void qkt(f32x16& p0, f32x16& p1, const char* Ks, const bf16x8* qr, int r32, int hi) {
  p0 = f32x16{}; p1 = f32x16{};
#pragma unroll
  for (int d0 = 0; d0 < 8; ++d0) { int cb = (d0 * 16 + hi * 8) * 2;
    bf16x8 b0 = *reinterpret_cast<const bf16x8*>(Ks + KSWZ(r32, cb));
    bf16x8 b1 = *reinterpret_cast<const bf16x8*>(Ks + KSWZ(32 + r32, cb));
    p0 = __builtin_amdgcn_mfma_f32_32x32x16_bf16(b0, qr[d0], p0, 0, 0, 0);
    p1 = __builtin_amdgcn_mfma_f32_32x32x16_bf16(b1, qr[d0], p1, 0, 0, 0); }
}
__device__ __forceinline__ int v_st(int k, int c) { const int kk = (k & ~0xC) | ((k & 4) << 1) | ((k & 8) >> 1); return ((kk >> 3) * 4 + (c >> 5)) * 512 + ((kk & 7) * 32 + (c & 31)) * 2; }
__device__ __forceinline__ int v_rd_base(int lane) { return ((lane & 3) << 3) | (((lane >> 2) & 3) << 6) | (((lane >> 4) & 1) << 5) | (((lane >> 5) & 1) << 8); }
constexpr int v_rd_off(int d0, int ks, int half) { return d0 * 512 + ks * 4096 + half * 2048; }
template <int OFF> __device__ __forceinline__ s16x4 tr_read(int vb) {
  s16x4 r; asm volatile("ds_read_b64_tr_b16 %0, %1 offset:%2" : "=&v"(r) : "v"(vb), "i"(OFF) : "memory"); return r;
}
template <int D0> __device__ __forceinline__ void pv_one(f32x16& od, int vb, bf16x8 pa0, bf16x8 pa1, bf16x8 pa2, bf16x8 pa3) {
  const s16x4 l0 = tr_read<v_rd_off(D0, 0, 0)>(vb), h0 = tr_read<v_rd_off(D0, 0, 1)>(vb), l1 = tr_read<v_rd_off(D0, 1, 0)>(vb), h1 = tr_read<v_rd_off(D0, 1, 1)>(vb);
  const s16x4 l2 = tr_read<v_rd_off(D0, 2, 0)>(vb), h2 = tr_read<v_rd_off(D0, 2, 1)>(vb), l3 = tr_read<v_rd_off(D0, 3, 0)>(vb), h3 = tr_read<v_rd_off(D0, 3, 1)>(vb);
  asm volatile("s_waitcnt lgkmcnt(0)" ::: "memory"); SBAR();
#define PK(L, H) (bf16x8){L[0], L[1], L[2], L[3], H[0], H[1], H[2], H[3]}
  od = __builtin_amdgcn_mfma_f32_32x32x16_bf16(pa0, PK(l0, h0), od, 0, 0, 0);
  od = __builtin_amdgcn_mfma_f32_32x32x16_bf16(pa1, PK(l1, h1), od, 0, 0, 0);
  od = __builtin_amdgcn_mfma_f32_32x32x16_bf16(pa2, PK(l2, h2), od, 0, 0, 0);
  od = __builtin_amdgcn_mfma_f32_32x32x16_bf16(pa3, PK(l3, h3), od, 0, 0, 0);
#undef PK
}
__device__ __forceinline__ void pv_d0(f32x16* o, int vb, bf16x8 pa0, bf16x8 pa1, bf16x8 pa2, bf16x8 pa3) {
  pv_one<0>(o[0], vb, pa0, pa1, pa2, pa3); pv_one<1>(o[1], vb, pa0, pa1, pa2, pa3); pv_one<2>(o[2], vb, pa0, pa1, pa2, pa3); pv_one<3>(o[3], vb, pa0, pa1, pa2, pa3);
}
struct Desc {
  const bf16_t* Q; int ldq;
  const bf16_t* K0; const bf16_t* V0; int ld0, n0;
  const bf16_t* K1; const bf16_t* V1; int ld1;
  int seq;
  bf16_t* O; int ldo;
  int ks, qrow0;
};
template <int MODE> __device__ __forceinline__ void na_mask(f32x16& p0, f32x16& p1, int t, const Desc& d, int wid, int r32, int hi, const float* btab) {
  if constexpr (MODE == 1) {
    if (t >= 4) {
      const int kr = d.ks + t - 4, qrow = d.qrow0 + (wid >> 1), qc = (wid & 1) * 32 + r32;
      const int r0q = min(max(qrow - 4, 0), 24);
      const bool rowok = (kr >= r0q) && (kr < r0q + 8);
      if (rowok) {
        const int qs = min(max(qc - 8, 0), 48);
        const float* brow = btab + (kr - qrow + 7) * 31 + (15 - qc + 4 * hi);
        const int kb = 4 * hi - qs;
#pragma unroll
        for (int rg = 0; rg < 4; ++rg) {
#pragma unroll
          for (int r = rg * 4; r < rg * 4 + 4; ++r) {
            const int kc = (r & 3) + 8 * (r >> 2);
            const bool ok0 = ((unsigned)(kc + kb) < 16u);
            const float b0 = brow[kc];
            p0[r] = ok0 ? p0[r] + b0 : -1e30f;
          }
          SBAR();
        }
#pragma unroll
        for (int rg = 0; rg < 4; ++rg) {
#pragma unroll
          for (int r = rg * 4; r < rg * 4 + 4; ++r) {
            const int kc = (r & 3) + 8 * (r >> 2);
            const bool ok1 = ((unsigned)(kc + 32 + kb) < 16u);
            const float b1 = brow[kc + 32];
            p1[r] = ok1 ? p1[r] + b1 : -1e30f;
          }
          SBAR();
        }
      } else {
#pragma unroll
        for (int r = 0; r < 16; ++r) { p0[r] = -1e30f; p1[r] = -1e30f; }
      }
    }
  }
}
template <int MODE>
__device__ __forceinline__ void attn_body(const Desc& d, char* lds) {
  const int tid = tid_opaque(), wid = tid >> 6, lane = tid & 63, r32 = lane & 31, hi = lane >> 5;
  char* V_lds = lds; char* K_lds = lds + 2 * SHM_V;
  float* ws = (float*)(lds + 2 * SHM_V + 2 * SHM_K) + wid * 64; float* li_l = ws; float* al_l = ws + 32;
  const float* btab = (const float*)(lds + SHM_ATTN) + 64;
  float m_reg = -1e30f, l_reg = 0; f32x16 o[4] = {}; bf16x8 qr[8];
  const bf16_t* Qw = d.Q + (long)(wid * QBLK + r32) * d.ldq + hi * 8;
#pragma unroll
  for (int d0 = 0; d0 < 8; ++d0) qr[d0] = *reinterpret_cast<const bf16x8*>(Qw + d0 * 16);
  const int sr = tid >> 4, sc = (tid & 15) * 8, vst0 = v_st(sr, sc), vst1 = v_st(32 + sr, sc);
  const int vb0 = (int)(uintptr_t)V_lds + v_rd_base(lane);
  constexpr int SDEPTH = (MODE == 1) ? 1 : 2;
  struct { bf16x8 vs0, vs1, ks0, ks1; } sr_[SDEPTH];
  const unsigned vo0a = (unsigned)(sr * d.ld0 + sc) * 2u, vo0b = (unsigned)((sr + 32) * d.ld0 + sc) * 2u, vo1a = (unsigned)(sr * d.ld1 + sc) * 2u, vo1b = (unsigned)((sr + 32) * d.ld1 + sc) * 2u;
#define SLOAD(i, k0) do { const bool s0_ = (k0) < d.n0; \
    const char* kb_ = s0_ ? (const char*)d.K0 + (size_t)(k0) * d.ld0 * 2 : (const char*)d.K1 + (size_t)((k0) - d.n0) * d.ld1 * 2; \
    const char* vb_ = s0_ ? (const char*)d.V0 + (size_t)(k0) * d.ld0 * 2 : (const char*)d.V1 + (size_t)((k0) - d.n0) * d.ld1 * 2; \
    const unsigned oa_ = s0_ ? vo0a : vo1a, ob_ = s0_ ? vo0b : vo1b; \
    sr_[i].vs0 = *reinterpret_cast<const bf16x8*>(vb_ + oa_); sr_[i].vs1 = *reinterpret_cast<const bf16x8*>(vb_ + ob_); \
    sr_[i].ks0 = *reinterpret_cast<const bf16x8*>(kb_ + oa_); sr_[i].ks1 = *reinterpret_cast<const bf16x8*>(kb_ + ob_); } while (0)
#define SWRITE(b, i) do { *(bf16x8*)(V_lds + (b) * SHM_V + vst0) = sr_[i].vs0;          \
    *(bf16x8*)(V_lds + (b) * SHM_V + vst1) = sr_[i].vs1; int kc = sc * 2;               \
    *(bf16x8*)(K_lds + (b) * SHM_K + KSWZ(sr, kc)) = sr_[i].ks0;                       \
    *(bf16x8*)(K_lds + (b) * SHM_K + KSWZ(32 + sr, kc)) = sr_[i].ks1; } while (0)
#define SWAIT() do { if constexpr (SDEPTH == 2) asm volatile("s_waitcnt vmcnt(4)" ::: "memory"); else asm volatile("s_waitcnt vmcnt(0)" ::: "memory"); } while (0)
#define RESC(a) do { if (__any((a) < 1.f)) { if (hi == 0) al_l[r32] = (a); asm volatile("s_waitcnt lgkmcnt(0)" ::: "memory"); \
    _Pragma("unroll") for (int dd = 0; dd < 4; ++dd) _Pragma("unroll") for (int r = 0; r < 16; ++r) o[dd][r] *= al_l[crow(r, hi)]; } } while (0)
  f32x16 pA0, pA1, pB0, pB1; float mnA, mnB, alA, alB; bf16x8 pa0, pa1, pa2, pa3; const int NT = d.seq / KVBLK;
  constexpr int SE = 0, SO = SDEPTH - 1;
  SLOAD(SE, 0); asm volatile("s_waitcnt vmcnt(0)" ::: "memory"); SWRITE(0, SE); __syncthreads();
  qkt(pA0, pA1, K_lds, qr, r32, hi); na_mask<MODE>(pA0, pA1, 0, d, wid, r32, hi, btab); partialSM(pA0, pA1, m_reg, mnA, alA);
  SLOAD(SO, KVBLK); if constexpr (SDEPTH == 2) { if (2 < NT) SLOAD(SE, 2 * KVBLK); }
  SWAIT(); SWRITE(1, SO); if constexpr (SDEPTH == 1) { if (2 < NT) SLOAD(SE, 2 * KVBLK); } __syncthreads();
  for (int j = 1; j + 1 < NT; j += 2) {
    SBAR(); qkt(pB0, pB1, K_lds + SHM_K, qr, r32, hi); na_mask<MODE>(pB0, pB1, j, d, wid, r32, hi, btab);
    finishSM(pA0, pA1, alA, l_reg, pa0, pa1, pa2, pa3); SBAR();
    if constexpr (SDEPTH == 2) SLOAD(SO, (j + SDEPTH) * KVBLK); SBAR();
    pv_d0(o, vb0, pa0, pa1, pa2, pa3); partialSM(pB0, pB1, m_reg, mnB, alB);
    __syncthreads(); SWAIT(); SWRITE(0, SE); if constexpr (SDEPTH == 1) SLOAD(SE, (j + 2) * KVBLK);
    RESC(alB); __syncthreads();
    SBAR(); qkt(pA0, pA1, K_lds, qr, r32, hi); na_mask<MODE>(pA0, pA1, j + 1, d, wid, r32, hi, btab);
    finishSM(pB0, pB1, alB, l_reg, pa0, pa1, pa2, pa3); SBAR();
    if constexpr (SDEPTH == 2) { if (j + 3 < NT) SLOAD(SE, (j + 3) * KVBLK); } SBAR();
    pv_d0(o, vb0 + (int)SHM_V, pa0, pa1, pa2, pa3); partialSM(pA0, pA1, m_reg, mnA, alA);
    __syncthreads(); SWAIT(); SWRITE(1, SO); if constexpr (SDEPTH == 1) { if (j + 3 < NT) SLOAD(SO, (j + 3) * KVBLK); }
    RESC(alA); __syncthreads();
  }
  SBAR(); qkt(pB0, pB1, K_lds + SHM_K, qr, r32, hi); na_mask<MODE>(pB0, pB1, NT - 1, d, wid, r32, hi, btab);
  finishSM(pA0, pA1, alA, l_reg, pa0, pa1, pa2, pa3); SBAR();
  pv_d0(o, vb0, pa0, pa1, pa2, pa3); partialSM(pB0, pB1, m_reg, mnB, alB);
  __syncthreads(); RESC(alB);
  finishSM(pB0, pB1, alB, l_reg, pa0, pa1, pa2, pa3); SBAR();
  pv_d0(o, vb0 + (int)SHM_V, pa0, pa1, pa2, pa3);
  if (hi == 0) li_l[r32] = l_reg; asm volatile("s_waitcnt lgkmcnt(0)" ::: "memory");
  float rli[16];
#pragma unroll
  for (int r = 0; r < 16; ++r) rli[r] = __builtin_amdgcn_rcpf(li_l[crow(r, hi)]);
  bf16_t* Ow = d.O + (long)(wid * QBLK) * DM;
#pragma unroll
  for (int r = 0; r < 16; ++r) { int orow = crow(r, hi);
#pragma unroll
    for (int d0 = 0; d0 < 4; ++d0) Ow[(long)orow * DM + d0 * 32 + r32] = (bf16_t)(cvtpk(o[d0][r] * rli[r], 0.f) & 0xffffu); }
#undef SLOAD
#undef SWRITE
#undef SWAIT
#undef RESC
}
}

__device__ __forceinline__ void ada_item(const Params& p, int item, unsigned char* shm) {
  const int tid = tid_opaque(), wid = tid >> 6, lane = tid & 63;
  const int layer = item / 96, r = item % 96, kh = r / 48, cb = r % 48;
  float* sc = (float*)shm;
  float* red = (float*)shm + 9 * 1024;
  __syncthreads();
  for (int i = tid; i < 9 * 1024; i += 512) { const int rr = i >> 10, kk = i & 1023;
    const float v = rr < 8 ? p.in[I_C][rr * 2048 + kh * 1024 + kk] : p.in[I_CCTX][kh * 1024 + kk]; sc[i] = silu_f(v); }
  __syncthreads();
  const float* W = p.in[I_ADAW] + ((size_t)layer * 2048 + kh * 1024 + wid * 128) * 12288 + cb * 256 + lane * 4;
  f32x4 acc[9];
#pragma unroll
  for (int i = 0; i < 9; ++i) acc[i] = (f32x4){0.f, 0.f, 0.f, 0.f};
  for (int k = 0; k < 128; k += 8) {
    f32x4 w[8];
#pragma unroll
    for (int u = 0; u < 8; ++u) w[u] = *(const f32x4*)(W + (size_t)(k + u) * 12288);
#pragma unroll
    for (int u = 0; u < 8; ++u)
#pragma unroll
      for (int i = 0; i < 9; ++i) acc[i] += sc[i * 1024 + wid * 128 + k + u] * w[u];
  }
#pragma unroll
  for (int i = 0; i < 9; ++i) *(f32x4*)(red + ((size_t)wid * 9 + i) * 256 + lane * 4) = acc[i];
  __syncthreads();
  float* part = (float*)(p.ws + W_PART);
  for (int i = tid; i < 9 * 256; i += 512) { const int rr = i >> 8, c = i & 255; float s = 0.f;
#pragma unroll
    for (int w = 0; w < 8; ++w) s += red[((size_t)w * 9 + rr) * 256 + c];
    const int col = cb * 256 + c;
    if (kh == 0) s += p.in[I_ADAB][layer * 12288 + col];
    part[((size_t)(layer * 2 + kh) * 9 + rr) * 12288 + col] = s; }
}
template <int MAP> __device__ __forceinline__ void transpose_tile(const float* W, int ldw, int K, int k0, int n0, bf16_t* Wt, unsigned char* shm) {
  const int tid = tid_opaque(); float* tile = (float*)shm;
  __syncthreads();
  f32x4 v[8];
#pragma unroll
  for (int i = 0; i < 8; ++i) { const int kk = (tid >> 6) + i * 8, c4 = (tid & 63) * 4; v[i] = *(const f32x4*)(W + (size_t)(k0 + kk) * ldw + n0 + c4); }
#pragma unroll
  for (int i = 0; i < 8; ++i) { const int kk = (tid >> 6) + i * 8, c4 = (tid & 63) * 4; *(f32x4*)(tile + kk * 260 + c4) = v[i]; }
  __syncthreads();
  const int n = tid & 255, kq = tid >> 8; int col = n0 + n, row;
  if (MAP == 0) row = col;
  else { const int isg = col >= FF ? 1 : 0, ch = col - isg * FF; row = (ch >> 7) * 256 + isg * 128 + (ch & 127); }
  bf16_t* dst = Wt + (size_t)row * K + k0 + kq * 32;
#pragma unroll
  for (int s = 0; s < 4; ++s) { float f[8];
#pragma unroll
    for (int i = 0; i < 8; ++i) f[i] = tile[(kq * 32 + s * 8 + i) * 260 + n];
    u32x4 w = {cvtpk(f[0], f[1]), cvtpk(f[2], f[3]), cvtpk(f[4], f[5]), cvtpk(f[6], f[7])}; *(u32x4*)(dst + s * 8) = w; }
}
template <int J> __device__ __forceinline__ void fold_item(const float* W, int ldw, int colbase, const float* M, const float* cs, bf16_t* Wt, int rowbase, int kc, unsigned char* shm) {
  const int tid = tid_opaque(); float* wl = (float*)shm;
  constexpr int KPT = 32 * J / 512;
  __syncthreads();
#pragma unroll
  for (int i = 0; i < 2; ++i) { const int idx = tid + i * 512, kk = idx >> 5, c4 = (idx & 31) * 4;
    *(f32x4*)(wl + kk * 132 + c4) = *(const f32x4*)(W + (size_t)(kc * 32 + kk) * ldw + colbase + c4); }
  __syncthreads();
  const int j = tid % J, kq = tid / J;
  float acc[KPT];
#pragma unroll
  for (int i = 0; i < KPT; ++i) acc[i] = 0.f;
  for (int c = 0; c < 128; c += 4) {
    const float m0 = M[(c + 0) * J + j], m1 = M[(c + 1) * J + j], m2 = M[(c + 2) * J + j], m3 = M[(c + 3) * J + j];
#pragma unroll
    for (int i = 0; i < KPT; ++i) { const f32x4 wv = *(const f32x4*)(wl + (kq * KPT + i) * 132 + c); acc[i] += wv[0] * m0 + wv[1] * m1 + wv[2] * m2 + wv[3] * m3; }
  }
  const float s = cs ? cs[j] : 1.f;
  bf16_t* dst = Wt + (size_t)(rowbase + j) * DM + kc * 32 + kq * KPT;
#pragma unroll
  for (int i = 0; i < KPT; i += 8) { u32x4 w = {cvtpk(acc[i] * s, acc[i + 1] * s), cvtpk(acc[i + 2] * s, acc[i + 3] * s), cvtpk(acc[i + 4] * s, acc[i + 5] * s), cvtpk(acc[i + 6] * s, acc[i + 7] * s)};
    *(u32x4*)(dst + i) = w; }
}
__device__ __forceinline__ void fold_item2(const float* W, int ldw, int colbase, const float* M, int ldm, int mcol0, const float* cs, bf16_t* Wt, int rowbase, int kc, unsigned char* shm) {
  const int tid = tid_opaque(); float* wl = (float*)shm;
  float* ml = (float*)(shm + 16896);
  __syncthreads();
  f32x4 wr_[2], mr_[8];
#pragma unroll
  for (int i = 0; i < 2; ++i) { const int idx = tid + i * 512, kk = idx >> 5, c4 = (idx & 31) * 4; wr_[i] = *(const f32x4*)(W + (size_t)(kc * 32 + kk) * ldw + colbase + c4); }
#pragma unroll
  for (int i = 0; i < 8; ++i) { const int idx = tid + i * 512, c = idx >> 5, c4 = (idx & 31) * 4; mr_[i] = *(const f32x4*)(M + (size_t)c * ldm + mcol0 + c4); }
#pragma unroll
  for (int i = 0; i < 2; ++i) { const int idx = tid + i * 512, kk = idx >> 5, c4 = (idx & 31) * 4; *(f32x4*)(wl + kk * 132 + c4) = wr_[i]; }
#pragma unroll
  for (int i = 0; i < 8; ++i) { const int idx = tid + i * 512, c = idx >> 5, c4 = (idx & 31) * 4; *(f32x4*)(ml + c * 128 + c4) = mr_[i]; }
  __syncthreads();
  const int j = tid & 127, kq = tid >> 7;
  float acc[8];
#pragma unroll
  for (int i = 0; i < 8; ++i) acc[i] = 0.f;
#pragma unroll 4
  for (int c = 0; c < 128; c += 4) {
    const float m0 = ml[(c + 0) * 128 + j], m1 = ml[(c + 1) * 128 + j], m2 = ml[(c + 2) * 128 + j], m3 = ml[(c + 3) * 128 + j];
#pragma unroll
    for (int i = 0; i < 8; ++i) { const f32x4 wv = *(const f32x4*)(wl + (kq * 8 + i) * 132 + c); acc[i] += wv[0] * m0 + wv[1] * m1 + wv[2] * m2 + wv[3] * m3; }
  }
  const float sc_ = cs ? cs[j] : 1.f;
  u32x4 w = {cvtpk(acc[0] * sc_, acc[1] * sc_), cvtpk(acc[2] * sc_, acc[3] * sc_), cvtpk(acc[4] * sc_, acc[5] * sc_), cvtpk(acc[6] * sc_, acc[7] * sc_)};
  *(u32x4*)(Wt + (size_t)(rowbase + j) * DM + kc * 32 + kq * 8) = w;
}
template <int MODE, int NR> __device__ __forceinline__ void norm_rows(const Params& p, int row0, const float* xp, const float* xs, const float* g, int layer, int kshift, float* yout) {
  const int lane = tid_opaque() & 63;
  f32x4 v[NR][8]; float ss[NR];
#pragma unroll
  for (int r = 0; r < NR; ++r) { const int row = row0 + r * 8;
    const float* x = row < NP ? xp + (size_t)row * DM : xs + (size_t)(row - NP) * DM;
#pragma unroll
    for (int i = 0; i < 8; ++i) v[r][i] = *(const f32x4*)(x + (i * 64 + lane) * 4); }
#pragma unroll
  for (int r = 0; r < NR; ++r) { float s = 0.f;
#pragma unroll
    for (int i = 0; i < 8; ++i) s += v[r][i][0] * v[r][i][0] + v[r][i][1] * v[r][i][1] + v[r][i][2] * v[r][i][2] + v[r][i][3] * v[r][i][3];
    ss[r] = rsqrtf(wave_sum(s) * (1.f / 2048.f) + 1e-6f); }
  if (MODE == 0) {
    const int bidx = row0 < NP ? 8 : ((row0 - NP) >> 11);
    const float* part = (const float*)(p.ws + W_PART);
#pragma unroll
    for (int i = 0; i < 8; ++i) { const int c = (i * 64 + lane) * 4;
      const f32x4 gv = *(const f32x4*)(g + c), sh = modv4(part, layer, bidx, kshift, c), scl = modv4(part, layer, bidx, kshift + 1, c);
      const f32x4 gs = gv * (scl + 1.f);
#pragma unroll
      for (int r = 0; r < NR; ++r) { const f32x4 y = v[r][i] * ss[r] * gs + sh;
        u32x2 w = {cvtpk(y[0], y[1]), cvtpk(y[2], y[3])}; *(u32x2*)((bf16_t*)(p.ws + W_ACT) + (size_t)(row0 + r * 8) * DM + c) = w; } }
  } else {
#pragma unroll
    for (int i = 0; i < 8; ++i) { const int c = (i * 64 + lane) * 4; const f32x4 gv = *(const f32x4*)(g + c);
#pragma unroll
      for (int r = 0; r < NR; ++r) *(f32x4*)(yout + (size_t)(row0 + r * 8) * DM + c) = v[r][i] * ss[r] * gv; }
  }
}
template <int MODE, int NR> __device__ __forceinline__ void norm_rows_b(const Params& p, int row0, const float* g, int layer, int kshift, float* yout) {
  const int lane = tid_opaque() & 63;
  const bf16_t* xb = (const bf16_t*)(p.ws + W_XB);
  u32x4 v[NR][4]; float ss[NR];
#pragma unroll
  for (int r = 0; r < NR; ++r)
#pragma unroll
    for (int i = 0; i < 4; ++i) v[r][i] = *(const u32x4*)(xb + (size_t)(row0 + r * 8) * DM + (i * 64 + lane) * 8);
#pragma unroll
  for (int r = 0; r < NR; ++r) { float s = 0.f;
#pragma unroll
    for (int i = 0; i < 4; ++i)
#pragma unroll
      for (int e = 0; e < 4; ++e) { const float a = bflo(v[r][i][e]), b = bfhi(v[r][i][e]); s += a * a + b * b; }
    ss[r] = rsqrtf(wave_sum(s) * (1.f / 2048.f) + 1e-6f); }
  const int bidx = row0 < NP ? 8 : ((row0 - NP) >> 11);
  const float* part = (const float*)(p.ws + W_PART);
#pragma unroll
  for (int i = 0; i < 4; ++i) { const int c = (i * 64 + lane) * 8;
    f32x4 gs0 = *(const f32x4*)(g + c), gs1 = *(const f32x4*)(g + c + 4), sh0 = {0.f, 0.f, 0.f, 0.f}, sh1 = {0.f, 0.f, 0.f, 0.f};
    if (MODE == 0) { gs0 = gs0 * (modv4(part, layer, bidx, kshift + 1, c) + 1.f); gs1 = gs1 * (modv4(part, layer, bidx, kshift + 1, c + 4) + 1.f);
      sh0 = modv4(part, layer, bidx, kshift, c); sh1 = modv4(part, layer, bidx, kshift, c + 4); }
#pragma unroll
    for (int r = 0; r < NR; ++r) { const u32x4 w = v[r][i];
      const f32x4 x0 = {bflo(w[0]), bfhi(w[0]), bflo(w[1]), bfhi(w[1])}, x1 = {bflo(w[2]), bfhi(w[2]), bflo(w[3]), bfhi(w[3])};
      const f32x4 y0 = x0 * ss[r] * gs0 + sh0, y1 = x1 * ss[r] * gs1 + sh1;
      if (MODE == 0) { u32x4 o = {cvtpk(y0[0], y0[1]), cvtpk(y0[2], y0[3]), cvtpk(y1[0], y1[1]), cvtpk(y1[2], y1[3])};
        *(u32x4*)((bf16_t*)(p.ws + W_ACT) + (size_t)(row0 + r * 8) * DM + c) = o; }
      else { float* y = yout + (size_t)(row0 + r * 8) * DM + c; *(f32x4*)y = y0; *(f32x4*)(y + 4) = y1; } } }
}
__device__ __forceinline__ void fix_phase(const Params& p, int layer) {
  const float* UB = (const float*)(p.ws + W_UB); bf16_t* G = (bf16_t*)(p.ws + W_BIG);
  const float* cw = p.in[I_FFCW] + (size_t)layer * 3 * FF2; const float* cb = p.in[I_FFCB] + (size_t)layer * FF2;
  const long total = 768L * (FF / 4), stride = (long)gridDim.x * 512;
  for (long i0 = (long)blockIdx.x * 512 + tid_opaque(); i0 < total; i0 += 2 * stride) {
    f32x4 pv[2], pg[2], cv[2], cg[2], nv[2], ng[2], w[2][8]; float wp[2], wn[2]; int rowq[2], chq[2]; bool ok[2];
#pragma unroll
    for (int q = 0; q < 2; ++q) {
      const long iq = i0 + q * stride; ok[q] = iq < total; const long i = ok[q] ? iq : i0;
      const int rr = (int)(i / (FF / 4)), ch = (int)(i % (FF / 4)) * 4;
      const int chunk = rr >> 1, last = rr & 1, row = chunk * 64 + (last ? 63 : 0);
      const int seqlen = row < NP ? 256 : 2048; const int rel = row < NP ? row : row - NP;
      const int ubc = (ch >> 7) * 256 + (ch & 127);
      const bool hp = last ? true : (rel % seqlen) != 0, hn = last ? ((rel + 1) % seqlen) != 0 : true;
      const int pc = last ? chunk : max(chunk - 1, 0), nc = last ? min(chunk + 1, 383) : chunk;
      const float* pu = UB + ((size_t)pc * 4 + (last ? 2 : 3)) * FF2 + ubc;
      const float* cu = UB + ((size_t)chunk * 4 + (last ? 3 : 0)) * FF2 + ubc;
      const float* nu = UB + ((size_t)nc * 4 + (last ? 0 : 1)) * FF2 + ubc;
      pv[q] = *(const f32x4*)pu; pg[q] = *(const f32x4*)(pu + 128); cv[q] = *(const f32x4*)cu; cg[q] = *(const f32x4*)(cu + 128); nv[q] = *(const f32x4*)nu; ng[q] = *(const f32x4*)(nu + 128);
      w[q][0] = *(const f32x4*)(cw + ch); w[q][1] = *(const f32x4*)(cw + FF2 + ch); w[q][2] = *(const f32x4*)(cw + 2 * FF2 + ch); w[q][3] = *(const f32x4*)(cb + ch);
      w[q][4] = *(const f32x4*)(cw + FF + ch); w[q][5] = *(const f32x4*)(cw + FF2 + FF + ch); w[q][6] = *(const f32x4*)(cw + 2 * FF2 + FF + ch); w[q][7] = *(const f32x4*)(cb + FF + ch);
      wp[q] = hp ? 1.f : 0.f; wn[q] = hn ? 1.f : 0.f; rowq[q] = row; chq[q] = ch;
    }
#pragma unroll
    for (int q = 0; q < 2; ++q) {
      const f32x4 val = w[q][0] * (pv[q] * wp[q]) + w[q][1] * cv[q] + w[q][2] * (nv[q] * wn[q]) + w[q][3];
      const f32x4 gat = w[q][4] * (pg[q] * wp[q]) + w[q][5] * cg[q] + w[q][6] * (ng[q] * wn[q]) + w[q][7];
      u32x2 o = {cvtpk(silu_fast(gat[0]) * val[0], silu_fast(gat[1]) * val[1]), cvtpk(silu_fast(gat[2]) * val[2], silu_fast(gat[3]) * val[3])};
      if (ok[q]) *(u32x2*)(G + (size_t)rowq[q] * FF + chq[q]) = o;
    }
  }
}
__device__ __forceinline__ void oddprep_row(const Params& p, int row) {
  const int lane = tid_opaque() & 63;
  bf16_t* pr = (bf16_t*)(p.ws + W_BIG) + (size_t)row * ODN;
  const bool lat = row >= NP; const int t = lat ? (row - NP) & 2047 : row & 255;
  const int grow = t >> 6, gcol = t & 63;
  const float* rope = (const float*)(p.ws + W_ROPE);
  unsigned raw[16];
#pragma unroll
  for (int v = 0; v < 16; ++v) raw[v] = *(const unsigned*)(pr + 512 + v * 128 + lane * 2);
  const int seqlen = lat ? 2048 : 256;
  const bf16_t* zb = pr + lane * 8;
  u32x4 zw[16];
#pragma unroll
  for (int si = 0; si < 16; ++si) { const int tc = min(max(t + si - 8, 0), seqlen - 1); zw[si] = *(const u32x4*)(zb + (long)(tc - t) * ODN); }
  const int e0 = lane * 2;
  const float gq0 = p.in[I_ODQG][e0], gq1 = p.in[I_ODQG][e0 + 1], gk0 = p.in[I_ODKG][e0], gk1 = p.in[I_ODKG][e0 + 1];
  const int pos = lane < 32 ? grow : gcol; const int i0 = e0 & 31;
  const float c0 = rope[(pos * 32 + i0) * 2], s0 = rope[(pos * 32 + i0) * 2 + 1], c1 = rope[(pos * 32 + i0 + 1) * 2], s1 = rope[(pos * 32 + i0 + 1) * 2 + 1];
  const bool isx1 = (lane & 16) == 0;
#pragma unroll
  for (int v = 0; v < 16; ++v) {
    float a = bflo(raw[v]), b = bfhi(raw[v]);
    const float ss = wave_sum_dpp(a * a + b * b);
    const float rinv = rsqrtf(ss * (1.f / 128.f) + 1e-6f);
    a = a * rinv * (v < 12 ? gq0 : gk0); b = b * rinv * (v < 12 ? gq1 : gk1);
    if (lat) {
      const float pa = __shfl_xor(a, 16), pb = __shfl_xor(b, 16);
      const float na = isx1 ? a * c0 - pa * s0 : a * c0 + pa * s0;
      const float nb = isx1 ? b * c1 - pb * s1 : b * c1 + pb * s1;
      a = na; b = nb;
    } else if (v >= 12) { float* o = p.out + O_GK + (size_t)row * 512 + (v - 12) * 128 + e0; o[0] = a; o[1] = b; }
    *(unsigned*)(pr + 512 + v * 128 + lane * 2) = cvtpk(a, b);
  }
  const int grp = lane >> 4; const int hw = 1 << grp;
  const int lo = max(t - hw, 0), hi = min(t + hw, seqlen);
  float acc[8];
#pragma unroll
  for (int i = 0; i < 8; ++i) acc[i] = 0.f;
#pragma unroll
  for (int si = 0; si < 16; ++si) { const int ts = t + si - 8; const float wgt = (ts >= lo && ts < hi) ? 1.f : 0.f;
#pragma unroll
    for (int i = 0; i < 4; ++i) { acc[2 * i] += wgt * bflo(zw[si][i]); acc[2 * i + 1] += wgt * bfhi(zw[si][i]); } }
  const u32x4 self = zw[8]; const float inv = 1.f / (float)(hi - lo);
  unsigned ow[4];
#pragma unroll
  for (int i = 0; i < 4; ++i) ow[i] = cvtpk(acc[2 * i] * inv - bflo(self[i]), acc[2 * i + 1] * inv - bfhi(self[i]));
  u32x4 w = {ow[0], ow[1], ow[2], ow[3]};
  *(u32x4*)((bf16_t*)(p.ws + W_ACT) + (size_t)row * DM + lane * 8) = w;
}

__device__ __forceinline__ void do_tile(const Params& p, int i, unsigned char* shm) {
  constexpr int T0 = 576, T1 = 256, T2 = 320, T3 = 256, T4 = 2816;
  if (i < T0) { const int kt = i / 18, nt = i % 18; transpose_tile<0>(p.in[I_EVWIN], 5120, DM, kt * 64, nt * 256, (bf16_t*)(p.ws + W_EVIN), shm); return; } i -= T0;
  if (i < T1) { const int kt = i / 8, nt = i % 8; transpose_tile<0>(p.in[I_EVWOUT], DM, DM, kt * 64, nt * 256, (bf16_t*)(p.ws + W_EVOUT), shm); return; } i -= T1;
  if (i < T2) { const int kt = i / 10, nt = i % 10; transpose_tile<0>(p.in[I_ODWIN], ODN, DM, kt * 64, 512 + nt * 256, (bf16_t*)(p.ws + W_ODIN), shm); return; } i -= T2;
  if (i < T3) { const int kt = i / 8, nt = i % 8; transpose_tile<0>(p.in[I_ODWOUT], DM, DM, kt * 64, nt * 256, (bf16_t*)(p.ws + W_ODOUT), shm); return; } i -= T3;
  if (i < T4) { const int l = i / 1408, r = i % 1408, kt = r / 44, nt = r % 44;
    transpose_tile<1>(p.in[I_FFUP] + (size_t)l * DM * FF2, FF2, DM, kt * 64, nt * 256, (bf16_t*)(p.ws + W_UP) + (size_t)l * FF2 * DM, shm); return; } i -= T4;
  { const int l = i / 704, r = i % 704, kt = r / 8, nt = r % 8;
    transpose_tile<0>(p.in[I_FFDN] + (size_t)l * FF * DM, DM, FF, kt * 64, nt * 256, (bf16_t*)(p.ws + W_DN) + (size_t)l * DM * FF, shm); }
}
__device__ __forceinline__ int tile_now(int j) { return j < 832 ? j : (j < 2240 ? 1408 + (j - 832) : 4224 + (j - 2240)); }
__device__ __forceinline__ int tile_def(int d) { return d < 576 ? 832 + d : (d < 1984 ? 2816 + (d - 576) : 4928 + (d - 1984)); }
__device__ __forceinline__ void prep_phase(const Params& p, unsigned char* shm) {
  const int G = gridDim.x, bid = blockIdx.x, tid = tid_opaque();
  {
    const bool defer = (G == 256);
    const int n_ada = defer ? 96 : 192, n_tiles = defer ? 2944 : 5632;
    unsigned* qctr = (unsigned*)(p.ws + W_BAR);
    volatile LAS unsigned* qslot = (volatile LAS unsigned*)((LAS unsigned char*)shm + (LDS_BYTES - 32));
    for (;;) {
      __syncthreads();
      if (tid == 0) *qslot = atomicAdd(qctr, 1u);
      __syncthreads();
      const int it0 = (int)*qslot;
      if (it0 >= n_ada + n_tiles) break;
      if (it0 < n_ada) { ada_item(p, it0, shm); continue; }
      do_tile(p, defer ? tile_now(it0 - n_ada) : it0 - n_ada, shm);
    }
  }
  const long gt = (long)bid * 512 + tid, gs = (long)G * 512;
  {
    const long n0 = 8L * 256 * 1536 / 8, n1 = 8L * 256 * 512 / 8;
    const long ntot = 2 * n0 + 2 * n1;
    for (long ib = gt; ib < ntot; ib += 4 * gs) {
      f32x4 va[4], vb[4]; bf16_t* dq[4]; bool okq[4];
#pragma unroll
      for (int q = 0; q < 4; ++q) { const long iq = ib + q * gs; okq[q] = iq < ntot; long j = okq[q] ? iq : ib;
        const float* src; bf16_t* dst;
        if (j < n0) { src = p.in[I_CNAK]; dst = (bf16_t*)(p.ws + W_CNAK); }
        else if (j < 2 * n0) { j -= n0; src = p.in[I_CNAV]; dst = (bf16_t*)(p.ws + W_CNAV); }
        else if (j < 2 * n0 + n1) { j -= 2 * n0; src = p.in[I_CGK]; dst = (bf16_t*)(p.ws + W_CGK); }
        else { j -= 2 * n0 + n1; src = p.in[I_CGV]; dst = (bf16_t*)(p.ws + W_CGV); }
        va[q] = *(const f32x4*)(src + j * 8); vb[q] = *(const f32x4*)(src + j * 8 + 4); dq[q] = dst + j * 8; }
#pragma unroll
      for (int q = 0; q < 4; ++q) { u32x4 w = {cvtpk(va[q][0], va[q][1]), cvtpk(va[q][2], va[q][3]), cvtpk(vb[q][0], vb[q][1]), cvtpk(vb[q][2], vb[q][3])}; if (okq[q]) *(u32x4*)dq[q] = w; }
    }
  }
  {
    float* ct = (float*)shm;
    __syncthreads();
    for (int i = tid; i < 2048; i += 512) ct[i] = cospif((float)i * (2.f / 2048.f));
    __syncthreads();
    const long nS = 2048L * 4096 / 8, nC = 256L * 512 / 8;
    for (long i = gt; i < nS + nC; i += gs) {
      int npos, sh, ts; long j; bf16_t* dst;
      if (i < nS) { npos = 2048; sh = 11; ts = 0; j = i; dst = (bf16_t*)(p.ws + W_DFTS); } else { npos = 256; sh = 8; ts = 3; j = i - nS; dst = (bf16_t*)(p.ws + W_DFTC); }
      const int prow = (int)((j * 8) >> (sh + 1)), k0 = (int)((j * 8) & (2 * npos - 1));
      float f[8];
#pragma unroll
      for (int e = 0; e < 8; ++e) { const int k = k0 + e; const int kk = k & (npos - 1); const int m = ((prow * kk) & (npos - 1)) << ts;
        f[e] = (k < npos) ? ct[m] : -ct[(m - 512) & 2047]; }
      u32x4 w = {cvtpk(f[0], f[1]), cvtpk(f[2], f[3]), cvtpk(f[4], f[5]), cvtpk(f[6], f[7])}; *(u32x4*)(dst + j * 8) = w;
    }
    float* M = (float*)(p.ws + W_FOLDM);
    for (long i = gt; i < 4L * 128 * 256; i += gs) { const int j = (int)(i & 255), c = (int)((i >> 8) & 127), g = (int)(i >> 15);
      const float* fw = p.in[I_EVFNET] + (size_t)g * 128 * 128 + (j & 127); float s = 0.f; const int off = (j < 128) ? 0 : 2048 - 512;
#pragma unroll 8
      for (int c2 = 0; c2 < 128; ++c2) { const float tr = ct[((((c * c2) & 127) << 4) + off) & 2047]; s += tr * fw[c2 * 128]; }
      M[i] = s; }
  }
  {
    float* rope = (float*)(p.ws + W_ROPE);
    for (long i = gt; i < 64 * 32; i += gs) { const int pos = (int)(i >> 5), k = (int)(i & 31);
      const float invf = exp2f(-(float)k * (1.f / 32.f) * 13.287712379549449f);
      const float ang = (float)pos * invf; const float x = ang * 0.3183098861837907f;
      rope[i * 2] = cospif(x); rope[i * 2 + 1] = sinpif(x); }
  }
}

#define XB_TMO      128
#define XB_XCNT(j)  (256  + 64 * (j))
#define XB_XSUB(j)  (1280 + 64 * (j))
#define XB_XGEN(j)  (2304 + 64 * (j))
#define XB_TOP      3328
#define XB_TOPGEN   3392
#define XCD_BAR_WORDS 3456
#define XB_SPIN_CAP (1u << 18)
__device__ __forceinline__ unsigned xb_ld(unsigned* p)              { return __hip_atomic_load(p, __ATOMIC_RELAXED, __HIP_MEMORY_SCOPE_AGENT); }
__device__ __forceinline__ unsigned xb_add(unsigned* p, unsigned v) { return __hip_atomic_fetch_add(p, v, __ATOMIC_RELAXED, __HIP_MEMORY_SCOPE_AGENT); }
__device__ __forceinline__ unsigned xb_xcc_id() { return (unsigned)__builtin_amdgcn_s_getreg((3 << 11) | 20) & 0xFu; }
#define XB_SPIN(cond, bar) do { unsigned _sp = 0; while (cond) { __builtin_amdgcn_s_sleep(1); \
    if ((++_sp & 255u) == 0u) { if (xb_ld(&(bar)[XB_TMO])) break; if (_sp > XB_SPIN_CAP) { atomicAdd(&(bar)[XB_TMO], 1u); break; } } } } while (0)
struct XcdBarrier { unsigned* bar; unsigned x; volatile LAS unsigned* st; };
__device__ __forceinline__ XcdBarrier xcd_barrier_post(unsigned* bar, volatile LAS unsigned* st) {
    XcdBarrier b; b.bar = bar; b.x = xb_xcc_id(); b.st = st;
    if (threadIdx.x == 0) (void)xb_add(&bar[XB_XCNT(b.x)], 1u);
    return b;
}
__device__ __forceinline__ void xcd_barrier_complete(unsigned* bar, unsigned x, unsigned& nloc, unsigned& nx) {
    const unsigned G = gridDim.x * gridDim.y * gridDim.z;
    unsigned sum, cnt, mine, sp = 0u;
    for (;;) {
        sum = 0u; cnt = 0u; mine = 0u;
#pragma unroll
        for (unsigned j = 0; j < 16; ++j) { const unsigned c = xb_ld(&bar[XB_XCNT(j)]); sum += c; cnt += (c > 0u) ? 1u : 0u; mine = (j == x) ? c : mine; }
        if (sum == G) break;
        __builtin_amdgcn_s_sleep(1);
        if ((++sp & 255u) == 0u) { if (xb_ld(&bar[XB_TMO])) break; if (sp > XB_SPIN_CAP) { atomicAdd(&bar[XB_TMO], 1u); break; } }
    }
    nloc = mine > 0u ? mine : 1u; nx = cnt > 0u ? cnt : 1u;
}
__device__ __forceinline__ void xcd_barrier(const XcdBarrier& b) {
    asm volatile("s_waitcnt vmcnt(0)" ::: "memory");
    __syncthreads();
    if (threadIdx.x == 0) {
        unsigned* bar = b.bar;
        __builtin_amdgcn_s_waitcnt(0);
        unsigned nloc = b.st[0], nx = b.st[1];
        if (nloc == 0u) { xcd_barrier_complete(bar, b.x, nloc, nx); b.st[0] = nloc; b.st[1] = nx; }
        const unsigned old = xb_add(&bar[XB_XSUB(b.x)], 1u);
        const unsigned gen = old / nloc;
        if (old + 1u == (gen + 1u) * nloc) {
            __builtin_amdgcn_fence(__ATOMIC_RELEASE, "agent");
            asm volatile("s_waitcnt vmcnt(0)" ::: "memory");
            const unsigned og = xb_add(&bar[XB_TOP], 1u);
            const unsigned tg = og / nx;
            if (og + 1u == (tg + 1u) * nx) xb_add(&bar[XB_TOPGEN], 1u);
            else XB_SPIN(xb_ld(&bar[XB_TOPGEN]) == tg, bar);
            __builtin_amdgcn_fence(__ATOMIC_ACQUIRE, "agent");
            xb_add(&bar[XB_XGEN(b.x)], 1u);
            asm volatile("s_waitcnt vmcnt(0)" ::: "memory");
        } else {
            XB_SPIN(xb_ld(&bar[XB_XGEN(b.x)]) == gen, bar);
            __builtin_amdgcn_fence(__ATOMIC_ACQUIRE, "agent");
            asm volatile("s_waitcnt vmcnt(0)" ::: "memory");
        }
    }
    __syncthreads();
}

__global__ void __launch_bounds__(512, 2) mega(Params p_unused) {
  extern __shared__ __attribute__((aligned(16))) unsigned char shm[];
  cg::grid_group grid = cg::this_grid();
  typedef const Params __attribute__((address_space(4)))* KP;
  KP kp0 = (KP)__builtin_amdgcn_kernarg_segment_ptr();
  const int G = gridDim.x, bid = blockIdx.x;
  const int ph_lo = kp0->ph_lo, ph_hi = kp0->ph_hi;
  volatile LAS unsigned* xst = (volatile LAS unsigned*)((LAS unsigned char*)shm + (LDS_BYTES - 16));
  if (threadIdx.x == 0) { xst[0] = 0u; xst[1] = 0u; }
  __syncthreads();
  XcdBarrier xb = xcd_barrier_post((unsigned*)(kp0->ws + W_BAR), xst);
  for (int phx = ph_lo * 2; phx < ph_hi * 2; ++phx) {
    const int ph = phx >> 1;
    if ((phx & 1) && !((REPMASK >> ph) & 1)) continue;
    if (phx > ph_lo * 2) { if (ph_hi > 1000) grid.sync(); else xcd_barrier(xb); }
    KP kp = kp0; asm volatile("" : "+s"(kp));
    Params p;
#pragma unroll
    for (int i = 0; i < 27; ++i) p.in[i] = kp->in[i];
    p.out = kp->out; p.ws = kp->ws; p.ph_lo = 0; p.ph_hi = 0;
    float* xr = p.out + O_Y;
    bf16_t* ACT = (bf16_t*)(p.ws + W_ACT); bf16_t* BIG = (bf16_t*)(p.ws + W_BIG);
    const float* part = (const float*)(p.ws + W_PART);
    int kind, layer = ph >= 9 ? 1 : 0;
    switch (ph) {
      case 0: kind = 0; break;
      case 1: case 5: case 9: case 14: kind = 1; break;
      case 2: case 10: kind = 2; break;
      case 3: case 12: kind = 3; break;
      case 4: case 8: case 13: case 17: kind = 4; break;
      case 6: case 15: kind = 5; break;
      case 7: case 16: kind = 6; break;
      case 11: kind = 7; break;
      default: kind = 8; break;
    }
    if (kind == 0 && (KMASK & 1)) {
      prep_phase(p, shm);
    } else if (kind == 1 && (KMASK & 2)) {
      const bool first = (ph == 1);
      const float* xp = first ? p.in[I_XP] : xr; const float* xs = first ? p.in[I_XS] : xr + (size_t)NP * DM;
      const bool n2 = (ph == 5 || ph == 14);
      const float* g = (n2 ? p.in[I_N2G] : p.in[I_N1G]) + layer * DM;
      if (first) {
        for (int it = bid; it < 768; it += G) {
          if (it < 512) { const int gi = it >> 7, kc = (it >> 1) & 63, jh = it & 1;
            fold_item2(p.in[I_EVWIN], 5120, 4608 + gi * 128, (const float*)(p.ws + W_FOLDM) + (size_t)gi * 128 * 256, 256, jh * 128, nullptr, (bf16_t*)(p.ws + W_EVIN), 4608 + gi * 256 + jh * 128, kc, shm); }
          else { const int v = it - 512, gi = v >> 6, kc = v & 63;
            fold_item2(p.in[I_ODWIN], ODN, gi * 128, p.in[I_ODPOOLW] + (size_t)gi * 128 * 128, 128, 0, p.in[I_ODPOOLS] + gi * 128, (bf16_t*)(p.ws + W_ODIN), gi * 128, kc, shm); }
        }
      }
      const int wid = tid_opaque() >> 6;
      if (first) { for (int it = bid; it < NTOK / 32; it += G) norm_rows<0, 4>(p, it * 32 + wid, xp, xs, g, layer, n2 ? 3 : 0, nullptr); }
      else { for (int it = bid; it < NTOK / 32; it += G) norm_rows_b<0, 4>(p, it * 32 + wid, g, layer, n2 ? 3 : 0, nullptr); }
    } else if (kind == 2 && (KMASK & 4)) {
      pg8::Gemm gm; gm.A = ACT; gm.M = NTOK; gm.K = DM;
      EpiIn E; E.O = BIG; E.out = p.out; E.yts = (bf16_t*)(p.ws + W_YTS); E.ytc = (bf16_t*)(p.ws + W_YTC);
      if (layer == 0) { gm.Bt = (const bf16_t*)(p.ws + W_EVIN); gm.N = EVN; E.ldc = EVN; E.even = 1; }
      else { gm.Bt = (const bf16_t*)(p.ws + W_ODIN); gm.N = ODN; E.ldc = ODN; E.even = 0; }
      pg8::StaticOrder S; S.init(gm.M, gm.N, G, bid);
      pg8::gemm_phase<EpiIn>((LAS unsigned char*)shm, gm, S, E);
      if (layer == 0 && G == 256 && bid >= 64) { for (int d = bid - 64; d < 2112; d += 192) do_tile(p, tile_def(d), shm); }
    } else if (kind == 3 && (KMASK & 8)) {
      const int nunits = 768 + 384;
      const bool bal = (layer == 0 && G == 256);
      const int nloc = bal ? (bid < 128 ? 5 : 4) : (nunits - bid + G - 1) / G;
      for (int iu = 0; iu < nloc; ++iu) {
        int u;
        if (bal) { if (bid < 128) u = iu < 4 ? bid * 4 + iu : 768 + bid; else u = iu < 2 ? 512 + (bid - 128) * 2 + iu : 896 + (bid - 128) * 2 + (iu - 2); }
        else if (layer == 1 && G == 256 && iu < 3) u = (bid & 7) * 96 + iu * 32 + (bid >> 3);
        else u = bid + iu * G;
        at::Desc d; int masked = 0, head = 0;
        if (layer == 0) {
          if (u < 768) { const int b = u / 96, rem = u % 96, h = rem >> 3, rg = rem & 7; head = h; masked = 1;
            const size_t qrow = (size_t)NP + b * 2048 + rg * 256; const bool edge = (rg == 0 || rg == 7); const int ks = edge ? (rg ? 24 : 0) : min(max(4 * rg - 4, 0), 20);
            d.Q = BIG + qrow * EVN + h * 128; d.ldq = EVN;
            d.K0 = (const bf16_t*)(p.ws + W_CNAK) + (size_t)b * 256 * 1536 + h * 128; d.V0 = (const bf16_t*)(p.ws + W_CNAV) + (size_t)b * 256 * 1536 + h * 128; d.ld0 = 1536; d.n0 = 256;
            const size_t krow = (size_t)NP + b * 2048 + ks * 64;
            d.K1 = BIG + krow * EVN + 1536 + h * 128; d.V1 = BIG + krow * EVN + 3072 + h * 128; d.ld1 = EVN; d.seq = edge ? 768 : 1024;
            d.O = ACT + qrow * DM + h * 128; d.ldo = DM; d.ks = ks; d.qrow0 = 4 * rg;
          } else { const int v = u - 768, b = v / 12, h = v % 12; const size_t qrow = (size_t)b * 256;
            d.Q = BIG + qrow * EVN + h * 128; d.ldq = EVN;
            d.K0 = BIG + qrow * EVN + 1536 + h * 128; d.V0 = BIG + qrow * EVN + 3072 + h * 128; d.ld0 = EVN; d.n0 = 256;
            d.K1 = d.K0; d.V1 = d.V0; d.ld1 = EVN; d.seq = 256; d.O = ACT + qrow * DM + h * 128; d.ldo = DM; d.ks = 0; d.qrow0 = 0; }
        } else {
          if (u < 768) { const int b = u / 96, rem = u % 96, h = rem >> 3, qb = rem & 7, kvh = h / 3;
            const size_t qrow = (size_t)NP + b * 2048 + qb * 256;
            d.Q = BIG + qrow * ODN + 512 + h * 128; d.ldq = ODN;
            d.K0 = (const bf16_t*)(p.ws + W_CGK) + (size_t)b * 256 * 512 + kvh * 128; d.V0 = (const bf16_t*)(p.ws + W_CGV) + (size_t)b * 256 * 512 + kvh * 128; d.ld0 = 512; d.n0 = 256;
            const size_t krow = (size_t)NP + b * 2048;
            d.K1 = BIG + krow * ODN + 2048 + kvh * 128; d.V1 = BIG + krow * ODN + 2560 + kvh * 128; d.ld1 = ODN; d.seq = 2304;
            d.O = ACT + qrow * DM + 512 + h * 128; d.ldo = DM; d.ks = 0; d.qrow0 = 0;
          } else { const int v = u - 768, b = v / 12, h = v % 12, kvh = h / 3; const size_t qrow = (size_t)b * 256;
            d.Q = BIG + qrow * ODN + 512 + h * 128; d.ldq = ODN;
            d.K0 = BIG + qrow * ODN + 2048 + kvh * 128; d.V0 = BIG + qrow * ODN + 2560 + kvh * 128; d.ld0 = ODN; d.n0 = 256;
            d.K1 = d.K0; d.V1 = d.V0; d.ld1 = ODN; d.seq = 256; d.O = ACT + qrow * DM + 512 + h * 128; d.ldo = DM; d.ks = 0; d.qrow0 = 0; }
        }
        __syncthreads();
        if (masked && (AMASK & 1)) {
          float* btab = (float*)(shm + at::SHM_ATTN) + 64;
          const int tid = tid_opaque();
          if (tid < 465) btab[tid] = p.in[I_EVBIAS][head * 465 + tid] * (1.f / at::SCALE);
          at::attn_body<1>(d, (char*)shm);
        } else if (AMASK & 2) at::attn_body<0>(d, (char*)shm);
      }
      if (layer == 0 && (AMASK & 4)) {
        __syncthreads();
#pragma unroll 1
        for (int v = 0; v < 2; ++v) {
          pg8::Gemm gm; EpiFourier E; E.mix = ACT;
          if (v == 0) { gm.A = (const bf16_t*)(p.ws + W_DFTS); gm.Bt = (const bf16_t*)(p.ws + W_YTS); gm.M = 2048; gm.N = 4096; gm.K = 4096; E.rowbase = NP; E.npos = 2048; E.scale = 0.001953125f; }
          else { gm.A = (const bf16_t*)(p.ws + W_DFTC); gm.Bt = (const bf16_t*)(p.ws + W_YTC); gm.M = 256; gm.N = 16384; gm.K = 512; E.rowbase = 0; E.npos = 256; E.scale = 0.005524271728019903f; }
          pg8::StaticOrder S; S.init(gm.M, gm.N, G, (bid + 128) % G);
          pg8::gemm_phase<EpiFourier>((LAS unsigned char*)shm, gm, S, E);
          __syncthreads();
        }
      }
    } else if (kind == 4 && (KMASK & 16)) {
      pg8::Gemm gm; gm.M = NTOK; gm.N = DM; EpiRes E; E.xb = (bf16_t*)(p.ws + W_XB); E.xo = (phx & 1) ? ACT : E.xb; E.part = part; E.layer = layer; E.xp = p.in[I_XP]; E.xs = p.in[I_XS]; E.from_in = 0;
      if (ph == 4) { gm.A = ACT; gm.Bt = (const bf16_t*)(p.ws + W_EVOUT); gm.K = DM; E.gk = 2; E.from_in = 1; }
      else if (ph == 13) { gm.A = ACT; gm.Bt = (const bf16_t*)(p.ws + W_ODOUT); gm.K = DM; E.gk = 2; }
      else { gm.A = BIG; gm.Bt = layer ? (const bf16_t*)(p.ws + W_DN + (size_t)DM * FF * 2) : (const bf16_t*)(p.ws + W_DN); gm.K = FF; E.gk = 5; }
      pg8::StaticOrder S; S.init(gm.M, gm.N, G, bid);
      pg8::gemm_phase<EpiRes>((LAS unsigned char*)shm, gm, S, E);
    } else if (kind == 5 && (KMASK & 32)) {
      pg8::Gemm gm; gm.A = ACT; gm.Bt = (const bf16_t*)(p.ws + W_UP) + (size_t)layer * FF2 * DM; gm.M = NTOK; gm.N = FF2; gm.K = DM;
      EpiUp E; E.G = BIG; E.UB = (float*)(p.ws + W_UB); E.cw = p.in[I_FFCW] + (size_t)layer * 3 * FF2; E.cb = p.in[I_FFCB] + (size_t)layer * FF2;
      pg8::StaticOrder S; S.init(gm.M, gm.N, G, bid);
      pg8::gemm_phase<EpiUp>((LAS unsigned char*)shm, gm, S, E);
      if (layer == 0 && G == 256 && bid >= 128) { if (bid < 224) ada_item(p, 96 + (bid - 128), shm); for (int d = 2112 + (bid - 128); d < 2688; d += 128) do_tile(p, tile_def(d), shm); }
    } else if (kind == 6 && (KMASK & 64)) {
      fix_phase(p, layer);
    } else if (kind == 7 && (KMASK & 128)) {
      const int wid = tid_opaque() >> 6;
      for (int it = bid; it < NTOK / 8; it += G) oddprep_row(p, it * 8 + wid);
    } else if (KMASK & 256) {
      for (int e = 0; e < EXTRA_SYNCS; ++e) xcd_barrier(xb);
      const int wid = tid_opaque() >> 6;
      for (int it = bid; it < NTOK / 32; it += G) norm_rows_b<1, 4>(p, it * 32 + wid, p.in[I_FING], 0, 0, xr);
    }
  }
}

extern "C" void kernel_launch(void* const* d_in, const int* in_sizes, int n_in, void* d_out, int out_size, void* d_ws, size_t ws_size, hipStream_t stream) {
  static int grid = 0;
  if (grid == 0) {
    if (n_in != 27 || out_size != 83886080 || ws_size < W_END) { fprintf(stderr, "kernel_launch: unexpected shapes: n_in %d out %d ws %zu (need %zu)\n", n_in, out_size, ws_size, (size_t)W_END); grid = -1; return; }
    int dev = 0, cus = 0, per_cu = 0;
    if (hipGetDevice(&dev) != hipSuccess || hipDeviceGetAttribute(&cus, hipDeviceAttributeMultiprocessorCount, dev) != hipSuccess) { grid = -1; return; }
    if (hipFuncSetAttribute((const void*)mega, hipFuncAttributeMaxDynamicSharedMemorySize, LDS_BYTES) != hipSuccess) { fprintf(stderr, "kernel_launch: hipFuncSetAttribute failed\n"); grid = -1; return; }
    if (hipOccupancyMaxActiveBlocksPerMultiprocessor(&per_cu, (const void*)mega, 512, LDS_BYTES) != hipSuccess || per_cu < 1) { fprintf(stderr, "kernel_launch: occupancy query says %d\n", per_cu); per_cu = 1; }
    (void)hipGetLastError();
    grid = cus * per_cu;
  }
  if (grid < 0) return;
  Params p{};
  for (int i = 0; i < 27; ++i) p.in[i] = (const float*)d_in[i];
  p.out = (float*)d_out; p.ws = (unsigned char*)d_ws;
#if N_LAUNCH_SPLIT
  for (int ph = 0; ph < PH_LIMIT; ++ph) { if (ph == SKIP_PH) continue; p.ph_lo = ph; p.ph_hi = ph + 1; hipLaunchKernelGGL(mega, dim3(grid), dim3(512), LDS_BYTES, stream, p); }
#else
  p.ph_lo = 0; p.ph_hi = NPH;
  (void)hipMemsetAsync((unsigned char*)d_ws + W_BAR, 0, 16384, stream);
  void* args[] = {&p};
  hipError_t e = hipLaunchCooperativeKernel((const void*)mega, dim3(grid), dim3(512), args, LDS_BYTES, stream);
  if (e != hipSuccess) fprintf(stderr, "kernel_launch: cooperative launch failed: %s (grid %d)\n", hipGetErrorString(e), grid);
#endif
}
```
